# Optimizing an MI355X kernel written in HIP

```python
import math
import jax, jax.numpy as jnp
from jax import lax
import numpy as np

D_MODEL = 2048
BATCH = 2
SEQ = 8192
DEPTH = 2

EXPAND = 2
MIX_WIDTH = EXPAND * D_MODEL
N_EVEN = (DEPTH + 1) // 2
N_ODD = DEPTH // 2
RET_WIDTH = MIX_WIDTH // 2
RET_HEADS = 4
RET_DV = RET_WIDTH // RET_HEADS
RET_DK = RET_DV // 2
RET_QK_WIDTH = RET_HEADS * RET_DK
RET_CHUNK = 128
ROPE_BASE = 10000.0
SGU_WIDTH = MIX_WIDTH // 2
SGU_GROUPS = 8
SGU_GDIM = SGU_WIDTH // SGU_GROUPS
SGU_CHUNK = 128
GLA_WIDTH = MIX_WIDTH
GLA_HEADS = 8
GLA_DV = GLA_WIDTH // GLA_HEADS
GLA_DK = GLA_DV // 2
GLA_QK_WIDTH = GLA_HEADS * GLA_DK
GLA_RANK = 16
GLA_TAU = 16.0
GLA_CHUNK = 64
EPS = 1e-6

EVEN_SIZES = (RET_QK_WIDTH, RET_QK_WIDTH, RET_WIDTH, RET_WIDTH, SGU_WIDTH, SGU_WIDTH, SGU_WIDTH)
ODD_SIZES = (GLA_QK_WIDTH, GLA_QK_WIDTH, GLA_WIDTH, GLA_WIDTH, GLA_RANK)
EVEN_IN = sum(EVEN_SIZES)
ODD_IN = sum(ODD_SIZES)

kernel_name = "hybrid_retention_sgu_gla_trunk"


def split_cols(p, sizes):
    outs, off = [], 0
    for s in sizes:
        outs.append(p[..., off:off + s])
        off += s
    return outs


def rms_norm(x, g):
    xf = x.astype(jnp.float32)
    y = xf * lax.rsqrt(jnp.mean(xf * xf, axis=-1, keepdims=True) + EPS)
    return (y * g.astype(jnp.float32)).astype(x.dtype)


def head_norm(o):
    of = o.astype(jnp.float32)
    return (of * lax.rsqrt(jnp.mean(of * of, axis=-1, keepdims=True) + EPS)).astype(o.dtype)


def rotary(x, positions):
    half = x.shape[-1] // 2
    inv = jnp.power(ROPE_BASE, -jnp.arange(half, dtype=jnp.float32) / half)
    ang = positions.astype(jnp.float32)[:, :, None] * inv
    cos = jnp.cos(ang)[:, :, None, :]
    sin = jnp.sin(ang)[:, :, None, :]
    xf = x.astype(jnp.float32)
    x1, x2 = xf[..., :half], xf[..., half:]
    return jnp.concatenate([x1 * cos - x2 * sin, x1 * sin + x2 * cos], axis=-1).astype(x.dtype)


def to_chunks(x, c):
    b, s, h, d = x.shape
    return x.reshape(b, s // c, c, h, d).transpose(1, 0, 3, 2, 4)


def from_chunks(x):
    nc, b, h, c, d = x.shape
    return x.transpose(1, 0, 3, 2, 4).reshape(b, nc * c, h, d)


def retention(q, k, v, positions):
    b, s, h, dk = q.shape
    dv = v.shape[-1]
    c = RET_CHUNK
    q = rotary(q, positions) * (dk ** -0.5)
    k = rotary(k, positions)
    log_gamma = jnp.log1p(-jnp.power(2.0, -5.0 - jnp.arange(h, dtype=jnp.float32)))
    idx = jnp.arange(c, dtype=jnp.float32)
    rel = idx[:, None] - idx[None, :]
    causal = rel >= 0
    decay_intra = jnp.where(causal, jnp.exp(log_gamma[:, None, None] * jnp.where(causal, rel, 0.0)), 0.0)
    q_decay = jnp.exp(log_gamma[:, None] * (idx + 1.0))[:, :, None]
    k_decay = jnp.exp(log_gamma[:, None] * (c - 1.0 - idx))[:, :, None]
    chunk_decay = jnp.exp(log_gamma * c)[:, None, None]

    def step(state, inp):
        qi, ki, vi = (t.astype(jnp.float32) for t in inp)
        scores = jnp.einsum('bhtk,bhsk->bhts', qi, ki) * decay_intra
        o = (jnp.einsum('bhts,bhsv->bhtv', scores, vi)
             + jnp.einsum('bhtk,bhkv->bhtv', qi * q_decay, state))
        state = chunk_decay * state + jnp.einsum('bhsk,bhsv->bhkv', ki * k_decay, vi)
        return state, o

    state0 = jnp.zeros((b, h, dk, dv), jnp.float32)
    _, o = lax.scan(step, state0, (to_chunks(q, c), to_chunks(k, c), to_chunks(v, c)))
    return from_chunks(o).astype(v.dtype)


def spatial_gating(u, v, ln_gain, w_s, b_s):
    b, s, g, dg = v.shape
    c = SGU_CHUNK
    vf = v.astype(jnp.float32)
    mean = jnp.mean(vf, axis=-1, keepdims=True)
    var = jnp.mean(jnp.square(vf - mean), axis=-1, keepdims=True)
    vn = (vf - mean) * lax.rsqrt(var + EPS) * ln_gain.astype(jnp.float32).reshape(g, dg)
    vn = vn.reshape(b, s // c, c, g, dg)
    mask = jnp.tril(jnp.ones((c, c), dtype=bool))
    w = jnp.where(mask[None], w_s.astype(jnp.float32), 0.0)
    sg = jnp.einsum('gts,bnsgc->bntgc', w, vn) + b_s.astype(jnp.float32).T[None, None, :, :, None]
    return (u.astype(jnp.float32) * sg.reshape(b, s, g, dg)).astype(u.dtype)


def gla(q, k, v, log_alpha):
    b, s, h, dk = q.shape
    dv = v.shape[-1]
    c = GLA_CHUNK
    q = q * (dk ** -0.5)
    mask = jnp.tril(jnp.ones((c, c), dtype=bool))[:, :, None]

    def step(state, inp):
        qi, ki, vi, ai = (t.astype(jnp.float32) for t in inp)
        bc = jnp.cumsum(ai, axis=2)
        diff = bc[:, :, :, None, :] - bc[:, :, None, :, :]
        dec = jnp.exp(jnp.where(mask, diff, -jnp.inf))
        scores = jnp.einsum('bhtsk,bhsk->bhts', qi[:, :, :, None, :] * dec, ki)
        o = (jnp.einsum('bhts,bhsv->bhtv', scores, vi)
             + jnp.einsum('bhtk,bhkv->bhtv', qi * jnp.exp(bc), state))
        b_last = bc[:, :, -1:, :]
        state = (jnp.exp(b_last[:, :, 0, :])[..., None] * state
                 + jnp.einsum('bhsk,bhsv->bhkv', ki * jnp.exp(b_last - bc), vi))
        return state, o

    state0 = jnp.zeros((b, h, dk, dv), jnp.float32)
    xs = (to_chunks(q, c), to_chunks(k, c), to_chunks(v, c), to_chunks(log_alpha, c))
    _, o = lax.scan(step, state0, xs)
    return from_chunks(o).astype(v.dtype)


def even_layer(x, positions, norm_g, w_in, sgu_gain, sgu_w_s, sgu_b, w_out):
    b, s, _ = x.shape
    h = rms_norm(x, norm_g)
    proj = h @ w_in
    q, k, v, g_r, u, vs, g_s = split_cols(proj, EVEN_SIZES)
    ret = retention(q.reshape(b, s, RET_HEADS, RET_DK), k.reshape(b, s, RET_HEADS, RET_DK),
                    v.reshape(b, s, RET_HEADS, RET_DV), positions)
    ret = head_norm(ret).reshape(b, s, RET_WIDTH) * jax.nn.silu(g_r)
    sgu = spatial_gating(u.reshape(b, s, SGU_GROUPS, SGU_GDIM), vs.reshape(b, s, SGU_GROUPS, SGU_GDIM),
                         sgu_gain, sgu_w_s, sgu_b)
    sgu = sgu.reshape(b, s, SGU_WIDTH) * jax.nn.silu(g_s)
    mixed = jnp.concatenate([ret, sgu], axis=-1)
    return x + mixed @ w_out


def odd_layer(x, norm_g, w_in, w_lr, b_lr, w_out):
    b, s, _ = x.shape
    h = rms_norm(x, norm_g)
    proj = h @ w_in
    q, k, v, g, lr = split_cols(proj, ODD_SIZES)
    log_alpha = jax.nn.log_sigmoid((lr @ w_lr + b_lr).astype(jnp.float32)) / GLA_TAU
    o = gla(q.reshape(b, s, GLA_HEADS, GLA_DK), k.reshape(b, s, GLA_HEADS, GLA_DK),
            v.reshape(b, s, GLA_HEADS, GLA_DV), log_alpha.reshape(b, s, GLA_HEADS, GLA_DK))
    o = head_norm(o).reshape(b, s, GLA_WIDTH) * jax.nn.silu(g)
    return x + o @ w_out


def setup_inputs(seed: int = 0) -> dict:
    key = jax.random.key(seed)
    ks = jax.random.split(key, 16)
    nrm = jax.random.normal
    f32 = jnp.float32
    x = nrm(ks[0], (BATCH, SEQ, D_MODEL), f32)
    positions = jnp.tile(jnp.arange(SEQ, dtype=jnp.int32)[None, :], (BATCH, 1))
    ev_norm = 1.0 + 0.02 * nrm(ks[1], (N_EVEN, D_MODEL), f32)
    ev_w_in = nrm(ks[2], (N_EVEN, D_MODEL, EVEN_IN), f32) * D_MODEL ** -0.5
    sgu_gain = 1.0 + 0.02 * nrm(ks[3], (N_EVEN, SGU_WIDTH), f32)
    sgu_w_s = nrm(ks[4], (N_EVEN, SGU_GROUPS, SGU_CHUNK, SGU_CHUNK), f32) * SGU_CHUNK ** -0.5
    sgu_b = 1.0 + 0.02 * nrm(ks[5], (N_EVEN, SGU_GROUPS, SGU_CHUNK), f32)
    ev_w_out = nrm(ks[6], (N_EVEN, MIX_WIDTH, D_MODEL), f32) * MIX_WIDTH ** -0.5
    od_norm = 1.0 + 0.02 * nrm(ks[7], (N_ODD, D_MODEL), f32)
    od_w_in = nrm(ks[8], (N_ODD, D_MODEL, ODD_IN), f32) * D_MODEL ** -0.5
    gla_w_lr = nrm(ks[9], (N_ODD, GLA_RANK, GLA_QK_WIDTH), f32) * GLA_RANK ** -0.5
    gla_b_lr = 0.02 * nrm(ks[10], (N_ODD, GLA_QK_WIDTH), f32)
    od_w_out = nrm(ks[11], (N_ODD, MIX_WIDTH, D_MODEL), f32) * MIX_WIDTH ** -0.5
    final_norm = 1.0 + 0.02 * nrm(ks[12], (D_MODEL,), f32)
    return {"x": x, "positions": positions, "ev_norm": ev_norm, "ev_w_in": ev_w_in,
            "sgu_gain": sgu_gain, "sgu_w_s": sgu_w_s, "sgu_b": sgu_b, "ev_w_out": ev_w_out,
            "od_norm": od_norm, "od_w_in": od_w_in, "gla_w_lr": gla_w_lr, "gla_b_lr": gla_b_lr,
            "od_w_out": od_w_out, "final_norm": final_norm}


def reference(x, positions, ev_norm, ev_w_in, sgu_gain, sgu_w_s, sgu_b, ev_w_out,
              od_norm, od_w_in, gla_w_lr, gla_b_lr, od_w_out, final_norm):
    for i in range(DEPTH):
        j = i // 2
        if i % 2 == 0:
            x = even_layer(x, positions, ev_norm[j], ev_w_in[j], sgu_gain[j], sgu_w_s[j],
                           sgu_b[j], ev_w_out[j])
        else:
            x = odd_layer(x, od_norm[j], od_w_in[j], gla_w_lr[j], gla_b_lr[j], od_w_out[j])
    return rms_norm(x, final_norm)
```

```cpp
#include <hip/hip_runtime.h>
#include <hip/hip_cooperative_groups.h>
#include <cstdio>
#include <cstdint>
namespace cg = cooperative_groups;

namespace pg8 {
#define PG8_LAS __attribute__((address_space(3)))
typedef unsigned short bf16_t;
typedef short bf16x8 __attribute__((ext_vector_type(8)));
typedef float f32x4 __attribute__((ext_vector_type(4)));
typedef unsigned u32x4 __attribute__((ext_vector_type(4)));
constexpr int BM = 256, BK = 64, HALF = 128, HTB = HALF * BK * 2, STAGE_BYTES = 8 * HTB, NXCD = 8, WGM = 8;
__host__ __device__ __forceinline__ int lds_byte(int r, int c) { const int st = (r >> 4) * 2 + (c >> 5), rr = r & 15, cc = c & 31, ob = rr * 64 + cc * 2; return st * 1024 + (ob ^ (((ob >> 9) & 1) << 5)); }
__host__ __device__ __forceinline__ void stage_rc(int b, int& R, int& C) { const int st = b / 1024, sb = b % 1024, swz = sb ^ (((sb >> 9) & 1) << 5); R = (st >> 1) * 16 + swz / 64; C = (st & 1) * 32 + (swz % 64) / 2; }
__host__ __device__ __forceinline__ int perm32(int rho) { const int n = rho >> 4, i = rho & 15; return 8 * (i >> 2) + 4 * n + (i & 3); }
struct Unit { int pm, pn; };
struct Gemm { const bf16_t* A; const bf16_t* Bt; int M, N, K, lda; };
struct StaticOrder {
    int nM, nN, nwg, G, c;
    __host__ __device__ void init(int M, int N, int G_, int c_) { nM = M / BM; nN = N / BM; nwg = nM * nN; G = G_; c = c_; }
    __host__ __device__ bool next(int i, Unit& u) const {
        const long L = (long)i * G + c; if (L >= nwg) return false;
        int wgid = (int)L; { const int q = nwg / NXCD, r = nwg % NXCD, xcd = wgid % NXCD, off = wgid / NXCD; wgid = (xcd < r ? xcd * (q + 1) : r * (q + 1) + (xcd - r) * q) + off; }
        const int nig = WGM * nN, gid = wgid / nig, fm = gid * WGM, gsz = (nM - fm) < WGM ? (nM - fm) : WGM;
        u.pm = fm + ((wgid % nig) % gsz); u.pn = (wgid % nig) / gsz; return true;
    }
    __device__ __forceinline__ void a_ready(const Unit&) const {}
    __device__ __forceinline__ void done(const Unit&) const {}
};
typedef float f32x2c __attribute__((ext_vector_type(2)));
typedef __bf16 bf16x2c __attribute__((ext_vector_type(2)));
__device__ __forceinline__ unsigned cvt_pk_bf16(float lo, float hi) { const f32x2c v = {lo, hi}; const bf16x2c b = __builtin_convertvector(v, bf16x2c); return __builtin_bit_cast(unsigned, b); }
struct EpiBf16P {
    static constexpr bool PERM = true, WIDE = false, AFTER_DRAIN = false;
    bf16_t* O; int ldc;
    __device__ __forceinline__ void operator()(const f32x4 (&acc)[2][2][4][2], const Unit& u, int wr, int wc, int fr, int fq) const {
        const int row0 = u.pm * BM + wr * 64 + fr, col0 = u.pn * BM + wc * 32 + 8 * fq;
#pragma unroll
        for (int ai = 0; ai < 2; ++ai)
#pragma unroll
            for (int m = 0; m < 4; ++m) { bf16_t* rowp = O + (size_t)(row0 + ai * HALF + m * 16) * ldc + col0;
#pragma unroll
                for (int bj = 0; bj < 2; ++bj) { const f32x4 v0 = acc[ai][bj][m][0], v1 = acc[ai][bj][m][1];
                    u32x4 w; w.x = cvt_pk_bf16(v0[0], v0[1]); w.y = cvt_pk_bf16(v0[2], v0[3]); w.z = cvt_pk_bf16(v1[0], v1[1]); w.w = cvt_pk_bf16(v1[2], v1[3]);
                    *(u32x4*)(rowp + bj * HALF) = w; } }
    }
};
struct EpiNull {
    static constexpr bool PERM = false, WIDE = false, AFTER_DRAIN = false;
    float* out; int never;
    __device__ __forceinline__ void operator()(const f32x4 (&acc)[2][2][4][2], const Unit& u, int wr, int wc, int fr, int fq) const {
        f32x4 s = {0.f, 0.f, 0.f, 0.f};
#pragma unroll
        for (int ai = 0; ai < 2; ++ai)
#pragma unroll
            for (int bj = 0; bj < 2; ++bj)
#pragma unroll
                for (int m = 0; m < 4; ++m)
#pragma unroll
                    for (int n = 0; n < 2; ++n) s += acc[ai][bj][m][n];
        if (never) *(f32x4*)(out + (size_t)(u.pm * BM + wr * 64 + fr) * 2048 + u.pn * BM + wc * 32 + 4 * fq) = s;
    }
};
struct EpiBf16W {
    static constexpr bool PERM = true, WIDE = true, AFTER_DRAIN = false;
    bf16_t* O; int ldc; PG8_LAS unsigned char* stg;
    __device__ __forceinline__ void operator()(const f32x4 (&acc)[2][2][4][2], const Unit& u, int wr, int wc, int fr, int fq) const {
        PG8_LAS unsigned char* my = stg + (wr * 4 + wc) * 2304;
        const int lane = fq * 16 + fr, rrow = lane >> 3, rc8 = lane & 7;
        bf16_t* obase = O + (size_t)(u.pm * BM + wr * 64 + rrow) * ldc + u.pn * BM + wc * 64 + rc8 * 8;
#pragma unroll
        for (int ai = 0; ai < 2; ++ai)
#pragma unroll
            for (int m = 0; m < 4; ++m) {
                u32x4 w0, w1;
                w0.x = cvt_pk_bf16(acc[ai][0][m][0][0], acc[ai][0][m][0][1]); w0.y = cvt_pk_bf16(acc[ai][0][m][0][2], acc[ai][0][m][0][3]);
                w0.z = cvt_pk_bf16(acc[ai][0][m][1][0], acc[ai][0][m][1][1]); w0.w = cvt_pk_bf16(acc[ai][0][m][1][2], acc[ai][0][m][1][3]);
                w1.x = cvt_pk_bf16(acc[ai][1][m][0][0], acc[ai][1][m][0][1]); w1.y = cvt_pk_bf16(acc[ai][1][m][0][2], acc[ai][1][m][0][3]);
                w1.z = cvt_pk_bf16(acc[ai][1][m][1][0], acc[ai][1][m][1][1]); w1.w = cvt_pk_bf16(acc[ai][1][m][1][2], acc[ai][1][m][1][3]);
                *(PG8_LAS u32x4*)(my + fr * 144 + fq * 32) = w0; *(PG8_LAS u32x4*)(my + fr * 144 + fq * 32 + 16) = w1;
                asm volatile("s_waitcnt lgkmcnt(0)" ::: "memory");
                const u32x4 r0 = *(const PG8_LAS u32x4*)(my + rrow * 144 + rc8 * 16), r1 = *(const PG8_LAS u32x4*)(my + (8 + rrow) * 144 + rc8 * 16);
                asm volatile("s_waitcnt lgkmcnt(0)" ::: "memory");
                bf16_t* op = obase + (size_t)(ai * HALF + m * 16) * ldc;
                __builtin_nontemporal_store(r0, (u32x4*)op); __builtin_nontemporal_store(r1, (u32x4*)(op + (size_t)8 * ldc));
            }
    }
};
struct EpiHot {
    static constexpr bool PERM = true, WIDE = false, AFTER_DRAIN = false;
    bf16_t* O;
    __device__ __forceinline__ void operator()(const f32x4 (&acc)[2][2][4][2], const Unit& u, int wr, int wc, int fr, int fq) const {
        const int row0 = wr * 64 + fr, col0 = wc * 32 + 8 * fq;
#pragma unroll
        for (int ai = 0; ai < 2; ++ai)
#pragma unroll
            for (int m = 0; m < 4; ++m) { bf16_t* rowp = O + (size_t)blockIdx.x * 65536 + (size_t)(row0 + ai * HALF + m * 16) * 256 + col0;
#pragma unroll
                for (int bj = 0; bj < 2; ++bj) { const f32x4 v0 = acc[ai][bj][m][0], v1 = acc[ai][bj][m][1];
                    u32x4 w; w.x = cvt_pk_bf16(v0[0], v0[1]); w.y = cvt_pk_bf16(v0[2], v0[3]); w.z = cvt_pk_bf16(v1[0], v1[1]); w.w = cvt_pk_bf16(v1[2], v1[3]);
                    *(u32x4*)(rowp + bj * HALF) = w; } }
    }
};
struct EpiF32P {
    static constexpr bool PERM = true, WIDE = false, AFTER_DRAIN = false;
    float* out; int ldc;
    __device__ __forceinline__ void operator()(const f32x4 (&acc)[2][2][4][2], const Unit& u, int wr, int wc, int fr, int fq) const {
        const int row0 = u.pm * BM + wr * 64 + fr, col0 = u.pn * BM + wc * 32 + 8 * fq;
#pragma unroll
        for (int ai = 0; ai < 2; ++ai)
#pragma unroll
            for (int m = 0; m < 4; ++m) { float* rowp = out + (size_t)(row0 + ai * HALF + m * 16) * ldc + col0;
#pragma unroll
                for (int bj = 0; bj < 2; ++bj) { *(f32x4*)(rowp + bj * HALF) = acc[ai][bj][m][0]; *(f32x4*)(rowp + bj * HALF + 4) = acc[ai][bj][m][1]; } }
    }
};
template <class Epi, class Sched, bool ALIGN_EPI = false, bool SP2 = false, int NHS = 0>
__device__ __forceinline__ void gemm_phase(PG8_LAS unsigned char* lds, const Gemm g, const Sched& S, const Epi& E, const PG8_LAS float* hs = nullptr) {
    int tid_ = threadIdx.x; asm volatile("" : "+v"(tid_));
    const int tid = tid_, wid = __builtin_amdgcn_readfirstlane(tid >> 6), lane = tid & 63, wr = wid >> 2, wc = wid & 3, fr = lane & 15, fq = lane >> 4;
    const int K = g.K, nt = K / BK;
    unsigned voffA[2], voffB[2];
#pragma unroll
    for (int i = 0; i < 2; ++i) { int R, C; stage_rc(tid * 16 + i * 8192, R, C); const int Rb = Epi::WIDE ? (64 * (R >> 5) + 16 * ((R & 15) >> 2) + 4 * ((R >> 4) & 1) + (R & 3)) : (Epi::PERM ? ((R & ~31) + perm32(R & 31)) : R);
        voffA[i] = (unsigned)(R * g.lda + C) * 2u; voffB[i] = (unsigned)(Rb * K + C) * 2u; }
    const size_t kstep = (size_t)(BK * 2);
    const size_t hstepA = (size_t)HALF * g.lda * 2, hstepB = Epi::WIDE ? (size_t)8 * K * 2 : (size_t)HALF * K * 2;
    const size_t tstepA = 2 * hstepA, tstepB = (size_t)BM * K * 2;
    const unsigned ldsw = (unsigned)wid * 1024u;
    const int aoff = lds_byte(wr * 64 + fr, fq * 8), boff = lds_byte(wc * 32 + fr, fq * 8);
#define PG8_SA(b, h) (((b) * 2 + (h)) * HTB)
#define PG8_SB(b, h) ((4 + (b) * 2 + (h)) * HTB)
#define PG8_STAGE(bufoff, gbase, voff) do { _Pragma("unroll") for (int _i = 0; _i < 2; ++_i) \
        __builtin_amdgcn_global_load_lds((const unsigned*)((const char*)(gbase) + (voff)[_i]), (PG8_LAS unsigned*)(lds + (bufoff) + ldsw + _i * 8192), 16, 0, 0); } while (0)
#define PG8_LDA(dst, b, h) do { _Pragma("unroll") for (int m = 0; m < 4; ++m) _Pragma("unroll") for (int k = 0; k < 2; ++k) dst[m][k] = *(const PG8_LAS bf16x8*)(lds + PG8_SA(b, h) + aoff + m * 2048 + k * 1024); } while (0)
#define PG8_LDB(dst, b, h) do { _Pragma("unroll") for (int n = 0; n < 2; ++n) _Pragma("unroll") for (int k = 0; k < 2; ++k) dst[n][k] = *(const PG8_LAS bf16x8*)(lds + PG8_SB(b, h) + boff + n * 2048 + k * 1024); } while (0)
#define PG8_MMA(ai, bj, At, Bt) do { __builtin_amdgcn_s_setprio(1); _Pragma("unroll") for (int m = 0; m < 4; ++m) _Pragma("unroll") for (int n = 0; n < 2; ++n) _Pragma("unroll") for (int k = 0; k < 2; ++k) \
        acc[ai][bj][m][n] = __builtin_amdgcn_mfma_f32_16x16x32_bf16(Bt[n][k], At[m][k], acc[ai][bj][m][n], 0, 0, 0); __builtin_amdgcn_s_setprio(0); } while (0)
#define PG8_WAIT_V(n) asm volatile("s_waitcnt vmcnt(" #n ")" ::: "memory")
#define PG8_WAIT_L(n) asm volatile("s_waitcnt lgkmcnt(" #n ")" ::: "memory")
#define PG8_BAR __builtin_amdgcn_s_barrier()
#define PG8_SCHED __builtin_amdgcn_sched_barrier(0)
    Unit cur, nxt; int ui = 0;
    if (!S.next(0, cur)) return;
    f32x4 acc[2][2][4][2];
#pragma unroll
    for (int a = 0; a < 2; ++a)
#pragma unroll
        for (int b = 0; b < 2; ++b)
#pragma unroll
            for (int m = 0; m < 4; ++m)
#pragma unroll
                for (int n = 0; n < 2; ++n) acc[a][b][m][n] = (f32x4){0.f, 0.f, 0.f, 0.f};
    bf16x8 At[4][2], B0[2][2], B1[2][2];
    const char* cA = (const char*)g.A + (size_t)cur.pm * tstepA; const char* cB = (const char*)g.Bt + (size_t)cur.pn * tstepB;
    S.a_ready(cur);
    if constexpr (SP2) {
        PG8_STAGE(PG8_SB(0, 0), cB, voffB); PG8_STAGE(PG8_SB(0, 1), cB + hstepB, voffB); PG8_STAGE(PG8_SA(0, 0), cA, voffA); PG8_STAGE(PG8_SA(0, 1), cA + hstepA, voffA);
        if (wr == 1) PG8_BAR;
        PG8_WAIT_V(2); PG8_BAR;
        PG8_STAGE(PG8_SB(1, 0), cB + kstep, voffB); PG8_STAGE(PG8_SA(1, 0), cA + kstep, voffA); PG8_STAGE(PG8_SB(1, 1), cB + hstepB + kstep, voffB);
        PG8_WAIT_V(6); PG8_BAR;
    } else {
        PG8_STAGE(PG8_SB(0, 0), cB, voffB); PG8_STAGE(PG8_SA(0, 0), cA, voffA); PG8_STAGE(PG8_SB(0, 1), cB + hstepB, voffB); PG8_STAGE(PG8_SA(0, 1), cA + hstepA, voffA);
        if (wr == 1) PG8_BAR;
        PG8_WAIT_V(4); PG8_BAR;
        PG8_STAGE(PG8_SB(1, 0), cB + kstep, voffB); PG8_STAGE(PG8_SA(1, 0), cA + kstep, voffA); PG8_STAGE(PG8_SB(1, 1), cB + hstepB + kstep, voffB);
        PG8_WAIT_V(6); PG8_BAR;
    }
    for (;;) {
        const bool has_next = S.next(ui + 1, nxt);
        const char* nA = has_next ? (const char*)g.A + (size_t)nxt.pm * tstepA : cA; const char* nB = has_next ? (const char*)g.Bt + (size_t)nxt.pn * tstepB : cB;
        for (int t = 0; t < nt; t += 2) {
            const bool last = (t == nt - 2);
            const char* a1 = cA + (size_t)(t + 1) * kstep;
            const char* a2 = last ? nA : cA + (size_t)(t + 2) * kstep; const char* b2 = last ? nB : cB + (size_t)(t + 2) * kstep;
            const char* a3 = a2 + kstep; const char* b3 = b2 + kstep;
            if (last && has_next) S.a_ready(nxt);
            if constexpr (SP2) {
            PG8_LDB(B0, 0, 0); PG8_LDB(B1, 0, 1); PG8_SCHED; PG8_LDA(At, 0, 0); PG8_STAGE(PG8_SA(1, 1), a1 + hstepA, voffA);
            PG8_WAIT_V(8); PG8_WAIT_L(0); PG8_BAR; PG8_MMA(0, 0, At, B0); PG8_MMA(0, 1, At, B1); PG8_BAR; PG8_SCHED;
            PG8_LDA(At, 0, 1); PG8_STAGE(PG8_SB(0, 0), b2, voffB); PG8_STAGE(PG8_SB(0, 1), b2 + hstepB, voffB); PG8_STAGE(PG8_SA(0, 0), a2, voffA);
            PG8_WAIT_V(8); PG8_WAIT_L(0); PG8_BAR; PG8_MMA(1, 0, At, B0); PG8_MMA(1, 1, At, B1); PG8_BAR; PG8_SCHED;
            PG8_LDB(B0, 1, 0); PG8_LDB(B1, 1, 1); PG8_SCHED; PG8_LDA(At, 1, 0); PG8_STAGE(PG8_SA(0, 1), a2 + hstepA, voffA);
            PG8_WAIT_V(8); PG8_WAIT_L(0); PG8_BAR; PG8_MMA(0, 0, At, B0); PG8_MMA(0, 1, At, B1); PG8_BAR; PG8_SCHED;
            PG8_LDA(At, 1, 1); PG8_STAGE(PG8_SB(1, 0), b3, voffB); PG8_STAGE(PG8_SB(1, 1), b3 + hstepB, voffB); PG8_STAGE(PG8_SA(1, 0), a3, voffA);
            PG8_WAIT_V(8); PG8_WAIT_L(0); PG8_BAR; PG8_MMA(1, 0, At, B0); PG8_MMA(1, 1, At, B1); PG8_BAR; PG8_SCHED;
            if constexpr (NHS > 0) {
                if (((t + 2) & 7) == 0 && ((t + 2) >> 3) <= NHS) { const PG8_LAS float* tp = hs + (((t + 2) >> 3) - 1) * 256 + wr * 64 + fr;
#pragma unroll
                    for (int ai = 0; ai < 2; ++ai)
#pragma unroll
                        for (int m = 0; m < 4; ++m) { const float f = tp[ai * HALF + m * 16];
#pragma unroll
                            for (int bj = 0; bj < 2; ++bj)
#pragma unroll
                                for (int n = 0; n < 2; ++n) acc[ai][bj][m][n] *= f; }
                    PG8_SCHED; }
            }
            } else {
            PG8_LDB(B0, 0, 0); PG8_SCHED; PG8_LDA(At, 0, 0); PG8_STAGE(PG8_SA(1, 1), a1 + hstepA, voffA);
            PG8_WAIT_L(8); PG8_BAR; PG8_WAIT_L(0); PG8_MMA(0, 0, At, B0); PG8_BAR; PG8_SCHED;
            PG8_LDB(B1, 0, 1); PG8_STAGE(PG8_SB(0, 0), b2, voffB);
            PG8_BAR; PG8_WAIT_L(0); PG8_MMA(0, 1, At, B1); PG8_BAR;
            PG8_LDA(At, 0, 1); PG8_STAGE(PG8_SA(0, 0), a2, voffA);
            PG8_BAR; PG8_WAIT_L(0); PG8_MMA(1, 0, At, B0); PG8_BAR; PG8_SCHED;
            PG8_STAGE(PG8_SB(0, 1), b2 + hstepB, voffB);
            PG8_WAIT_V(6); PG8_BAR; PG8_MMA(1, 1, At, B1); PG8_BAR;
            PG8_LDB(B0, 1, 0); PG8_SCHED; PG8_LDA(At, 1, 0); PG8_STAGE(PG8_SA(0, 1), a2 + hstepA, voffA);
            PG8_WAIT_L(8); PG8_BAR; PG8_WAIT_L(0); PG8_MMA(0, 0, At, B0); PG8_BAR; PG8_SCHED;
            PG8_LDB(B1, 1, 1); PG8_STAGE(PG8_SB(1, 0), b3, voffB);
            PG8_BAR; PG8_WAIT_L(0); PG8_MMA(0, 1, At, B1); PG8_BAR;
            PG8_LDA(At, 1, 1); PG8_STAGE(PG8_SA(1, 0), a3, voffA);
            PG8_BAR; PG8_WAIT_L(0); PG8_MMA(1, 0, At, B0); PG8_BAR; PG8_SCHED;
            PG8_STAGE(PG8_SB(1, 1), b3 + hstepB, voffB);
            PG8_WAIT_V(6); PG8_BAR; PG8_MMA(1, 1, At, B1); PG8_BAR;
            }
        }
        if constexpr (ALIGN_EPI) { if (wr == 0) PG8_BAR; }
        if constexpr (!Epi::AFTER_DRAIN) { E(acc, cur, wr, wc, fr, fq); S.done(cur); }
        if (!has_next) break;
#pragma unroll
        for (int a = 0; a < 2; ++a)
#pragma unroll
            for (int b = 0; b < 2; ++b)
#pragma unroll
                for (int m = 0; m < 4; ++m)
#pragma unroll
                    for (int n = 0; n < 2; ++n) acc[a][b][m][n] = (f32x4){0.f, 0.f, 0.f, 0.f};
        cur = nxt; cA = nA; cB = nB; ++ui;
        if constexpr (ALIGN_EPI) { if (wr == 1) PG8_BAR; }
    }
    PG8_WAIT_V(0);
    if constexpr (!ALIGN_EPI) { if (wr == 0) PG8_BAR; }
    PG8_BAR;
    if constexpr (Epi::AFTER_DRAIN) { E.fused(acc, cur, wr, wc, fr, fq, lds, wid, lane); S.done(cur); }
#undef PG8_SA
#undef PG8_SB
#undef PG8_STAGE
#undef PG8_LDA
#undef PG8_LDB
#undef PG8_MMA
#undef PG8_WAIT_V
#undef PG8_WAIT_L
#undef PG8_BAR
#undef PG8_SCHED
}
}

constexpr int T = 16384, SEQ = 8192, DM = 2048, LD = 12288 + 64;
constexpr int Q0 = 0, K0 = 1024, V0 = 2048, U0 = 4096, VS0 = 6144, GR0 = 8192, GS0 = 10240;
constexpr int Q1 = 0, K1 = 2048, V1 = 4096, G1 = 8192;
constexpr int MIXC = 8192;
constexpr size_t MiB = 1u << 20;
constexpr size_t WS_LR = 1 * MiB, WS_WLRT = 2 * MiB, WS_DEC = 3 * MiB, WS_WA = 8 * MiB, WS_H = 56 * MiB, WS_P = 120 * MiB, WS_END = 512 * MiB;
static_assert(WS_P + (size_t)T * LD * 2 <= WS_END, "d_ws map");
constexpr size_t WS_SC = WS_H, WS_SS = WS_H + 16 * MiB, WS_WO0 = WS_H + 32 * MiB;
constexpr int HS_OFF = 131072 + 8 * 2304 + 256;
constexpr int LDS_BYTES = HS_OFF + 8192;
#ifndef PROBE
#define PROBE 0
#endif

#define LAS __attribute__((address_space(3)))
typedef unsigned short bf16;
typedef short bf16x8 __attribute__((ext_vector_type(8)));
typedef float f32x4 __attribute__((ext_vector_type(4)));
typedef unsigned u32x4 __attribute__((ext_vector_type(4)));
typedef unsigned u32x2 __attribute__((ext_vector_type(2)));
#define LDS_WAIT() asm volatile("s_waitcnt lgkmcnt(0)" ::: "memory")
typedef float f32x2_t __attribute__((ext_vector_type(2)));
typedef __bf16 bf16x2_t __attribute__((ext_vector_type(2)));
__device__ __forceinline__ unsigned pk2(float lo, float hi) { const f32x2_t v = {lo, hi}; const bf16x2_t b = __builtin_convertvector(v, bf16x2_t); return __builtin_bit_cast(unsigned, b); }
__device__ __forceinline__ unsigned f2bf(float f) { return pk2(f, 0.f) & 0xffffu; }
__device__ __forceinline__ float bflo(unsigned w) { return __builtin_bit_cast(float, w << 16); }
__device__ __forceinline__ float bfhi(unsigned w) { return __builtin_bit_cast(float, w & 0xffff0000u); }
__device__ __forceinline__ float bf2f(bf16 b) { return __builtin_bit_cast(float, ((unsigned)b) << 16); }
__device__ __forceinline__ f32x4 mma16(bf16x8 a, bf16x8 b, f32x4 c) { return __builtin_amdgcn_mfma_f32_16x16x32_bf16(a, b, c, 0, 0, 0); }
__device__ __forceinline__ float wave_sum(float v) {
#pragma unroll
    for (int o = 1; o < 64; o <<= 1) v += __shfl_xor(v, o);
    return v;
}
__device__ __forceinline__ float silu(float g) { return g / (1.f + __expf(-g)); }

__device__ __forceinline__ void transpose_item(const float* W, int ldw, int K, bf16* WT, int k0, int n0, int drow0, LAS float* scr, int lane) {
#pragma unroll 8
    for (int i = 0; i < 32; ++i) { const int kk = 2 * i + (lane >> 5); scr[kk * 33 + (lane & 31)] = __builtin_nontemporal_load(W + (size_t)(k0 + kk) * ldw + n0 + (lane & 31)); }
    LDS_WAIT(); asm volatile("" ::: "memory");
    const int c = lane & 7;
#pragma unroll
    for (int j = 0; j < 4; ++j) { const int n = (lane >> 3) + 8 * j; const LAS float* s = scr + (8 * c) * 33 + n;
        u32x4 o; o.x = pk2(s[0 * 33], s[1 * 33]); o.y = pk2(s[2 * 33], s[3 * 33]); o.z = pk2(s[4 * 33], s[5 * 33]); o.w = pk2(s[6 * 33], s[7 * 33]);
        *(u32x4*)(WT + (size_t)(drow0 + n) * K + k0 + 8 * c) = o; }
    LDS_WAIT(); asm volatile("" ::: "memory");
}
__device__ __forceinline__ int perm0(int n) { return n < 4096 ? n : (n < 6144 ? n + 4096 : (n < 10240 ? n - 2048 : n)); }
template <bool PERM> __device__ __forceinline__ void transpose_all(const float* W, int ldw, int K, int N, bf16* WT, LAS float* scr, int gw, int ngw, int lane) {
    const int nblk = N / 32, nitems = (K / 64) * nblk;
    for (int it = gw; it < nitems; it += ngw) { const int kb = it / nblk, nb = it % nblk; const int n0 = nb * 32;
        transpose_item(W, ldw, K, WT, kb * 64, n0, PERM ? perm0(n0) : n0, scr, lane); }
}
__device__ __forceinline__ void rms_row_bf16(const float* xrow, const float* g, bf16* orow, int lane) {
    f32x4 v[8]; float s = 0.f;
#pragma unroll
    for (int j = 0; j < 8; ++j) { v[j] = __builtin_nontemporal_load((const f32x4*)xrow + 64 * j + lane); s += (v[j].x * v[j].x + v[j].y * v[j].y) + (v[j].z * v[j].z + v[j].w * v[j].w); }
    const float r = rsqrtf(wave_sum(s) * (1.f / DM) + 1e-6f);
#pragma unroll
    for (int j = 0; j < 8; ++j) { const f32x4 gg = ((const f32x4*)g)[64 * j + lane]; const f32x4 o = v[j] * r * gg;
        u32x2 w; w.x = pk2(o.x, o.y); w.y = pk2(o.z, o.w); ((u32x2*)orow)[64 * j + lane] = w; }
}
__device__ __forceinline__ void res_rms_row_bf16(const float* xrow, const bf16* acc, const float* g, bf16* orow, int lane) {
    f32x4 v[8]; float s = 0.f;
#pragma unroll
    for (int j = 0; j < 8; ++j) { const u32x2 a = ((const u32x2*)acc)[64 * j + lane]; v[j] = __builtin_nontemporal_load((const f32x4*)xrow + 64 * j + lane) + (f32x4){bflo(a.x), bfhi(a.x), bflo(a.y), bfhi(a.y)};
        s += (v[j].x * v[j].x + v[j].y * v[j].y) + (v[j].z * v[j].z + v[j].w * v[j].w); }
    const float r = rsqrtf(wave_sum(s) * (1.f / DM) + 1e-6f);
#pragma unroll
    for (int j = 0; j < 8; ++j) { const f32x4 gg = ((const f32x4*)g)[64 * j + lane]; const f32x4 o = v[j] * r * gg;
        u32x2 w; w.x = pk2(o.x, o.y); w.y = pk2(o.z, o.w); ((u32x2*)orow)[64 * j + lane] = w; }
}
__device__ __forceinline__ void res_rms_row_f32(const float* xrow, float* io, const bf16* acc2, const float* g, int lane) {
    f32x4 v[8]; float s = 0.f;
#pragma unroll
    for (int j = 0; j < 8; ++j) { const u32x2 a1 = __builtin_nontemporal_load((const u32x2*)io + 64 * j + lane), a2 = __builtin_nontemporal_load((const u32x2*)acc2 + 64 * j + lane);
        v[j] = (__builtin_nontemporal_load((const f32x4*)xrow + 64 * j + lane) + (f32x4){bflo(a1.x), bfhi(a1.x), bflo(a1.y), bfhi(a1.y)}) + (f32x4){bflo(a2.x), bfhi(a2.x), bflo(a2.y), bfhi(a2.y)};
        s += (v[j].x * v[j].x + v[j].y * v[j].y) + (v[j].z * v[j].z + v[j].w * v[j].w); }
    const float r = rsqrtf(wave_sum(s) * (1.f / DM) + 1e-6f);
#pragma unroll
    for (int j = 0; j < 8; ++j) { const f32x4 gg = ((const f32x4*)g)[64 * j + lane]; __builtin_nontemporal_store(v[j] * r * gg, (f32x4*)io + 64 * j + lane); }
}

__device__ __forceinline__ void rms_rows2_bf16(const float* x0, const float* x1, const float* g, bf16* o0, bf16* o1, int lane) {
    f32x4 v[2][8]; float s[2] = {0.f, 0.f};
#pragma unroll
    for (int j = 0; j < 8; ++j) { v[0][j] = __builtin_nontemporal_load((const f32x4*)x0 + 64 * j + lane); v[1][j] = __builtin_nontemporal_load((const f32x4*)x1 + 64 * j + lane); }
#pragma unroll
    for (int q = 0; q < 2; ++q)
#pragma unroll
        for (int j = 0; j < 8; ++j) s[q] += (v[q][j].x * v[q][j].x + v[q][j].y * v[q][j].y) + (v[q][j].z * v[q][j].z + v[q][j].w * v[q][j].w);
    const float r0 = rsqrtf(wave_sum(s[0]) * (1.f / DM) + 1e-6f), r1 = rsqrtf(wave_sum(s[1]) * (1.f / DM) + 1e-6f);
#pragma unroll
    for (int j = 0; j < 8; ++j) { const f32x4 gg = ((const f32x4*)g)[64 * j + lane]; const f32x4 a = v[0][j] * r0 * gg, b = v[1][j] * r1 * gg;
        u32x2 w; w.x = pk2(a.x, a.y); w.y = pk2(a.z, a.w); ((u32x2*)o0)[64 * j + lane] = w; w.x = pk2(b.x, b.y); w.y = pk2(b.z, b.w); ((u32x2*)o1)[64 * j + lane] = w; }
}
__device__ __forceinline__ void res_rms_rows2_bf16(const float* x0, const float* x1, const bf16* a0, const bf16* a1, const float* g, bf16* o0, bf16* o1, int lane) {
    f32x4 v[2][8]; u32x2 c[2][8]; float s[2] = {0.f, 0.f};
#pragma unroll
    for (int j = 0; j < 8; ++j) { v[0][j] = __builtin_nontemporal_load((const f32x4*)x0 + 64 * j + lane); v[1][j] = __builtin_nontemporal_load((const f32x4*)x1 + 64 * j + lane);
        c[0][j] = ((const u32x2*)a0)[64 * j + lane]; c[1][j] = ((const u32x2*)a1)[64 * j + lane]; }
#pragma unroll
    for (int q = 0; q < 2; ++q)
#pragma unroll
        for (int j = 0; j < 8; ++j) { v[q][j] += (f32x4){bflo(c[q][j].x), bfhi(c[q][j].x), bflo(c[q][j].y), bfhi(c[q][j].y)};
            s[q] += (v[q][j].x * v[q][j].x + v[q][j].y * v[q][j].y) + (v[q][j].z * v[q][j].z + v[q][j].w * v[q][j].w); }
    const float r0 = rsqrtf(wave_sum(s[0]) * (1.f / DM) + 1e-6f), r1 = rsqrtf(wave_sum(s[1]) * (1.f / DM) + 1e-6f);
#pragma unroll
    for (int j = 0; j < 8; ++j) { const f32x4 gg = ((const f32x4*)g)[64 * j + lane]; const f32x4 a = v[0][j] * r0 * gg, b = v[1][j] * r1 * gg;
        u32x2 w; w.x = pk2(a.x, a.y); w.y = pk2(a.z, a.w); ((u32x2*)o0)[64 * j + lane] = w; w.x = pk2(b.x, b.y); w.y = pk2(b.z, b.w); ((u32x2*)o1)[64 * j + lane] = w; }
}
__device__ __forceinline__ void res_rms_rows2_f32(const float* x0, const float* x1, float* io0, float* io1, const bf16* b0, const bf16* b1, const float* g, int lane) {
    f32x4 v[2][8]; u32x2 c[2][8], d[2][8]; float s[2] = {0.f, 0.f};
#pragma unroll
    for (int j = 0; j < 8; ++j) { v[0][j] = __builtin_nontemporal_load((const f32x4*)x0 + 64 * j + lane); v[1][j] = __builtin_nontemporal_load((const f32x4*)x1 + 64 * j + lane);
        c[0][j] = __builtin_nontemporal_load((const u32x2*)io0 + 64 * j + lane); c[1][j] = __builtin_nontemporal_load((const u32x2*)io1 + 64 * j + lane);
        d[0][j] = __builtin_nontemporal_load((const u32x2*)b0 + 64 * j + lane); d[1][j] = __builtin_nontemporal_load((const u32x2*)b1 + 64 * j + lane); }
#pragma unroll
    for (int q = 0; q < 2; ++q)
#pragma unroll
        for (int j = 0; j < 8; ++j) { v[q][j] = (v[q][j] + (f32x4){bflo(c[q][j].x), bfhi(c[q][j].x), bflo(c[q][j].y), bfhi(c[q][j].y)}) + (f32x4){bflo(d[q][j].x), bfhi(d[q][j].x), bflo(d[q][j].y), bfhi(d[q][j].y)};
            s[q] += (v[q][j].x * v[q][j].x + v[q][j].y * v[q][j].y) + (v[q][j].z * v[q][j].z + v[q][j].w * v[q][j].w); }
    const float r0 = rsqrtf(wave_sum(s[0]) * (1.f / DM) + 1e-6f), r1 = rsqrtf(wave_sum(s[1]) * (1.f / DM) + 1e-6f);
#pragma unroll
    for (int j = 0; j < 8; ++j) { const f32x4 gg = ((const f32x4*)g)[64 * j + lane];
        __builtin_nontemporal_store(v[0][j] * r0 * gg, (f32x4*)io0 + 64 * j + lane); __builtin_nontemporal_store(v[1][j] * r1 * gg, (f32x4*)io1 + 64 * j + lane); }
}

template <bool DRY> __device__ __forceinline__ void retpre_unit(LAS unsigned char* lds, bf16* Pb, const int* pos, bf16* SC, float* DEC, int u, int tid, int never) {
    const int h = u & 3, n = (u >> 2) & 127, b = u >> 9;
    const int r0 = b * SEQ + n * 64;
    LAS bf16* Qs = (LAS bf16*)lds; LAS bf16* Ks = Qs + 64 * 264;
    const float lg2 = __log2f(1.f - exp2f(-5.f - (float)h));
    const int wv = tid >> 6, lane = tid & 63, l15 = lane & 15, quad = lane >> 4;
    for (int it = tid; it < 1024; it += 512) {
        const int t = it >> 4, j8 = it & 15;
        const float p = (float)pos[r0 + t];
        const bf16* qr = Pb + (size_t)(r0 + t) * LD + Q0 + h * 256 + j8 * 8;
        const bf16* kr = Pb + (size_t)(r0 + t) * LD + K0 + h * 256 + j8 * 8;
        const u32x4 q1 = *(const u32x4*)qr, q2 = *(const u32x4*)(qr + 128), k1 = *(const u32x4*)kr, k2 = *(const u32x4*)(kr + 128);
        u32x4 oq1, oq2, ok1, ok2;
#pragma unroll
        for (int e2 = 0; e2 < 4; ++e2) {
            float cs[2], sn[2];
#pragma unroll
            for (int z = 0; z < 2; ++z) { const float j = (float)(j8 * 8 + e2 * 2 + z);
                const float cj = exp2f(j * -0.10381025296523008f) * 0.15915494309189535f;
                const float hi = p * cj, lo = fmaf(p, cj, -hi); const float fr = (hi - floorf(hi)) + lo;
                sn[z] = __builtin_amdgcn_sinf(fr); cs[z] = __builtin_amdgcn_cosf(fr); }
            const float a0 = bflo(q1[e2]), a1 = bfhi(q1[e2]), b0 = bflo(q2[e2]), b1 = bfhi(q2[e2]);
            oq1[e2] = pk2((a0 * cs[0] - b0 * sn[0]) * 0.0625f, (a1 * cs[1] - b1 * sn[1]) * 0.0625f);
            oq2[e2] = pk2((a0 * sn[0] + b0 * cs[0]) * 0.0625f, (a1 * sn[1] + b1 * cs[1]) * 0.0625f);
            const float c0 = bflo(k1[e2]), c1 = bfhi(k1[e2]), d0 = bflo(k2[e2]), d1 = bfhi(k2[e2]);
            ok1[e2] = pk2(c0 * cs[0] - d0 * sn[0], c1 * cs[1] - d1 * sn[1]);
            ok2[e2] = pk2(c0 * sn[0] + d0 * cs[0], c1 * sn[1] + d1 * cs[1]);
        }
        *(LAS u32x4*)(Qs + t * 264 + j8 * 8) = oq1; *(LAS u32x4*)(Qs + t * 264 + 128 + j8 * 8) = oq2;
        *(LAS u32x4*)(Ks + t * 264 + j8 * 8) = ok1; *(LAS u32x4*)(Ks + t * 264 + 128 + j8 * 8) = ok2;
    }
    __syncthreads();
#pragma unroll
    for (int tl = 0; tl < 2; ++tl) { const int tile = 2 * wv + tl, ti = tile >> 2, si = tile & 3; const int t = ti * 16 + l15;
        u32x2 w; w.x = 0u; w.y = 0u;
        if (si <= ti) { f32x4 acc = {0.f, 0.f, 0.f, 0.f};
#pragma unroll
            for (int kk = 0; kk < 8; ++kk) { const bf16x8 qf = *(const LAS bf16x8*)(Qs + t * 264 + kk * 32 + quad * 8); const bf16x8 kf = *(const LAS bf16x8*)(Ks + (si * 16 + l15) * 264 + kk * 32 + quad * 8); acc = mma16(kf, qf, acc); }
            float v[4];
#pragma unroll
            for (int e = 0; e < 4; ++e) { const int s_ = si * 16 + quad * 4 + e; v[e] = (s_ <= t) ? acc[e] * exp2f((float)(t - s_) * lg2) : 0.f; }
            w.x = pk2(v[0], v[1]); w.y = pk2(v[2], v[3]); }
        if (!DRY || never) *(u32x2*)(SC + (size_t)u * 4096 + ((ti * 2 + (si >> 1)) * 64 + ((si & 1) * 2 + (quad >> 1)) * 16 + l15) * 8 + (quad & 1) * 4) = w; }
    for (int it = tid; it < 2048; it += 512) {
        const int fb = it >> 6, L = it & 63, tt = fb >> 3, kk = fb & 7, fl = L & 15, fq = L >> 4; const int t = tt * 16 + fl;
        const u32x4 v = *(const LAS u32x4*)(Qs + t * 264 + kk * 32 + fq * 8); const float f = exp2f((float)(t + 1) * lg2);
        u32x4 o;
#pragma unroll
        for (int e = 0; e < 4; ++e) o[e] = pk2(bflo(v[e]) * f, bfhi(v[e]) * f);
        if (!DRY || never) *(u32x4*)(Pb + (size_t)(r0 + 2 * fb + (L >> 5)) * LD + Q0 + h * 256 + (L & 31) * 8) = o;
    }
    for (int it = tid; it < 2048; it += 512) {
        const int fb = it >> 6, L = it & 63, kt = fb >> 1, kk = fb & 1, fl = L & 15, fq = L >> 4; const int k = kt * 16 + fl;
        u32x4 o;
#pragma unroll
        for (int e2 = 0; e2 < 4; ++e2) { const int s_ = kk * 32 + fq * 8 + e2 * 2;
            o[e2] = pk2(bf2f(Ks[s_ * 264 + k]) * exp2f((float)(63 - s_) * lg2), bf2f(Ks[(s_ + 1) * 264 + k]) * exp2f((float)(62 - s_) * lg2)); }
        if (!DRY || never) *(u32x4*)(Pb + (size_t)(r0 + 2 * fb + (L >> 5)) * LD + K0 + h * 256 + (L & 31) * 8) = o;
    }
    if ((!DRY || never) && tid < 256) DEC[(size_t)u * 256 + tid] = exp2f(64.f * lg2);
    __syncthreads();
}

template <bool DRY> __device__ __forceinline__ void sgu_unit(LAS unsigned char* lds, bf16* Pb, const float* gain, const float* w_s, const float* b_s, int u, int tid, int never) {
    const int g = u & 7, n = (u >> 3) & 63, b = u >> 9;
    const int r0 = b * SEQ + n * 128;
    LAS bf16* VnT = (LAS bf16*)lds;
    LAS bf16* Ws = VnT + 256 * 136;
    const int wv = tid >> 6, lane = tid & 63, l15 = lane & 15, quad = lane >> 4;
    for (int it = tid; it < 4096; it += 512) {
        const int t = it >> 5, s4 = (it & 31) * 4;
        const f32x4 w = *(const f32x4*)(w_s + (size_t)g * 16384 + t * 128 + s4);
        u32x2 o; o.x = pk2(s4 <= t ? w.x : 0.f, s4 + 1 <= t ? w.y : 0.f); o.y = pk2(s4 + 2 <= t ? w.z : 0.f, s4 + 3 <= t ? w.w : 0.f);
        *(LAS u32x2*)(Ws + t * 136 + s4) = o;
    }
    {
        const int row = tid >> 2, part = tid & 3;
        const bf16* src = Pb + (size_t)(r0 + row) * LD + VS0 + g * 256 + part * 64;
        u32x4 x[8]; float s = 0.f, s2 = 0.f;
#pragma unroll
        for (int j = 0; j < 8; ++j) { x[j] = *(const u32x4*)(src + j * 8);
#pragma unroll
            for (int e = 0; e < 4; ++e) { const float a = bflo(x[j][e]), c = bfhi(x[j][e]); s += a + c; s2 += a * a + c * c; } }
        s += __shfl_xor(s, 1); s2 += __shfl_xor(s2, 1); s += __shfl_xor(s, 2); s2 += __shfl_xor(s2, 2);
        const float mean = s * (1.f / 256.f); const float var = fmaxf(s2 * (1.f / 256.f) - mean * mean, 0.f); const float rstd = rsqrtf(var + 1e-6f);
        const float* gp = gain + g * 256 + part * 64;
#pragma unroll
        for (int j = 0; j < 8; ++j)
#pragma unroll
            for (int e = 0; e < 4; ++e) { const int c = part * 64 + j * 8 + e * 2;
                VnT[c * 136 + row] = (bf16)f2bf((bflo(x[j][e]) - mean) * rstd * gp[j * 8 + e * 2]);
                VnT[(c + 1) * 136 + row] = (bf16)f2bf((bfhi(x[j][e]) - mean) * rstd * gp[j * 8 + e * 2 + 1]); }
    }
    __syncthreads();
    {
        const int t = wv * 16 + l15; const int nk = (wv >> 1) + 1;
        bf16x8 wf[4];
#pragma unroll
        for (int kk = 0; kk < 4; ++kk) wf[kk] = *(const LAS bf16x8*)(Ws + t * 136 + kk * 32 + quad * 8);
        const float bias = b_s[g * 128 + t];
        bf16* rowp = Pb + (size_t)(r0 + t) * LD + g * 256 + quad * 4;
        for (int ci = 0; ci < 16; ++ci) {
            f32x4 acc = {0.f, 0.f, 0.f, 0.f};
#pragma unroll
            for (int kk = 0; kk < 4; ++kk) if (kk < nk) { const bf16x8 vf = *(const LAS bf16x8*)(VnT + (ci * 16 + l15) * 136 + kk * 32 + quad * 8); acc = mma16(vf, wf[kk], acc); }
            const u32x2 uu = *(const u32x2*)(rowp + U0 + ci * 16), gs = *(const u32x2*)(rowp + GS0 + ci * 16);
            u32x2 o;
            o.x = pk2(bflo(uu.x) * (acc[0] + bias) * silu(bflo(gs.x)), bfhi(uu.x) * (acc[1] + bias) * silu(bfhi(gs.x)));
            o.y = pk2(bflo(uu.y) * (acc[2] + bias) * silu(bflo(gs.y)), bfhi(uu.y) * (acc[3] + bias) * silu(bfhi(gs.y)));
            if (!DRY || never) *(u32x2*)(rowp + GS0 + ci * 16) = o;
        }
    }
    __syncthreads();
}

#define LBAR() do { asm volatile("s_waitcnt lgkmcnt(0)" ::: "memory"); __builtin_amdgcn_s_barrier(); asm volatile("" ::: "memory"); } while (0)
template <int NH, int QOFF, int KOFF, int VOFF, int GOFF, bool DRY>
__device__ __forceinline__ void scan_worker(LAS unsigned char* lds, bf16* Pb, const bf16* SC, const float* DEC, float* SS, int wk, int tid, int never) {
    constexpr int C = 64, NC = SEQ / C, VTS = C + 8, STS = 264;
    constexpr int ST_ELEMS = 32 * STS, VT_ELEMS = 32 * VTS;
    const int w = __builtin_amdgcn_readfirstlane(tid >> 6), lane = tid & 63, l15 = lane & 15, quad = lane >> 4;
    const int bh = wk >> 4, sl = wk & 15, b = bh / NH, h = bh % NH;
    LAS bf16* ST = (LAS bf16*)lds;
    LAS bf16* VT = ST + 2 * ST_ELEMS;
    LAS float* DC = (LAS float*)(VT + 2 * VT_ELEMS);
    const int vcol = VOFF + h * 512 + sl * 32;
    const int wq = w & 3;
    for (int i = tid; i < ST_ELEMS / 2; i += 512) ((LAS unsigned*)ST)[i] = 0u;
    if (w < 4) {
        const int vs_s = tid >> 2, vs_p = tid & 3;
        const unsigned offQ = (unsigned)((wq * 16 + (lane >> 5)) * LD + QOFF + h * 256 + (lane & 31) * 8), offP = (unsigned)(wq * 1024 + lane * 8);
        const unsigned offV = (unsigned)(vs_s * LD + vcol + vs_p * 8);
        const unsigned offO = (unsigned)((wq * 16 + l15) * LD + (vcol - VOFF + GOFF) + quad * 4), offS = (unsigned)(((wq * 16 + l15) * NH + h) * 32 + sl * 2);
        bf16x8 frA[10], frB[10], frC[10]; u32x4 vrA, vrB, vrC; u32x2 g0A, g1A, g0B, g1B, g0C, g1C;
#define O_LOAD(S, nn) do { const bf16* cb_ = Pb + (size_t)(b * SEQ + (nn) * C) * LD; const bf16* sb_ = SC + (size_t)((b * NC + (nn)) * NH + h) * (C * C); \
            _Pragma("unroll") for (int kk = 0; kk < 8; ++kk) { const bf16* ck_ = cb_ + kk * 2 * LD; fr##S[kk] = *(const bf16x8*)(ck_ + offQ); } \
            _Pragma("unroll") for (int kk = 0; kk < 2; ++kk) fr##S[8 + kk] = *(const bf16x8*)(sb_ + offP + kk * 512); \
            vr##S = *(const u32x4*)(cb_ + offV); g0##S = *(const u32x2*)(cb_ + offO); g1##S = *(const u32x2*)(cb_ + offO + 16); } while (0)
#define O_VT_WRITE(S, VTp) do { _Pragma("unroll") for (int e = 0; e < 4; ++e) { (VTp)[(vs_p * 8 + 2 * e) * VTS + vs_s] = (bf16)(vr##S[e] & 0xffffu); (VTp)[(vs_p * 8 + 2 * e + 1) * VTS + vs_s] = (bf16)(vr##S[e] >> 16); } } while (0)
#define O_STEP(S, SN, SL, n_) do { const int n = (n_); const int buf = n & 1; const int r0 = b * SEQ + n * C; \
            LAS bf16* STb = ST + buf * ST_ELEMS; LAS bf16* VTb = VT + buf * VT_ELEMS; LAS bf16* VTn = VT + (buf ^ 1) * VT_ELEMS; \
            LBAR(); \
            { const int nn_ = (n + 2 < NC) ? n + 2 : NC - 1; O_LOAD(SL, nn_); } \
            f32x4 o0 = {0.f, 0.f, 0.f, 0.f}, o1 = {0.f, 0.f, 0.f, 0.f}; \
            _Pragma("unroll") for (int kk = 0; kk < 8; ++kk) { const bf16x8 s0 = *(const LAS bf16x8*)(STb + l15 * STS + kk * 32 + quad * 8); const bf16x8 s1 = *(const LAS bf16x8*)(STb + (16 + l15) * STS + kk * 32 + quad * 8); \
                o0 = mma16(s0, fr##S[kk], o0); o1 = mma16(s1, fr##S[kk], o1); } \
            _Pragma("unroll") for (int kk = 0; kk < 2; ++kk) { const bf16x8 v0 = *(const LAS bf16x8*)(VTb + l15 * VTS + kk * 32 + quad * 8); const bf16x8 v1 = *(const LAS bf16x8*)(VTb + (16 + l15) * VTS + kk * 32 + quad * 8); \
                o0 = mma16(v0, fr##S[8 + kk], o0); o1 = mma16(v1, fr##S[8 + kk], o1); } \
            u32x2 p0, p1; p0.x = pk2(o0[0] * silu(bflo(g0##S.x)), o0[1] * silu(bfhi(g0##S.x))); p0.y = pk2(o0[2] * silu(bflo(g0##S.y)), o0[3] * silu(bfhi(g0##S.y))); \
            p1.x = pk2(o1[0] * silu(bflo(g1##S.x)), o1[1] * silu(bfhi(g1##S.x))); p1.y = pk2(o1[2] * silu(bflo(g1##S.y)), o1[3] * silu(bfhi(g1##S.y))); \
            bf16* op = Pb + (size_t)r0 * LD + offO; \
            if (!DRY || never) { *(u32x2*)op = p0; *(u32x2*)(op + 16) = p1; } \
            float ss0 = (o0[0] * o0[0] + o0[1] * o0[1]) + (o0[2] * o0[2] + o0[3] * o0[3]), ss1 = (o1[0] * o1[0] + o1[1] * o1[1]) + (o1[2] * o1[2] + o1[3] * o1[3]); \
            ss0 += __shfl_xor(ss0, 16); ss1 += __shfl_xor(ss1, 16); ss0 += __shfl_xor(ss0, 32); ss1 += __shfl_xor(ss1, 32); \
            if ((!DRY || never) && quad == 0) { float* sp = SS + (size_t)r0 * NH * 32 + offS; sp[0] = ss0; sp[1] = ss1; } \
            O_VT_WRITE(SN, VTn); } while (0)
        O_LOAD(A, 0); O_LOAD(B, 1);
        O_VT_WRITE(A, VT);
        for (int n0 = 0; n0 < NC; n0 += 3) {
            O_STEP(A, B, C, n0);
            if (n0 + 1 < NC) O_STEP(B, C, A, n0 + 1);
            if (n0 + 2 < NC) O_STEP(C, A, B, n0 + 2);
        }
#undef O_LOAD
#undef O_VT_WRITE
#undef O_STEP
    } else {
        const unsigned offK = (unsigned)((wq * 16 + (lane >> 5)) * LD + KOFF + h * 256 + (lane & 31) * 8);
        const unsigned offD = (unsigned)(lane * 4);
        const bool dw = (w == 4);
        f32x4 sacc[4][2];
#pragma unroll
        for (int a = 0; a < 4; ++a)
#pragma unroll
            for (int v = 0; v < 2; ++v) sacc[a][v] = (f32x4){0.f, 0.f, 0.f, 0.f};
        bf16x8 frA[8], frB[8], frC[8]; u32x4 vrA = {0u, 0u, 0u, 0u}, vrB = vrA, vrC = vrA;
#define S_LOAD(S, nn) do { const bf16* cb_ = Pb + (size_t)(b * SEQ + (nn) * C) * LD; \
            _Pragma("unroll") for (int a = 0; a < 4; ++a) _Pragma("unroll") for (int kk = 0; kk < 2; ++kk) { const bf16* ca_ = cb_ + (a * 4 + kk * 2) * LD; fr##S[a * 2 + kk] = *(const bf16x8*)(ca_ + offK); } \
            if (dw) vr##S = *(const u32x4*)(DEC + (size_t)((b * NC + (nn)) * NH + h) * 256 + offD); } while (0)
#define S_STEP(S, SN, SL, n_) do { const int n = (n_); const int buf = n & 1; \
            LAS bf16* VTb = VT + buf * VT_ELEMS; LAS bf16* STn = ST + (buf ^ 1) * ST_ELEMS; LAS float* DCb = DC + buf * 256; \
            LBAR(); \
            { const int nn_ = (n + 2 < NC) ? n + 2 : NC - 1; S_LOAD(SL, nn_); } \
            bf16x8 vf[2][2]; \
            _Pragma("unroll") for (int v = 0; v < 2; ++v) _Pragma("unroll") for (int kk = 0; kk < 2; ++kk) vf[v][kk] = *(const LAS bf16x8*)(VTb + (v * 16 + l15) * VTS + kk * 32 + quad * 8); \
            _Pragma("unroll") for (int a = 0; a < 4; ++a) { const f32x4 dc4 = *(const LAS f32x4*)(DCb + (wq * 4 + a) * 16 + quad * 4); \
                _Pragma("unroll") for (int v = 0; v < 2; ++v) { \
                    f32x4 s_ = sacc[a][v] * dc4; \
                    _Pragma("unroll") for (int kk = 0; kk < 2; ++kk) s_ = mma16(fr##S[a * 2 + kk], vf[v][kk], s_); \
                    sacc[a][v] = s_; u32x2 o_; o_.x = pk2(s_[0], s_[1]); o_.y = pk2(s_[2], s_[3]); \
                    *(LAS u32x2*)(STn + (v * 16 + l15) * STS + (wq * 4 + a) * 16 + quad * 4) = o_; } } \
            if (dw) *(LAS u32x4*)(DC + (buf ^ 1) * 256 + lane * 4) = vr##SN; } while (0)
        S_LOAD(A, 0); S_LOAD(B, 1);
        if (dw) *(LAS u32x4*)(DC + lane * 4) = vrA;
        for (int n0 = 0; n0 < NC; n0 += 3) {
            S_STEP(A, B, C, n0);
            if (n0 + 1 < NC) S_STEP(B, C, A, n0 + 1);
            if (n0 + 2 < NC) S_STEP(C, A, B, n0 + 2);
        }
#undef S_LOAD
#undef S_STEP
    }
    asm volatile("s_waitcnt vmcnt(0)" ::: "memory");
    __syncthreads();
}

template <int NH, int GOFF, bool DRY>
__device__ __forceinline__ void fin_phase(bf16* Pb, const float* SS, int gw, int ngw, int lane, int never) {
    for (int item = gw; item < T * NH; item += ngw) {
        const int tok = item / NH, h = item % NH;
        float s = (lane < 32) ? __builtin_nontemporal_load(SS + (size_t)item * 32 + lane) : 0.f; s = wave_sum(s);
        const float rstd = rsqrtf(s * (1.f / 512.f) + 1e-6f);
        bf16* rowp = Pb + (size_t)tok * LD + GOFF + h * 512 + lane * 8;
        const u32x4 o = *(const u32x4*)rowp;
        u32x4 r;
#pragma unroll
        for (int e = 0; e < 4; ++e) r[e] = pk2(bflo(o[e]) * rstd, bfhi(o[e]) * rstd);
        if (!DRY || never) *(u32x4*)rowp = r;
    }
}

__device__ __forceinline__ void lr_phase(const bf16* H, const bf16* WLRT, float* LR, int gw, int ngw, int lane) {
    const int l15 = lane & 15, quad = lane >> 4;
    for (int tile = gw; tile < T / 16; tile += ngw) {
        f32x4 acc = {0.f, 0.f, 0.f, 0.f};
        const bf16* ap = H + (size_t)(tile * 16 + l15) * DM + quad * 8; const bf16* bp = WLRT + (size_t)l15 * DM + quad * 8;
#pragma unroll 8
        for (int kk = 0; kk < 64; ++kk) acc = mma16(*(const bf16x8*)(ap + kk * 32), *(const bf16x8*)(bp + kk * 32), acc);
#pragma unroll
        for (int e = 0; e < 4; ++e) LR[(size_t)(tile * 16 + quad * 4 + e) * 16 + l15] = acc[e];
    }
}

template <bool DRY> __device__ __forceinline__ void glapre_unit(LAS unsigned char* lds, bf16* Pb, const float* LR, const float* w_lr, const float* b_lr, bf16* SC, float* DEC, int u, int tid, int never) {
    const int h = u & 7, n = (u >> 3) & 127, b = u >> 10;
    const int r0 = b * SEQ + n * 64;
    LAS bf16* Qs = (LAS bf16*)lds; LAS bf16* Ks = Qs + 64 * 264;
    LAS float* lrs = (LAS float*)(lds + 2 * 64 * 264 * 2); LAS float* tot = lrs + 1024;
    const int c = tid & 255, half = tid >> 8;
    const int wv = tid >> 6, lane = tid & 63, l15 = lane & 15, quad = lane >> 4;
    if (tid < 256) ((LAS f32x4*)lrs)[tid] = ((const f32x4*)(LR + (size_t)r0 * 16))[tid];
    float wl[16];
#pragma unroll
    for (int r = 0; r < 16; ++r) wl[r] = w_lr[r * 2048 + h * 256 + c];
    const float bb = b_lr[h * 256 + c];
    __syncthreads();
    float bc[32]; float run = 0.f;
#pragma unroll
    for (int i = 0; i < 32; ++i) { const int t = half * 32 + i; float z = bb;
#pragma unroll
        for (int r4 = 0; r4 < 4; ++r4) { const f32x4 l = ((const LAS f32x4*)lrs)[t * 4 + r4]; z += (l.x * wl[4 * r4] + l.y * wl[4 * r4 + 1]) + (l.z * wl[4 * r4 + 2] + l.w * wl[4 * r4 + 3]); }
        const float a = -(fmaxf(-z, 0.f) + __logf(1.f + __expf(-fabsf(z)))) * 0.0625f;
        run += a; bc[i] = run; }
    tot[half * 256 + c] = run;
    __syncthreads();
    const float t0 = tot[c], t1 = tot[256 + c]; const float blast = t0 + t1, off = half ? t0 : 0.f; const float eb = __expf(blast);
    LAS float* ebs = tot + 512;
    const bf16* gq = Pb + (size_t)(r0 + half * 32) * LD + h * 256 + c;
#pragma unroll
    for (int i = 0; i < 32; ++i) { const int t = half * 32 + i; const float bcv = bc[i] + off;
        const float q = bf2f(gq[(size_t)i * LD + Q1]), k = bf2f(gq[(size_t)i * LD + K1]);
        const float e = __expf(bcv), ei = __expf(-bcv);
        Qs[t * 264 + c] = (bf16)f2bf(q * 0.0625f * e); Ks[t * 264 + c] = (bf16)f2bf(k * ei); }
    if (half == 0) { ebs[c] = eb; if (!DRY || never) DEC[(size_t)u * 256 + c] = eb; }
    __syncthreads();
    for (int it = tid; it < 2048; it += 512) {
        const int fb = it >> 6, L = it & 63, tt = fb >> 3, kk = fb & 7, fl = L & 15, fq = L >> 4;
        const u32x4 v = *(const LAS u32x4*)(Qs + (tt * 16 + fl) * 264 + kk * 32 + fq * 8);
        if (!DRY || never) *(u32x4*)(Pb + (size_t)(r0 + 2 * fb + (L >> 5)) * LD + Q1 + h * 256 + (L & 31) * 8) = v;
    }
    for (int it = tid; it < 2048; it += 512) {
        const int fb = it >> 6, L = it & 63, kt = fb >> 1, kk = fb & 1, fl = L & 15, fq = L >> 4; const int k = kt * 16 + fl; const float ek = ebs[k];
        u32x4 o;
#pragma unroll
        for (int e2 = 0; e2 < 4; ++e2) { const int s_ = kk * 32 + fq * 8 + e2 * 2; o[e2] = pk2(bf2f(Ks[s_ * 264 + k]) * ek, bf2f(Ks[(s_ + 1) * 264 + k]) * ek); }
        if (!DRY || never) *(u32x4*)(Pb + (size_t)(r0 + 2 * fb + (L >> 5)) * LD + K1 + h * 256 + (L & 31) * 8) = o;
    }
#pragma unroll
    for (int tl = 0; tl < 2; ++tl) { const int tile = 2 * wv + tl, ti = tile >> 2, si = tile & 3; const int t = ti * 16 + l15;
        u32x2 w; w.x = 0u; w.y = 0u;
        if (si <= ti) { f32x4 acc = {0.f, 0.f, 0.f, 0.f};
#pragma unroll
            for (int kk = 0; kk < 8; ++kk) { const bf16x8 qf = *(const LAS bf16x8*)(Qs + t * 264 + kk * 32 + quad * 8); const bf16x8 kf = *(const LAS bf16x8*)(Ks + (si * 16 + l15) * 264 + kk * 32 + quad * 8); acc = mma16(kf, qf, acc); }
            float v[4];
#pragma unroll
            for (int e = 0; e < 4; ++e) { const int s = si * 16 + quad * 4 + e; v[e] = (s <= t) ? acc[e] : 0.f; }
            w.x = pk2(v[0], v[1]); w.y = pk2(v[2], v[3]); }
        if (!DRY || never) *(u32x2*)(SC + (size_t)u * 4096 + ((ti * 2 + (si >> 1)) * 64 + ((si & 1) * 2 + (quad >> 1)) * 16 + l15) * 8 + (quad & 1) * 4) = w; }
    __syncthreads();
}

#define RLX_AGENT __ATOMIC_RELAXED, __HIP_MEMORY_SCOPE_AGENT
#define XB_TMO      128
#define XB_XCNT(j)  (256  + 64 * (j))
#define XB_XSUB(j)  (1280 + 64 * (j))
#define XB_XGEN(j)  (2304 + 64 * (j))
#define XB_TOP      3328
#define XB_TOPGEN   3392
#define XCD_BAR_WORDS 3456
#define XB_SPIN_CAP (1u << 18)

__device__ __forceinline__ unsigned xb_ld(unsigned* p)              { return __hip_atomic_load(p, __ATOMIC_RELAXED, __HIP_MEMORY_SCOPE_AGENT); }
__device__ __forceinline__ unsigned xb_add(unsigned* p, unsigned v) { return __hip_atomic_fetch_add(p, v, __ATOMIC_RELAXED, __HIP_MEMORY_SCOPE_AGENT); }
__device__ __forceinline__ unsigned xb_xcc_id() { return (unsigned)__builtin_amdgcn_s_getreg((3 << 11) | 20) & 0xFu; }
#define XB_SPIN(cond, bar) do { unsigned _sp = 0; while (cond) { __builtin_amdgcn_s_sleep(1); \
    if ((++_sp & 255u) == 0u) { if (xb_ld(&(bar)[XB_TMO])) break; if (_sp > XB_SPIN_CAP) { atomicAdd(&(bar)[XB_TMO], 1u); break; } } } } while (0)

struct XcdBarrier {
    unsigned* bar; unsigned x;
    volatile LAS unsigned* st;
};

__device__ __forceinline__ XcdBarrier xcd_barrier_post(unsigned* bar, volatile LAS unsigned* st) {
    XcdBarrier b; b.bar = bar; b.x = xb_xcc_id(); b.st = st;
    if (threadIdx.x == 0) (void)xb_add(&bar[XB_XCNT(b.x)], 1u);
    return b;
}
__device__ __forceinline__ void xcd_barrier_complete(unsigned* bar, unsigned x, unsigned& nloc, unsigned& nx) {
    const unsigned G = gridDim.x * gridDim.y * gridDim.z;
    unsigned sum, cnt, mine, sp = 0u;
    for (;;) {
        sum = 0u; cnt = 0u; mine = 0u;
#pragma unroll
        for (unsigned j = 0; j < 16; ++j) { const unsigned c = xb_ld(&bar[XB_XCNT(j)]); sum += c; cnt += (c > 0u) ? 1u : 0u; mine = (j == x) ? c : mine; }
        if (sum == G) break;
        __builtin_amdgcn_s_sleep(1);
        if ((++sp & 255u) == 0u) { if (xb_ld(&bar[XB_TMO])) break; if (sp > XB_SPIN_CAP) { atomicAdd(&bar[XB_TMO], 1u); break; } }
    }
    nloc = mine > 0u ? mine : 1u; nx = cnt > 0u ? cnt : 1u;
}

__device__ __forceinline__ void xcd_barrier(const XcdBarrier& b) {
    asm volatile("s_waitcnt vmcnt(0)" ::: "memory");
    __syncthreads();
    if (threadIdx.x == 0) {
        unsigned* bar = b.bar;
        __builtin_amdgcn_s_waitcnt(0);
        unsigned nloc = b.st[0], nx = b.st[1];
        if (nloc == 0u) { xcd_barrier_complete(bar, b.x, nloc, nx); b.st[0] = nloc; b.st[1] = nx; }
        const unsigned old = xb_add(&bar[XB_XSUB(b.x)], 1u);
        const unsigned gen = old / nloc;
        if (old + 1u == (gen + 1u) * nloc) {
            __builtin_amdgcn_fence(__ATOMIC_RELEASE, "agent");
            asm volatile("s_waitcnt vmcnt(0)" ::: "memory");
            const unsigned og = xb_add(&bar[XB_TOP], 1u);
            const unsigned tg = og / nx;
            if (og + 1u == (tg + 1u) * nx) xb_add(&bar[XB_TOPGEN], 1u);
            else XB_SPIN(xb_ld(&bar[XB_TOPGEN]) == tg, bar);
            __builtin_amdgcn_fence(__ATOMIC_ACQUIRE, "agent");
            xb_add(&bar[XB_XGEN(b.x)], 1u);
            asm volatile("s_waitcnt vmcnt(0)" ::: "memory");
        } else {
            XB_SPIN(xb_ld(&bar[XB_XGEN(b.x)]) == gen, bar);
            __builtin_amdgcn_fence(__ATOMIC_ACQUIRE, "agent");
            asm volatile("s_waitcnt vmcnt(0)" ::: "memory");
        }
    }
    __syncthreads();
}

template <int NH>
__device__ __forceinline__ void build_hs_table(LAS float* tab, const float* SS, int pm, int tid) {
    for (int it = tid; it < 256 * NH; it += 512) { const int row = it / NH, h = it % NH;
        const f32x4* sp = (const f32x4*)(SS + ((size_t)(pm * 256 + row) * NH + h) * 32);
        float s = 0.f;
#pragma unroll
        for (int i = 0; i < 8; ++i) { const f32x4 v = sp[i]; s += (v.x + v.y) + (v.z + v.w); }
        tab[h * 256 + row] = rsqrtf(s * (1.f / 512.f) + 1e-6f); }
    __syncthreads();
    float f[NH / 2];
#pragma unroll
    for (int k = 0; k < NH / 2; ++k) { const int it = tid + 512 * k, j = it >> 8, row = it & 255; f[k] = (j < NH - 1) ? tab[j * 256 + row] / tab[(j + 1) * 256 + row] : tab[j * 256 + row]; }
    __syncthreads();
#pragma unroll
    for (int k = 0; k < NH / 2; ++k) tab[tid + 512 * k] = f[k];
    __syncthreads();
}

struct Args { const float* x; const int* pos; const float* ev_norm; const float* ev_w_in; const float* sgu_gain; const float* sgu_w_s; const float* sgu_b; const float* ev_w_out;
              const float* od_norm; const float* od_w_in; const float* gla_w_lr; const float* gla_b_lr; const float* od_w_out; const float* final_norm; float* out; unsigned char* ws; int never; int pad; };

__global__ void __launch_bounds__(512, 2) trunk_fwd(Args a) {
    extern __shared__ __attribute__((aligned(16))) unsigned char lds_raw[];
    LAS unsigned char* lds = (LAS unsigned char*)lds_raw;
    cg::grid_group grid = cg::this_grid();
    volatile LAS unsigned* xbst = (volatile LAS unsigned*)(lds + 131072 + 8 * 2304);
    if (threadIdx.x < 2) xbst[threadIdx.x] = 0u;
    __syncthreads();
    XcdBarrier xbar = xcd_barrier_post((unsigned*)a.ws, xbst);
    const int G = gridDim.x, bid = blockIdx.x, ngw = G * 8;
#define PH_BEGIN int t_ = threadIdx.x; asm volatile("" : "+v"(t_)); const int tid = t_, lane = tid & 63, wave = __builtin_amdgcn_readfirstlane(tid >> 6), gw = bid * 8 + wave; LAS float* scr = (LAS float*)(lds + wave * 16384); (void)lane; (void)gw; (void)scr;
    unsigned char* ws = a.ws;
    float* LR = (float*)(ws + WS_LR); bf16* WLRT = (bf16*)(ws + WS_WLRT); float* DEC = (float*)(ws + WS_DEC);
    bf16* WA = (bf16*)(ws + WS_WA); bf16* H = (bf16*)(ws + WS_H); bf16* Pb = (bf16*)(ws + WS_P);
    bf16* SC = (bf16*)(ws + WS_SC); float* SS = (float*)(ws + WS_SS); bf16* WO0 = (bf16*)(ws + WS_WO0);

    { PH_BEGIN
    for (int rep = 0; rep < 1 + ((PROBE >> 11) & 1); ++rep) {
    transpose_all<true>(a.ev_w_in, 12288, 2048, 12288, WA, scr, gw, ngw, lane);
    { int m = gw; for (; m + ngw < T; m += 2 * ngw) rms_rows2_bf16(a.x + (size_t)m * DM, a.x + (size_t)(m + ngw) * DM, a.ev_norm, H + (size_t)m * DM, H + (size_t)(m + ngw) * DM, lane);
      if (m < T) rms_row_bf16(a.x + (size_t)m * DM, a.ev_norm, H + (size_t)m * DM, lane); }
    }
    }
    grid.sync();
    { PH_BEGIN
    if ((PROBE >> 15) & 1) { pg8::Gemm g{H, WA, T, 12288, 2048, 2048}; pg8::StaticOrder S; S.init(T, 12288, G, bid); pg8::EpiHot E{(bf16*)a.out};
      pg8::gemm_phase<pg8::EpiHot, pg8::StaticOrder, true, true>(lds, g, S, E); }
    for (int rep = 0; rep < 1 + ((PROBE >> 1) & 1); ++rep)
    { pg8::Gemm g{H, WA, T, 12288, 2048, 2048}; pg8::StaticOrder S; S.init(T, 12288, G, bid); pg8::EpiBf16W E{Pb, LD, lds + 131072};
      pg8::gemm_phase<pg8::EpiBf16W, pg8::StaticOrder, true, true>(lds, g, S, E); }
    }
    xcd_barrier(xbar);
    { PH_BEGIN
    if ((PROBE >> 2) & 1) for (int u = bid; u < 1024; u += G) retpre_unit<true>(lds, Pb, a.pos, SC, DEC, u, tid, a.never);
    for (int u = bid; u < 1024; u += G) retpre_unit<false>(lds, Pb, a.pos, SC, DEC, u, tid, a.never);
    }
    xcd_barrier(xbar);
    { PH_BEGIN
    for (int v = bid; v < 256; v += G) { const int xcd = v & 7, idx = v >> 3;
        if (idx < 16) { const int wk = xcd * 16 + idx;
            if ((PROBE >> 4) & 1) scan_worker<4, Q0, K0, V0, GR0, true>(lds, Pb, SC, DEC, SS, wk, tid, a.never);
            scan_worker<4, Q0, K0, V0, GR0, false>(lds, Pb, SC, DEC, SS, wk, tid, a.never);
        } else { const int hi = (idx - 16) * 8 + xcd;
            if ((PROBE >> 3) & 1) for (int u = hi; u < 1024; u += 128) sgu_unit<true>(lds, Pb, a.sgu_gain, a.sgu_w_s, a.sgu_b, u, tid, a.never);
            for (int u = hi; u < 1024; u += 128) sgu_unit<false>(lds, Pb, a.sgu_gain, a.sgu_w_s, a.sgu_b, u, tid, a.never);
            transpose_all<false>(a.ev_w_out, 2048, 4096, 2048, WO0, scr, hi * 8 + wave, 128 * 8, lane);
            transpose_all<false>(a.od_w_in, 12304, 2048, 12288, WA, scr, hi * 8 + wave, 128 * 8, lane);
        } }
    }
    xcd_barrier(xbar);
    if (G != 256) {
    { PH_BEGIN
    if ((PROBE >> 5) & 1) fin_phase<4, GR0, true>(Pb, SS, gw, ngw, lane, a.never);
    fin_phase<4, GR0, false>(Pb, SS, gw, ngw, lane, a.never);
    }
    xcd_barrier(xbar);
    }
    { PH_BEGIN
    { pg8::Gemm g{Pb + MIXC, WO0, T, 2048, 4096, LD}; pg8::StaticOrder S; S.init(T, 2048, G, bid); pg8::EpiBf16W E{(bf16*)a.out, 2 * DM, lds + 131072};
      if (G == 256) { pg8::Unit u0; S.next(0, u0); LAS float* tab = (LAS float*)(lds + HS_OFF); build_hs_table<4>(tab, SS, u0.pm, tid);
        pg8::gemm_phase<pg8::EpiBf16W, pg8::StaticOrder, true, true, 4>(lds, g, S, E, tab); }
      else pg8::gemm_phase<pg8::EpiBf16W, pg8::StaticOrder, true, true>(lds, g, S, E); }
    }
    xcd_barrier(xbar);
    { PH_BEGIN
    { int m = gw; for (; m + ngw < T; m += 2 * ngw) res_rms_rows2_bf16(a.x + (size_t)m * DM, a.x + (size_t)(m + ngw) * DM, (const bf16*)a.out + (size_t)m * 2 * DM, (const bf16*)a.out + (size_t)(m + ngw) * 2 * DM, a.od_norm, H + (size_t)m * DM, H + (size_t)(m + ngw) * DM, lane);
      if (m < T) res_rms_row_bf16(a.x + (size_t)m * DM, (const bf16*)a.out + (size_t)m * 2 * DM, a.od_norm, H + (size_t)m * DM, lane); }
    for (int i = bid * 512 + tid; i < 16 * 2048; i += G * 512) { const int r = i >> 11, k = i & 2047; WLRT[i] = (bf16)f2bf(a.od_w_in[(size_t)k * 12304 + 12288 + r]); }
    }
    xcd_barrier(xbar);
    { PH_BEGIN
    lr_phase(H, WLRT, LR, gw, ngw, lane);
    { pg8::Gemm g{H, WA, T, 12288, 2048, 2048}; pg8::StaticOrder S; S.init(T, 12288, G, bid); pg8::EpiBf16W E{Pb, LD, lds + 131072};
      pg8::gemm_phase<pg8::EpiBf16W, pg8::StaticOrder, true, true>(lds, g, S, E); }
    }
    xcd_barrier(xbar);
    { PH_BEGIN
    if ((PROBE >> 8) & 1) for (int u = bid; u < 2048; u += G) glapre_unit<true>(lds, Pb, LR, a.gla_w_lr, a.gla_b_lr, SC, DEC, u, tid, a.never);
    for (int u = bid; u < 2048; u += G) glapre_unit<false>(lds, Pb, LR, a.gla_w_lr, a.gla_b_lr, SC, DEC, u, tid, a.never);
    transpose_all<false>(a.od_w_out, 2048, 4096, 2048, WA, scr, gw, ngw, lane);
    }
    xcd_barrier(xbar);
    { PH_BEGIN
    for (int v = bid; v < 256; v += G) { const int xcd = v & 7, idx = v >> 3; const int wk = (xcd * 2 + (idx >> 4)) * 16 + (idx & 15);
        if ((PROBE >> 9) & 1) scan_worker<8, Q1, K1, V1, G1, true>(lds, Pb, SC, DEC, SS, wk, tid, a.never);
        scan_worker<8, Q1, K1, V1, G1, false>(lds, Pb, SC, DEC, SS, wk, tid, a.never); }
    }
    xcd_barrier(xbar);
    if (G != 256) {
    { PH_BEGIN
    if ((PROBE >> 10) & 1) fin_phase<8, G1, true>(Pb, SS, gw, ngw, lane, a.never);
    fin_phase<8, G1, false>(Pb, SS, gw, ngw, lane, a.never);
    }
    xcd_barrier(xbar);
    }
    { PH_BEGIN
    { pg8::Gemm g{Pb + MIXC, WA, T, 2048, 4096, LD}; pg8::StaticOrder S; S.init(T, 2048, G, bid); pg8::EpiBf16W E{Pb, LD, lds + 131072};
      if (G == 256) { pg8::Unit u0; S.next(0, u0); LAS float* tab = (LAS float*)(lds + HS_OFF); build_hs_table<8>(tab, SS, u0.pm, tid);
        pg8::gemm_phase<pg8::EpiBf16W, pg8::StaticOrder, true, true, 8>(lds, g, S, E, tab); }
      else pg8::gemm_phase<pg8::EpiBf16W, pg8::StaticOrder, true, true>(lds, g, S, E); }
    }
    xcd_barrier(xbar);
    if ((PROBE >> 12) & 1) { for (int rep = 0; rep < 12; ++rep) xcd_barrier(xbar); }
    { PH_BEGIN
    { int m = gw; for (; m + ngw < T; m += 2 * ngw) res_rms_rows2_f32(a.x + (size_t)m * DM, a.x + (size_t)(m + ngw) * DM, a.out + (size_t)m * DM, a.out + (size_t)(m + ngw) * DM, Pb + (size_t)m * LD, Pb + (size_t)(m + ngw) * LD, a.final_norm, lane);
      if (m < T) res_rms_row_f32(a.x + (size_t)m * DM, a.out + (size_t)m * DM, Pb + (size_t)m * LD, a.final_norm, lane); }
    }
}

extern "C" void kernel_launch(void* const* d_in, const int* in_sizes, int n_in, void* d_out, int out_size, void* d_ws, size_t ws_size, hipStream_t stream) {
    static int grid = 0;
    if (grid == 0) {
        if (n_in != 14 || out_size != T * DM || ws_size < WS_END) { fprintf(stderr, "kernel_launch: unexpected shapes (n_in %d out %d ws %zu)\n", n_in, out_size, ws_size); grid = -1; return; }
        int dev = 0, cus = 0, per_cu = 0;
        (void)hipGetDevice(&dev);
        (void)hipDeviceGetAttribute(&cus, hipDeviceAttributeMultiprocessorCount, dev);
        (void)hipFuncSetAttribute((const void*)trunk_fwd, hipFuncAttributeMaxDynamicSharedMemorySize, LDS_BYTES);
        (void)hipOccupancyMaxActiveBlocksPerMultiprocessor(&per_cu, (const void*)trunk_fwd, 512, LDS_BYTES);
        if (per_cu < 1) per_cu = 1;
        grid = cus * per_cu;
    }
    if (grid < 0) return;
    (void)hipMemsetAsync(d_ws, 0, 16384, stream);
    Args a{};
    a.x = (const float*)d_in[0]; a.pos = (const int*)d_in[1]; a.ev_norm = (const float*)d_in[2]; a.ev_w_in = (const float*)d_in[3]; a.sgu_gain = (const float*)d_in[4];
    a.sgu_w_s = (const float*)d_in[5]; a.sgu_b = (const float*)d_in[6]; a.ev_w_out = (const float*)d_in[7]; a.od_norm = (const float*)d_in[8]; a.od_w_in = (const float*)d_in[9];
    a.gla_w_lr = (const float*)d_in[10]; a.gla_b_lr = (const float*)d_in[11]; a.od_w_out = (const float*)d_in[12]; a.final_norm = (const float*)d_in[13];
    a.out = (float*)d_out; a.ws = (unsigned char*)d_ws;
    void* args[] = {&a};
    hipError_t e = hipLaunchCooperativeKernel((void*)trunk_fwd, dim3(grid), dim3(512), args, LDS_BYTES, stream);
    if (e != hipSuccess) fprintf(stderr, "kernel_launch: cooperative launch failed: %s (grid %d)\n", hipGetErrorString(e), grid);
}
```

```cpp
#include <hip/hip_runtime.h>
#include <hip/hip_cooperative_groups.h>
#include <cstdio>
#include <cstdint>
namespace cg = cooperative_groups;

namespace pg8 {
#define PG8_LAS __attribute__((address_space(3)))
typedef unsigned short bf16_t;
typedef short bf16x8 __attribute__((ext_vector_type(8)));
typedef float f32x4 __attribute__((ext_vector_type(4)));
typedef unsigned u32x4 __attribute__((ext_vector_type(4)));
constexpr int BM = 256, BK = 64, HALF = 128, HTB = HALF * BK * 2, STAGE_BYTES = 8 * HTB, NXCD = 8, WGM = 8;
__host__ __device__ __forceinline__ int lds_byte(int r, int c) { const int st = (r >> 4) * 2 + (c >> 5), rr = r & 15, cc = c & 31, ob = rr * 64 + cc * 2; return st * 1024 + (ob ^ (((ob >> 9) & 1) << 5)); }
__host__ __device__ __forceinline__ void stage_rc(int b, int& R, int& C) { const int st = b / 1024, sb = b % 1024, swz = sb ^ (((sb >> 9) & 1) << 5); R = (st >> 1) * 16 + swz / 64; C = (st & 1) * 32 + (swz % 64) / 2; }
__host__ __device__ __forceinline__ int perm32(int rho) { const int n = rho >> 4, i = rho & 15; return 8 * (i >> 2) + 4 * n + (i & 3); }
struct Unit { int pm, pn; };
struct Gemm { const bf16_t* A; const bf16_t* Bt; int M, N, K, lda; };
struct StaticOrder {
    int nM, nN, nwg, G, c;
    __host__ __device__ void init(int M, int N, int G_, int c_) { nM = M / BM; nN = N / BM; nwg = nM * nN; G = G_; c = c_; }
    __host__ __device__ bool next(int i, Unit& u) const {
        const long L = (long)i * G + c; if (L >= nwg) return false;
        int wgid = (int)L; { const int q = nwg / NXCD, r = nwg % NXCD, xcd = wgid % NXCD, off = wgid / NXCD; wgid = (xcd < r ? xcd * (q + 1) : r * (q + 1) + (xcd - r) * q) + off; }
        const int nig = WGM * nN, gid = wgid / nig, fm = gid * WGM, gsz = (nM - fm) < WGM ? (nM - fm) : WGM;
        u.pm = fm + ((wgid % nig) % gsz); u.pn = (wgid % nig) / gsz; return true;
    }
    __device__ __forceinline__ void a_ready(const Unit&) const {}
    __device__ __forceinline__ void done(const Unit&) const {}
};
typedef float f32x2c __attribute__((ext_vector_type(2)));
typedef __bf16 bf16x2c __attribute__((ext_vector_type(2)));
__device__ __forceinline__ unsigned cvt_pk_bf16(float lo, float hi) { const f32x2c v = {lo, hi}; const bf16x2c b = __builtin_convertvector(v, bf16x2c); return __builtin_bit_cast(unsigned, b); }
struct EpiBf16P {
    static constexpr bool PERM = true, WIDE = false, AFTER_DRAIN = false;
    bf16_t* O; int ldc;
    __device__ __forceinline__ void operator()(const f32x4 (&acc)[2][2][4][2], const Unit& u, int wr, int wc, int fr, int fq) const {
        const int row0 = u.pm * BM + wr * 64 + fr, col0 = u.pn * BM + wc * 32 + 8 * fq;
#pragma unroll
        for (int ai = 0; ai < 2; ++ai)
#pragma unroll
            for (int m = 0; m < 4; ++m) { bf16_t* rowp = O + (size_t)(row0 + ai * HALF + m * 16) * ldc + col0;
#pragma unroll
                for (int bj = 0; bj < 2; ++bj) { const f32x4 v0 = acc[ai][bj][m][0], v1 = acc[ai][bj][m][1];
                    u32x4 w; w.x = cvt_pk_bf16(v0[0], v0[1]); w.y = cvt_pk_bf16(v0[2], v0[3]); w.z = cvt_pk_bf16(v1[0], v1[1]); w.w = cvt_pk_bf16(v1[2], v1[3]);
                    *(u32x4*)(rowp + bj * HALF) = w; } }
    }
};
struct EpiNull {
    static constexpr bool PERM = false, WIDE = false, AFTER_DRAIN = false;
    float* out; int never;
    __device__ __forceinline__ void operator()(const f32x4 (&acc)[2][2][4][2], const Unit& u, int wr, int wc, int fr, int fq) const {
        f32x4 s = {0.f, 0.f, 0.f, 0.f};
#pragma unroll
        for (int ai = 0; ai < 2; ++ai)
#pragma unroll
            for (int bj = 0; bj < 2; ++bj)
#pragma unroll
                for (int m = 0; m < 4; ++m)
#pragma unroll
                    for (int n = 0; n < 2; ++n) s += acc[ai][bj][m][n];
        if (never) *(f32x4*)(out + (size_t)(u.pm * BM + wr * 64 + fr) * 2048 + u.pn * BM + wc * 32 + 4 * fq) = s;
    }
};
struct EpiBf16W {
    static constexpr bool PERM = true, WIDE = true, AFTER_DRAIN = false;
    bf16_t* O; int ldc; PG8_LAS unsigned char* stg;
    __device__ __forceinline__ void operator()(const f32x4 (&acc)[2][2][4][2], const Unit& u, int wr, int wc, int fr, int fq) const {
        PG8_LAS unsigned char* my = stg + (wr * 4 + wc) * 2304;
        const int lane = fq * 16 + fr, rrow = lane >> 3, rc8 = lane & 7;
        bf16_t* obase = O + (size_t)(u.pm * BM + wr * 64 + rrow) * ldc + u.pn * BM + wc * 64 + rc8 * 8;
#pragma unroll
        for (int ai = 0; ai < 2; ++ai)
#pragma unroll
            for (int m = 0; m < 4; ++m) {
                u32x4 w0, w1;
                w0.x = cvt_pk_bf16(acc[ai][0][m][0][0], acc[ai][0][m][0][1]); w0.y = cvt_pk_bf16(acc[ai][0][m][0][2], acc[ai][0][m][0][3]);
                w0.z = cvt_pk_bf16(acc[ai][0][m][1][0], acc[ai][0][m][1][1]); w0.w = cvt_pk_bf16(acc[ai][0][m][1][2], acc[ai][0][m][1][3]);
                w1.x = cvt_pk_bf16(acc[ai][1][m][0][0], acc[ai][1][m][0][1]); w1.y = cvt_pk_bf16(acc[ai][1][m][0][2], acc[ai][1][m][0][3]);
                w1.z = cvt_pk_bf16(acc[ai][1][m][1][0], acc[ai][1][m][1][1]); w1.w = cvt_pk_bf16(acc[ai][1][m][1][2], acc[ai][1][m][1][3]);
                *(PG8_LAS u32x4*)(my + fr * 144 + fq * 32) = w0; *(PG8_LAS u32x4*)(my + fr * 144 + fq * 32 + 16) = w1;
                asm volatile("" ::: "memory");
                const u32x4 r0 = *(const PG8_LAS u32x4*)(my + rrow * 144 + rc8 * 16), r1 = *(const PG8_LAS u32x4*)(my + (8 + rrow) * 144 + rc8 * 16);
                asm volatile("" ::: "memory");
                bf16_t* op = obase + (size_t)(ai * HALF + m * 16) * ldc;
                __builtin_nontemporal_store(r0, (u32x4*)op); __builtin_nontemporal_store(r1, (u32x4*)(op + (size_t)8 * ldc));
            }
    }
};
struct EpiHot {
    static constexpr bool PERM = true, WIDE = false, AFTER_DRAIN = false;
    bf16_t* O;
    __device__ __forceinline__ void operator()(const f32x4 (&acc)[2][2][4][2], const Unit& u, int wr, int wc, int fr, int fq) const {
        const int row0 = wr * 64 + fr, col0 = wc * 32 + 8 * fq;
#pragma unroll
        for (int ai = 0; ai < 2; ++ai)
#pragma unroll
            for (int m = 0; m < 4; ++m) { bf16_t* rowp = O + (size_t)blockIdx.x * 65536 + (size_t)(row0 + ai * HALF + m * 16) * 256 + col0;
#pragma unroll
                for (int bj = 0; bj < 2; ++bj) { const f32x4 v0 = acc[ai][bj][m][0], v1 = acc[ai][bj][m][1];
                    u32x4 w; w.x = cvt_pk_bf16(v0[0], v0[1]); w.y = cvt_pk_bf16(v0[2], v0[3]); w.z = cvt_pk_bf16(v1[0], v1[1]); w.w = cvt_pk_bf16(v1[2], v1[3]);
                    *(u32x4*)(rowp + bj * HALF) = w; } }
    }
};
struct EpiF32P {
    static constexpr bool PERM = true, WIDE = false, AFTER_DRAIN = false;
    float* out; int ldc;
    __device__ __forceinline__ void operator()(const f32x4 (&acc)[2][2][4][2], const Unit& u, int wr, int wc, int fr, int fq) const {
        const int row0 = u.pm * BM + wr * 64 + fr, col0 = u.pn * BM + wc * 32 + 8 * fq;
#pragma unroll
        for (int ai = 0; ai < 2; ++ai)
#pragma unroll
            for (int m = 0; m < 4; ++m) { float* rowp = out + (size_t)(row0 + ai * HALF + m * 16) * ldc + col0;
#pragma unroll
                for (int bj = 0; bj < 2; ++bj) { *(f32x4*)(rowp + bj * HALF) = acc[ai][bj][m][0]; *(f32x4*)(rowp + bj * HALF + 4) = acc[ai][bj][m][1]; } }
    }
};
template <class Epi, class Sched, bool ALIGN_EPI = false, bool SP2 = false, int NHS = 0>
__device__ __forceinline__ void gemm_phase(PG8_LAS unsigned char* lds, const Gemm g, const Sched& S, const Epi& E, const PG8_LAS float* hs = nullptr) {
    int tid_ = threadIdx.x; asm volatile("" : "+v"(tid_));
    const int tid = tid_, wid = __builtin_amdgcn_readfirstlane(tid >> 6), lane = tid & 63, wr = wid >> 2, wc = wid & 3, fr = lane & 15, fq = lane >> 4;
    const int K = g.K, nt = K / BK;
    unsigned voffA[2], voffB[2];
#pragma unroll
    for (int i = 0; i < 2; ++i) { int R, C; stage_rc(tid * 16 + i * 8192, R, C); const int Rb = Epi::WIDE ? (64 * (R >> 5) + 16 * ((R & 15) >> 2) + 4 * ((R >> 4) & 1) + (R & 3)) : (Epi::PERM ? ((R & ~31) + perm32(R & 31)) : R);
        voffA[i] = (unsigned)(R * g.lda + C) * 2u; voffB[i] = (unsigned)(Rb * K + C) * 2u; }
    const size_t kstep = (size_t)(BK * 2);
    const size_t hstepA = (size_t)HALF * g.lda * 2, hstepB = Epi::WIDE ? (size_t)8 * K * 2 : (size_t)HALF * K * 2;
    const size_t tstepA = 2 * hstepA, tstepB = (size_t)BM * K * 2;
    const unsigned ldsw = (unsigned)wid * 1024u;
    const int aoff = lds_byte(wr * 64 + fr, fq * 8), boff = lds_byte(wc * 32 + fr, fq * 8);
#define PG8_SA(b, h) (((b) * 2 + (h)) * HTB)
#define PG8_SB(b, h) ((4 + (b) * 2 + (h)) * HTB)
#define PG8_STAGE(bufoff, gbase, voff) do { _Pragma("unroll") for (int _i = 0; _i < 2; ++_i) \
        __builtin_amdgcn_global_load_lds((const unsigned*)((const char*)(gbase) + (voff)[_i]), (PG8_LAS unsigned*)(lds + (bufoff) + ldsw + _i * 8192), 16, 0, 0); } while (0)
#define PG8_LDA(dst, b, h) do { _Pragma("unroll") for (int m = 0; m < 4; ++m) _Pragma("unroll") for (int k = 0; k < 2; ++k) dst[m][k] = *(const PG8_LAS bf16x8*)(lds + PG8_SA(b, h) + aoff + m * 2048 + k * 1024); } while (0)
#define PG8_LDB(dst, b, h) do { _Pragma("unroll") for (int n = 0; n < 2; ++n) _Pragma("unroll") for (int k = 0; k < 2; ++k) dst[n][k] = *(const PG8_LAS bf16x8*)(lds + PG8_SB(b, h) + boff + n * 2048 + k * 1024); } while (0)
#define PG8_MMA(ai, bj, At, Bt) do { __builtin_amdgcn_s_setprio(1); _Pragma("unroll") for (int m = 0; m < 4; ++m) _Pragma("unroll") for (int n = 0; n < 2; ++n) _Pragma("unroll") for (int k = 0; k < 2; ++k) \
        acc[ai][bj][m][n] = __builtin_amdgcn_mfma_f32_16x16x32_bf16(Bt[n][k], At[m][k], acc[ai][bj][m][n], 0, 0, 0); __builtin_amdgcn_s_setprio(0); } while (0)
#define PG8_WAIT_V(n) asm volatile("s_waitcnt vmcnt(" #n ")" ::: "memory")
#define PG8_WAIT_L(n) asm volatile("s_waitcnt lgkmcnt(" #n ")" ::: "memory")
#define PG8_BAR __builtin_amdgcn_s_barrier()
#define PG8_SCHED __builtin_amdgcn_sched_barrier(0)
    Unit cur, nxt; int ui = 0;
    if (!S.next(0, cur)) return;
    f32x4 acc[2][2][4][2];
#pragma unroll
    for (int a = 0; a < 2; ++a)
#pragma unroll
        for (int b = 0; b < 2; ++b)
#pragma unroll
            for (int m = 0; m < 4; ++m)
#pragma unroll
                for (int n = 0; n < 2; ++n) acc[a][b][m][n] = (f32x4){0.f, 0.f, 0.f, 0.f};
    bf16x8 At[4][2], B0[2][2], B1[2][2];
    const char* cA = (const char*)g.A + (size_t)cur.pm * tstepA; const char* cB = (const char*)g.Bt + (size_t)cur.pn * tstepB;
    S.a_ready(cur);
    if constexpr (SP2) {
        PG8_STAGE(PG8_SB(0, 0), cB, voffB); PG8_STAGE(PG8_SB(0, 1), cB + hstepB, voffB); PG8_STAGE(PG8_SA(0, 0), cA, voffA); PG8_STAGE(PG8_SA(0, 1), cA + hstepA, voffA);
        if (wr == 1) PG8_BAR;
        PG8_WAIT_V(2); PG8_BAR;
        PG8_STAGE(PG8_SB(1, 0), cB + kstep, voffB); PG8_STAGE(PG8_SA(1, 0), cA + kstep, voffA); PG8_STAGE(PG8_SB(1, 1), cB + hstepB + kstep, voffB);
        PG8_WAIT_V(6); PG8_BAR;
    } else {
        PG8_STAGE(PG8_SB(0, 0), cB, voffB); PG8_STAGE(PG8_SA(0, 0), cA, voffA); PG8_STAGE(PG8_SB(0, 1), cB + hstepB, voffB); PG8_STAGE(PG8_SA(0, 1), cA + hstepA, voffA);
        if (wr == 1) PG8_BAR;
        PG8_WAIT_V(4); PG8_BAR;
        PG8_STAGE(PG8_SB(1, 0), cB + kstep, voffB); PG8_STAGE(PG8_SA(1, 0), cA + kstep, voffA); PG8_STAGE(PG8_SB(1, 1), cB + hstepB + kstep, voffB);
        PG8_WAIT_V(6); PG8_BAR;
    }
    for (;;) {
        const bool has_next = S.next(ui + 1, nxt);
        const char* nA = has_next ? (const char*)g.A + (size_t)nxt.pm * tstepA : cA; const char* nB = has_next ? (const char*)g.Bt + (size_t)nxt.pn * tstepB : cB;
        for (int t = 0; t < nt; t += 2) {
            const bool last = (t == nt - 2);
            const char* a1 = cA + (size_t)(t + 1) * kstep;
            const char* a2 = last ? nA : cA + (size_t)(t + 2) * kstep; const char* b2 = last ? nB : cB + (size_t)(t + 2) * kstep;
            const char* a3 = a2 + kstep; const char* b3 = b2 + kstep;
            if (last && has_next) S.a_ready(nxt);
            if constexpr (SP2) {
            PG8_LDB(B0, 0, 0); PG8_LDB(B1, 0, 1); PG8_SCHED; PG8_LDA(At, 0, 0); PG8_STAGE(PG8_SA(1, 1), a1 + hstepA, voffA);
            PG8_WAIT_V(8); PG8_WAIT_L(0); PG8_BAR; PG8_MMA(0, 0, At, B0); PG8_MMA(0, 1, At, B1); PG8_BAR; PG8_SCHED;
            PG8_LDA(At, 0, 1); PG8_STAGE(PG8_SB(0, 0), b2, voffB); PG8_STAGE(PG8_SB(0, 1), b2 + hstepB, voffB); PG8_STAGE(PG8_SA(0, 0), a2, voffA);
            PG8_WAIT_V(8); PG8_WAIT_L(0); PG8_BAR; PG8_MMA(1, 0, At, B0); PG8_MMA(1, 1, At, B1); PG8_BAR; PG8_SCHED;
            PG8_LDB(B0, 1, 0); PG8_LDB(B1, 1, 1); PG8_SCHED; PG8_LDA(At, 1, 0); PG8_STAGE(PG8_SA(0, 1), a2 + hstepA, voffA);
            PG8_WAIT_V(8); PG8_WAIT_L(0); PG8_BAR; PG8_MMA(0, 0, At, B0); PG8_MMA(0, 1, At, B1); PG8_BAR; PG8_SCHED;
            PG8_LDA(At, 1, 1); PG8_STAGE(PG8_SB(1, 0), b3, voffB); PG8_STAGE(PG8_SB(1, 1), b3 + hstepB, voffB); PG8_STAGE(PG8_SA(1, 0), a3, voffA);
            PG8_WAIT_V(8); PG8_WAIT_L(0); PG8_BAR; PG8_MMA(1, 0, At, B0); PG8_MMA(1, 1, At, B1); PG8_BAR; PG8_SCHED;
            if constexpr (NHS > 0) {
                if (((t + 2) & 7) == 0 && ((t + 2) >> 3) <= NHS) { const PG8_LAS float* tp = hs + (((t + 2) >> 3) - 1) * 256 + wr * 64 + fr;
#pragma unroll
                    for (int ai = 0; ai < 2; ++ai)
#pragma unroll
                        for (int m = 0; m < 4; ++m) { const float f = tp[ai * HALF + m * 16];
#pragma unroll
                            for (int bj = 0; bj < 2; ++bj)
#pragma unroll
                                for (int n = 0; n < 2; ++n) acc[ai][bj][m][n] *= f; }
                    PG8_SCHED; }
            }
            } else {
            PG8_LDB(B0, 0, 0); PG8_SCHED; PG8_LDA(At, 0, 0); PG8_STAGE(PG8_SA(1, 1), a1 + hstepA, voffA);
            PG8_WAIT_L(8); PG8_BAR; PG8_WAIT_L(0); PG8_MMA(0, 0, At, B0); PG8_BAR; PG8_SCHED;
            PG8_LDB(B1, 0, 1); PG8_STAGE(PG8_SB(0, 0), b2, voffB);
            PG8_BAR; PG8_WAIT_L(0); PG8_MMA(0, 1, At, B1); PG8_BAR;
            PG8_LDA(At, 0, 1); PG8_STAGE(PG8_SA(0, 0), a2, voffA);
            PG8_BAR; PG8_WAIT_L(0); PG8_MMA(1, 0, At, B0); PG8_BAR; PG8_SCHED;
            PG8_STAGE(PG8_SB(0, 1), b2 + hstepB, voffB);
            PG8_WAIT_V(6); PG8_BAR; PG8_MMA(1, 1, At, B1); PG8_BAR;
            PG8_LDB(B0, 1, 0); PG8_SCHED; PG8_LDA(At, 1, 0); PG8_STAGE(PG8_SA(0, 1), a2 + hstepA, voffA);
            PG8_WAIT_L(8); PG8_BAR; PG8_WAIT_L(0); PG8_MMA(0, 0, At, B0); PG8_BAR; PG8_SCHED;
            PG8_LDB(B1, 1, 1); PG8_STAGE(PG8_SB(1, 0), b3, voffB);
            PG8_BAR; PG8_WAIT_L(0); PG8_MMA(0, 1, At, B1); PG8_BAR;
            PG8_LDA(At, 1, 1); PG8_STAGE(PG8_SA(1, 0), a3, voffA);
            PG8_BAR; PG8_WAIT_L(0); PG8_MMA(1, 0, At, B0); PG8_BAR; PG8_SCHED;
            PG8_STAGE(PG8_SB(1, 1), b3 + hstepB, voffB);
            PG8_WAIT_V(6); PG8_BAR; PG8_MMA(1, 1, At, B1); PG8_BAR;
            }
        }
        if constexpr (ALIGN_EPI) { if (wr == 0) PG8_BAR; }
        if constexpr (!Epi::AFTER_DRAIN) { E(acc, cur, wr, wc, fr, fq); S.done(cur); }
        if (!has_next) break;
#pragma unroll
        for (int a = 0; a < 2; ++a)
#pragma unroll
            for (int b = 0; b < 2; ++b)
#pragma unroll
                for (int m = 0; m < 4; ++m)
#pragma unroll
                    for (int n = 0; n < 2; ++n) acc[a][b][m][n] = (f32x4){0.f, 0.f, 0.f, 0.f};
        cur = nxt; cA = nA; cB = nB; ++ui;
        if constexpr (ALIGN_EPI) { if (wr == 1) PG8_BAR; }
    }
    PG8_WAIT_V(0);
    if constexpr (!ALIGN_EPI) { if (wr == 0) PG8_BAR; }
    PG8_BAR;
    if constexpr (Epi::AFTER_DRAIN) { E.fused(acc, cur, wr, wc, fr, fq, lds, wid, lane); S.done(cur); }
#undef PG8_SA
#undef PG8_SB
#undef PG8_STAGE
#undef PG8_LDA
#undef PG8_LDB
#undef PG8_MMA
#undef PG8_WAIT_V
#undef PG8_WAIT_L
#undef PG8_BAR
#undef PG8_SCHED
}
}

constexpr int T = 16384, SEQ = 8192, DM = 2048, LD = 12288 + 64;
constexpr int Q0 = 0, K0 = 1024, V0 = 2048, U0 = 4096, VS0 = 6144, GR0 = 8192, GS0 = 10240;
constexpr int Q1 = 0, K1 = 2048, V1 = 4096, G1 = 8192;
constexpr int MIXC = 8192;
constexpr size_t MiB = 1u << 20;
constexpr size_t WS_LR = 1 * MiB, WS_WLRT = 2 * MiB, WS_DEC = 3 * MiB, WS_WA = 8 * MiB, WS_H = 56 * MiB, WS_P = 120 * MiB, WS_END = 512 * MiB;
static_assert(WS_P + (size_t)T * LD * 2 <= WS_END, "d_ws map");
constexpr size_t WS_SC = WS_H, WS_SS = WS_H + 16 * MiB, WS_WO0 = WS_H + 32 * MiB;
constexpr int HS_OFF = 131072 + 8 * 2304 + 256;
constexpr int LDS_BYTES = HS_OFF + 8192;
#ifndef PROBE
#define PROBE 0
#endif

#define LAS __attribute__((address_space(3)))
typedef unsigned short bf16;
typedef short bf16x8 __attribute__((ext_vector_type(8)));
typedef float f32x4 __attribute__((ext_vector_type(4)));
typedef unsigned u32x4 __attribute__((ext_vector_type(4)));
typedef unsigned u32x2 __attribute__((ext_vector_type(2)));
#define LDS_WAIT() asm volatile("s_waitcnt lgkmcnt(0)" ::: "memory")
typedef float f32x2_t __attribute__((ext_vector_type(2)));
typedef __bf16 bf16x2_t __attribute__((ext_vector_type(2)));
__device__ __forceinline__ unsigned pk2(float lo, float hi) { const f32x2_t v = {lo, hi}; const bf16x2_t b = __builtin_convertvector(v, bf16x2_t); return __builtin_bit_cast(unsigned, b); }
__device__ __forceinline__ unsigned f2bf(float f) { return pk2(f, 0.f) & 0xffffu; }
__device__ __forceinline__ float bflo(unsigned w) { return __builtin_bit_cast(float, w << 16); }
__device__ __forceinline__ float bfhi(unsigned w) { return __builtin_bit_cast(float, w & 0xffff0000u); }
__device__ __forceinline__ float bf2f(bf16 b) { return __builtin_bit_cast(float, ((unsigned)b) << 16); }
__device__ __forceinline__ f32x4 mma16(bf16x8 a, bf16x8 b, f32x4 c) { return __builtin_amdgcn_mfma_f32_16x16x32_bf16(a, b, c, 0, 0, 0); }
__device__ __forceinline__ float wave_sum(float v) {
#pragma unroll
    for (int o = 1; o < 64; o <<= 1) v += __shfl_xor(v, o);
    return v;
}
__device__ __forceinline__ float silu(float g) { return g / (1.f + __expf(-g)); }

__device__ __forceinline__ void transpose_item(const float* W, int ldw, int K, bf16* WT, int k0, int n0, int drow0, LAS float* scr, int lane) {
#pragma unroll 8
    for (int i = 0; i < 32; ++i) { const int kk = 2 * i + (lane >> 5); scr[kk * 33 + (lane & 31)] = __builtin_nontemporal_load(W + (size_t)(k0 + kk) * ldw + n0 + (lane & 31)); }
    LDS_WAIT(); asm volatile("" ::: "memory");
    const int c = lane & 7;
#pragma unroll
    for (int j = 0; j < 4; ++j) { const int n = (lane >> 3) + 8 * j; const LAS float* s = scr + (8 * c) * 33 + n;
        u32x4 o; o.x = pk2(s[0 * 33], s[1 * 33]); o.y = pk2(s[2 * 33], s[3 * 33]); o.z = pk2(s[4 * 33], s[5 * 33]); o.w = pk2(s[6 * 33], s[7 * 33]);
        *(u32x4*)(WT + (size_t)(drow0 + n) * K + k0 + 8 * c) = o; }
    LDS_WAIT(); asm volatile("" ::: "memory");
}
__device__ __forceinline__ int perm0(int n) { return n < 4096 ? n : (n < 6144 ? n + 4096 : (n < 10240 ? n - 2048 : n)); }
template <bool PERM> __device__ __forceinline__ void transpose_all(const float* W, int ldw, int K, int N, bf16* WT, LAS float* scr, int gw, int ngw, int lane) {
    const int nblk = N / 32, nitems = (K / 64) * nblk;
    for (int it = gw; it < nitems; it += ngw) { const int kb = it / nblk, nb = it % nblk; const int n0 = nb * 32;
        transpose_item(W, ldw, K, WT, kb * 64, n0, PERM ? perm0(n0) : n0, scr, lane); }
}
__device__ __forceinline__ void rms_row_bf16(const float* xrow, const float* g, bf16* orow, int lane) {
    f32x4 v[8]; float s = 0.f;
#pragma unroll
    for (int j = 0; j < 8; ++j) { v[j] = __builtin_nontemporal_load((const f32x4*)xrow + 64 * j + lane); s += (v[j].x * v[j].x + v[j].y * v[j].y) + (v[j].z * v[j].z + v[j].w * v[j].w); }
    const float r = rsqrtf(wave_sum(s) * (1.f / DM) + 1e-6f);
#pragma unroll
    for (int j = 0; j < 8; ++j) { const f32x4 gg = ((const f32x4*)g)[64 * j + lane]; const f32x4 o = v[j] * r * gg;
        u32x2 w; w.x = pk2(o.x, o.y); w.y = pk2(o.z, o.w); ((u32x2*)orow)[64 * j + lane] = w; }
}
__device__ __forceinline__ void res_rms_row_bf16(const float* xrow, const bf16* acc, const float* g, bf16* orow, int lane) {
    f32x4 v[8]; float s = 0.f;
#pragma unroll
    for (int j = 0; j < 8; ++j) { const u32x2 a = ((const u32x2*)acc)[64 * j + lane]; v[j] = __builtin_nontemporal_load((const f32x4*)xrow + 64 * j + lane) + (f32x4){bflo(a.x), bfhi(a.x), bflo(a.y), bfhi(a.y)};
        s += (v[j].x * v[j].x + v[j].y * v[j].y) + (v[j].z * v[j].z + v[j].w * v[j].w); }
    const float r = rsqrtf(wave_sum(s) * (1.f / DM) + 1e-6f);
#pragma unroll
    for (int j = 0; j < 8; ++j) { const f32x4 gg = ((const f32x4*)g)[64 * j + lane]; const f32x4 o = v[j] * r * gg;
        u32x2 w; w.x = pk2(o.x, o.y); w.y = pk2(o.z, o.w); ((u32x2*)orow)[64 * j + lane] = w; }
}
__device__ __forceinline__ void res_rms_row_f32(const float* xrow, float* io, const bf16* acc2, const float* g, int lane) {
    f32x4 v[8]; float s = 0.f;
#pragma unroll
    for (int j = 0; j < 8; ++j) { const u32x2 a1 = __builtin_nontemporal_load((const u32x2*)io + 64 * j + lane), a2 = __builtin_nontemporal_load((const u32x2*)acc2 + 64 * j + lane);
        v[j] = (__builtin_nontemporal_load((const f32x4*)xrow + 64 * j + lane) + (f32x4){bflo(a1.x), bfhi(a1.x), bflo(a1.y), bfhi(a1.y)}) + (f32x4){bflo(a2.x), bfhi(a2.x), bflo(a2.y), bfhi(a2.y)};
        s += (v[j].x * v[j].x + v[j].y * v[j].y) + (v[j].z * v[j].z + v[j].w * v[j].w); }
    const float r = rsqrtf(wave_sum(s) * (1.f / DM) + 1e-6f);
#pragma unroll
    for (int j = 0; j < 8; ++j) { const f32x4 gg = ((const f32x4*)g)[64 * j + lane]; __builtin_nontemporal_store(v[j] * r * gg, (f32x4*)io + 64 * j + lane); }
}

template <bool DRY> __device__ __forceinline__ void retpre_unit(LAS unsigned char* lds, bf16* Pb, const int* pos, bf16* SC, float* DEC, int u, int tid, int never) {
    const int h = u & 3, n = (u >> 2) & 127, b = u >> 9;
    const int r0 = b * SEQ + n * 64;
    LAS bf16* Qs = (LAS bf16*)lds; LAS bf16* Ks = Qs + 64 * 264;
    const float lg2 = __log2f(1.f - exp2f(-5.f - (float)h));
    const int wv = tid >> 6, lane = tid & 63, l15 = lane & 15, quad = lane >> 4;
    for (int it = tid; it < 1024; it += 512) {
        const int t = it >> 4, j8 = it & 15;
        const float p = (float)pos[r0 + t];
        const bf16* qr = Pb + (size_t)(r0 + t) * LD + Q0 + h * 256 + j8 * 8;
        const bf16* kr = Pb + (size_t)(r0 + t) * LD + K0 + h * 256 + j8 * 8;
        const u32x4 q1 = *(const u32x4*)qr, q2 = *(const u32x4*)(qr + 128), k1 = *(const u32x4*)kr, k2 = *(const u32x4*)(kr + 128);
        u32x4 oq1, oq2, ok1, ok2;
#pragma unroll
        for (int e2 = 0; e2 < 4; ++e2) {
            float cs[2], sn[2];
#pragma unroll
            for (int z = 0; z < 2; ++z) { const float j = (float)(j8 * 8 + e2 * 2 + z);
                const float cj = exp2f(j * -0.10381025296523008f) * 0.15915494309189535f;
                const float hi = p * cj, lo = fmaf(p, cj, -hi); const float fr = (hi - floorf(hi)) + lo;
                sn[z] = __builtin_amdgcn_sinf(fr); cs[z] = __builtin_amdgcn_cosf(fr); }
            const float a0 = bflo(q1[e2]), a1 = bfhi(q1[e2]), b0 = bflo(q2[e2]), b1 = bfhi(q2[e2]);
            oq1[e2] = pk2((a0 * cs[0] - b0 * sn[0]) * 0.0625f, (a1 * cs[1] - b1 * sn[1]) * 0.0625f);
            oq2[e2] = pk2((a0 * sn[0] + b0 * cs[0]) * 0.0625f, (a1 * sn[1] + b1 * cs[1]) * 0.0625f);
            const float c0 = bflo(k1[e2]), c1 = bfhi(k1[e2]), d0 = bflo(k2[e2]), d1 = bfhi(k2[e2]);
            ok1[e2] = pk2(c0 * cs[0] - d0 * sn[0], c1 * cs[1] - d1 * sn[1]);
            ok2[e2] = pk2(c0 * sn[0] + d0 * cs[0], c1 * sn[1] + d1 * cs[1]);
        }
        *(LAS u32x4*)(Qs + t * 264 + j8 * 8) = oq1; *(LAS u32x4*)(Qs + t * 264 + 128 + j8 * 8) = oq2;
        *(LAS u32x4*)(Ks + t * 264 + j8 * 8) = ok1; *(LAS u32x4*)(Ks + t * 264 + 128 + j8 * 8) = ok2;
    }
    __syncthreads();
#pragma unroll
    for (int tl = 0; tl < 2; ++tl) { const int tile = 2 * wv + tl, ti = tile >> 2, si = tile & 3; const int t = ti * 16 + l15;
        u32x2 w; w.x = 0u; w.y = 0u;
        if (si <= ti) { f32x4 acc = {0.f, 0.f, 0.f, 0.f};
#pragma unroll
            for (int kk = 0; kk < 8; ++kk) { const bf16x8 qf = *(const LAS bf16x8*)(Qs + t * 264 + kk * 32 + quad * 8); const bf16x8 kf = *(const LAS bf16x8*)(Ks + (si * 16 + l15) * 264 + kk * 32 + quad * 8); acc = mma16(kf, qf, acc); }
            float v[4];
#pragma unroll
            for (int e = 0; e < 4; ++e) { const int s_ = si * 16 + quad * 4 + e; v[e] = (s_ <= t) ? acc[e] * exp2f((float)(t - s_) * lg2) : 0.f; }
            w.x = pk2(v[0], v[1]); w.y = pk2(v[2], v[3]); }
        if (!DRY || never) *(u32x2*)(SC + (size_t)u * 4096 + ((ti * 2 + (si >> 1)) * 64 + ((si & 1) * 2 + (quad >> 1)) * 16 + l15) * 8 + (quad & 1) * 4) = w; }
    for (int it = tid; it < 2048; it += 512) {
        const int fb = it >> 6, L = it & 63, tt = fb >> 3, kk = fb & 7, fl = L & 15, fq = L >> 4; const int t = tt * 16 + fl;
        const u32x4 v = *(const LAS u32x4*)(Qs + t * 264 + kk * 32 + fq * 8); const float f = exp2f((float)(t + 1) * lg2);
        u32x4 o;
#pragma unroll
        for (int e = 0; e < 4; ++e) o[e] = pk2(bflo(v[e]) * f, bfhi(v[e]) * f);
        if (!DRY || never) *(u32x4*)(Pb + (size_t)(r0 + 2 * fb + (L >> 5)) * LD + Q0 + h * 256 + (L & 31) * 8) = o;
    }
    for (int it = tid; it < 2048; it += 512) {
        const int fb = it >> 6, L = it & 63, kt = fb >> 1, kk = fb & 1, fl = L & 15, fq = L >> 4; const int k = kt * 16 + fl;
        u32x4 o;
#pragma unroll
        for (int e2 = 0; e2 < 4; ++e2) { const int s_ = kk * 32 + fq * 8 + e2 * 2;
            o[e2] = pk2(bf2f(Ks[s_ * 264 + k]) * exp2f((float)(63 - s_) * lg2), bf2f(Ks[(s_ + 1) * 264 + k]) * exp2f((float)(62 - s_) * lg2)); }
        if (!DRY || never) *(u32x4*)(Pb + (size_t)(r0 + 2 * fb + (L >> 5)) * LD + K0 + h * 256 + (L & 31) * 8) = o;
    }
    if ((!DRY || never) && tid < 256) DEC[(size_t)u * 256 + tid] = exp2f(64.f * lg2);
    __syncthreads();
}

template <bool DRY> __device__ __forceinline__ void sgu_unit(LAS unsigned char* lds, bf16* Pb, const float* gain, const float* w_s, const float* b_s, int u, int tid, int never) {
    const int g = u & 7, n = (u >> 3) & 63, b = u >> 9;
    const int r0 = b * SEQ + n * 128;
    LAS bf16* VnT = (LAS bf16*)lds;
    LAS bf16* Ws = VnT + 256 * 136;
    const int wv = tid >> 6, lane = tid & 63, l15 = lane & 15, quad = lane >> 4;
    for (int it = tid; it < 4096; it += 512) {
        const int t = it >> 5, s4 = (it & 31) * 4;
        const f32x4 w = *(const f32x4*)(w_s + (size_t)g * 16384 + t * 128 + s4);
        u32x2 o; o.x = pk2(s4 <= t ? w.x : 0.f, s4 + 1 <= t ? w.y : 0.f); o.y = pk2(s4 + 2 <= t ? w.z : 0.f, s4 + 3 <= t ? w.w : 0.f);
        *(LAS u32x2*)(Ws + t * 136 + s4) = o;
    }
    {
        const int row = tid >> 2, part = tid & 3;
        const bf16* src = Pb + (size_t)(r0 + row) * LD + VS0 + g * 256 + part * 64;
        u32x4 x[8]; float s = 0.f, s2 = 0.f;
#pragma unroll
        for (int j = 0; j < 8; ++j) { x[j] = *(const u32x4*)(src + j * 8);
#pragma unroll
            for (int e = 0; e < 4; ++e) { const float a = bflo(x[j][e]), c = bfhi(x[j][e]); s += a + c; s2 += a * a + c * c; } }
        s += __shfl_xor(s, 1); s2 += __shfl_xor(s2, 1); s += __shfl_xor(s, 2); s2 += __shfl_xor(s2, 2);
        const float mean = s * (1.f / 256.f); const float var = fmaxf(s2 * (1.f / 256.f) - mean * mean, 0.f); const float rstd = rsqrtf(var + 1e-6f);
        const float* gp = gain + g * 256 + part * 64;
#pragma unroll
        for (int j = 0; j < 8; ++j)
#pragma unroll
            for (int e = 0; e < 4; ++e) { const int c = part * 64 + j * 8 + e * 2;
                VnT[c * 136 + row] = (bf16)f2bf((bflo(x[j][e]) - mean) * rstd * gp[j * 8 + e * 2]);
                VnT[(c + 1) * 136 + row] = (bf16)f2bf((bfhi(x[j][e]) - mean) * rstd * gp[j * 8 + e * 2 + 1]); }
    }
    __syncthreads();
    {
        const int t = wv * 16 + l15; const int nk = (wv >> 1) + 1;
        bf16x8 wf[4];
#pragma unroll
        for (int kk = 0; kk < 4; ++kk) wf[kk] = *(const LAS bf16x8*)(Ws + t * 136 + kk * 32 + quad * 8);
        const float bias = b_s[g * 128 + t];
        bf16* rowp = Pb + (size_t)(r0 + t) * LD + g * 256 + quad * 4;
        for (int ci = 0; ci < 16; ++ci) {
            f32x4 acc = {0.f, 0.f, 0.f, 0.f};
#pragma unroll
            for (int kk = 0; kk < 4; ++kk) if (kk < nk) { const bf16x8 vf = *(const LAS bf16x8*)(VnT + (ci * 16 + l15) * 136 + kk * 32 + quad * 8); acc = mma16(vf, wf[kk], acc); }
            const u32x2 uu = *(const u32x2*)(rowp + U0 + ci * 16), gs = *(const u32x2*)(rowp + GS0 + ci * 16);
            u32x2 o;
            o.x = pk2(bflo(uu.x) * (acc[0] + bias) * silu(bflo(gs.x)), bfhi(uu.x) * (acc[1] + bias) * silu(bfhi(gs.x)));
            o.y = pk2(bflo(uu.y) * (acc[2] + bias) * silu(bflo(gs.y)), bfhi(uu.y) * (acc[3] + bias) * silu(bfhi(gs.y)));
            if (!DRY || never) *(u32x2*)(rowp + GS0 + ci * 16) = o;
        }
    }
    __syncthreads();
}

#define LBAR() do { asm volatile("s_waitcnt lgkmcnt(0)" ::: "memory"); __builtin_amdgcn_s_barrier(); asm volatile("" ::: "memory"); } while (0)
template <int NH, int QOFF, int KOFF, int VOFF, int GOFF, bool DRY>
__device__ __forceinline__ void scan_worker(LAS unsigned char* lds, bf16* Pb, const bf16* SC, const float* DEC, float* SS, int wk, int tid, int never) {
    constexpr int C = 64, NC = SEQ / C, VTS = C + 8, STS = 264;
    constexpr int ST_ELEMS = 32 * STS, VT_ELEMS = 32 * VTS;
    const int w = __builtin_amdgcn_readfirstlane(tid >> 6), lane = tid & 63, l15 = lane & 15, quad = lane >> 4;
    const int bh = wk >> 4, sl = wk & 15, b = bh / NH, h = bh % NH;
    LAS bf16* ST = (LAS bf16*)lds;
    LAS bf16* VT = ST + 2 * ST_ELEMS;
    LAS float* DC = (LAS float*)(VT + 2 * VT_ELEMS);
    const int vcol = VOFF + h * 512 + sl * 32;
    const int wq = w & 3;
    for (int i = tid; i < ST_ELEMS / 2; i += 512) ((LAS unsigned*)ST)[i] = 0u;
    if (w < 4) {
        const int vs_s = tid >> 2, vs_p = tid & 3;
        const unsigned offQ = (unsigned)((wq * 16 + (lane >> 5)) * LD + QOFF + h * 256 + (lane & 31) * 8), offP = (unsigned)(wq * 1024 + lane * 8);
        const unsigned offV = (unsigned)(vs_s * LD + vcol + vs_p * 8);
        const unsigned offO = (unsigned)((wq * 16 + l15) * LD + (vcol - VOFF + GOFF) + quad * 4), offS = (unsigned)(((wq * 16 + l15) * NH + h) * 32 + sl * 2);
        bf16x8 frA[10], frB[10], frC[10]; u32x4 vrA, vrB, vrC; u32x2 g0A, g1A, g0B, g1B, g0C, g1C;
#define O_LOAD(S, nn) do { const bf16* cb_ = Pb + (size_t)(b * SEQ + (nn) * C) * LD; const bf16* sb_ = SC + (size_t)((b * NC + (nn)) * NH + h) * (C * C); \
            _Pragma("unroll") for (int kk = 0; kk < 8; ++kk) { const bf16* ck_ = cb_ + kk * 2 * LD; fr##S[kk] = *(const bf16x8*)(ck_ + offQ); } \
            _Pragma("unroll") for (int kk = 0; kk < 2; ++kk) fr##S[8 + kk] = *(const bf16x8*)(sb_ + offP + kk * 512); \
            vr##S = *(const u32x4*)(cb_ + offV); g0##S = *(const u32x2*)(cb_ + offO); g1##S = *(const u32x2*)(cb_ + offO + 16); } while (0)
#define O_VT_WRITE(S, VTp) do { _Pragma("unroll") for (int e = 0; e < 4; ++e) { (VTp)[(vs_p * 8 + 2 * e) * VTS + vs_s] = (bf16)(vr##S[e] & 0xffffu); (VTp)[(vs_p * 8 + 2 * e + 1) * VTS + vs_s] = (bf16)(vr##S[e] >> 16); } } while (0)
#define O_STEP(S, SN, SL, n_) do { const int n = (n_); const int buf = n & 1; const int r0 = b * SEQ + n * C; \
            LAS bf16* STb = ST + buf * ST_ELEMS; LAS bf16* VTb = VT + buf * VT_ELEMS; LAS bf16* VTn = VT + (buf ^ 1) * VT_ELEMS; \
            LBAR(); \
            { const int nn_ = (n + 2 < NC) ? n + 2 : NC - 1; O_LOAD(SL, nn_); } \
            f32x4 o0 = {0.f, 0.f, 0.f, 0.f}, o1 = {0.f, 0.f, 0.f, 0.f}; \
            _Pragma("unroll") for (int kk = 0; kk < 8; ++kk) { const bf16x8 s0 = *(const LAS bf16x8*)(STb + l15 * STS + kk * 32 + quad * 8); const bf16x8 s1 = *(const LAS bf16x8*)(STb + (16 + l15) * STS + kk * 32 + quad * 8); \
                o0 = mma16(s0, fr##S[kk], o0); o1 = mma16(s1, fr##S[kk], o1); } \
            _Pragma("unroll") for (int kk = 0; kk < 2; ++kk) { const bf16x8 v0 = *(const LAS bf16x8*)(VTb + l15 * VTS + kk * 32 + quad * 8); const bf16x8 v1 = *(const LAS bf16x8*)(VTb + (16 + l15) * VTS + kk * 32 + quad * 8); \
                o0 = mma16(v0, fr##S[8 + kk], o0); o1 = mma16(v1, fr##S[8 + kk], o1); } \
            u32x2 p0, p1; p0.x = pk2(o0[0] * silu(bflo(g0##S.x)), o0[1] * silu(bfhi(g0##S.x))); p0.y = pk2(o0[2] * silu(bflo(g0##S.y)), o0[3] * silu(bfhi(g0##S.y))); \
            p1.x = pk2(o1[0] * silu(bflo(g1##S.x)), o1[1] * silu(bfhi(g1##S.x))); p1.y = pk2(o1[2] * silu(bflo(g1##S.y)), o1[3] * silu(bfhi(g1##S.y))); \
            bf16* op = Pb + (size_t)r0 * LD + offO; \
            if (!DRY || never) { *(u32x2*)op = p0; *(u32x2*)(op + 16) = p1; } \
            float ss0 = (o0[0] * o0[0] + o0[1] * o0[1]) + (o0[2] * o0[2] + o0[3] * o0[3]), ss1 = (o1[0] * o1[0] + o1[1] * o1[1]) + (o1[2] * o1[2] + o1[3] * o1[3]); \
            ss0 += __shfl_xor(ss0, 16); ss1 += __shfl_xor(ss1, 16); ss0 += __shfl_xor(ss0, 32); ss1 += __shfl_xor(ss1, 32); \
            if ((!DRY || never) && quad == 0) { float* sp = SS + (size_t)r0 * NH * 32 + offS; sp[0] = ss0; sp[1] = ss1; } \
            O_VT_WRITE(SN, VTn); } while (0)
        O_LOAD(A, 0); O_LOAD(B, 1);
        O_VT_WRITE(A, VT);
        for (int n0 = 0; n0 < NC; n0 += 3) {
            O_STEP(A, B, C, n0);
            if (n0 + 1 < NC) O_STEP(B, C, A, n0 + 1);
            if (n0 + 2 < NC) O_STEP(C, A, B, n0 + 2);
        }
#undef O_LOAD
#undef O_VT_WRITE
#undef O_STEP
    } else {
        const unsigned offK = (unsigned)((wq * 16 + (lane >> 5)) * LD + KOFF + h * 256 + (lane & 31) * 8);
        const unsigned offD = (unsigned)(lane * 4);
        const bool dw = (w == 4);
        f32x4 sacc[4][2];
#pragma unroll
        for (int a = 0; a < 4; ++a)
#pragma unroll
            for (int v = 0; v < 2; ++v) sacc[a][v] = (f32x4){0.f, 0.f, 0.f, 0.f};
        bf16x8 frA[8], frB[8], frC[8]; u32x4 vrA = {0u, 0u, 0u, 0u}, vrB = vrA, vrC = vrA;
#define S_LOAD(S, nn) do { const bf16* cb_ = Pb + (size_t)(b * SEQ + (nn) * C) * LD; \
            _Pragma("unroll") for (int a = 0; a < 4; ++a) _Pragma("unroll") for (int kk = 0; kk < 2; ++kk) { const bf16* ca_ = cb_ + (a * 4 + kk * 2) * LD; fr##S[a * 2 + kk] = *(const bf16x8*)(ca_ + offK); } \
            if (dw) vr##S = *(const u32x4*)(DEC + (size_t)((b * NC + (nn)) * NH + h) * 256 + offD); } while (0)
#define S_STEP(S, SN, SL, n_) do { const int n = (n_); const int buf = n & 1; \
            LAS bf16* VTb = VT + buf * VT_ELEMS; LAS bf16* STn = ST + (buf ^ 1) * ST_ELEMS; LAS float* DCb = DC + buf * 256; \
            LBAR(); \
            { const int nn_ = (n + 2 < NC) ? n + 2 : NC - 1; S_LOAD(SL, nn_); } \
            bf16x8 vf[2][2]; \
            _Pragma("unroll") for (int v = 0; v < 2; ++v) _Pragma("unroll") for (int kk = 0; kk < 2; ++kk) vf[v][kk] = *(const LAS bf16x8*)(VTb + (v * 16 + l15) * VTS + kk * 32 + quad * 8); \
            _Pragma("unroll") for (int a = 0; a < 4; ++a) { const f32x4 dc4 = *(const LAS f32x4*)(DCb + (wq * 4 + a) * 16 + quad * 4); \
                _Pragma("unroll") for (int v = 0; v < 2; ++v) { \
                    f32x4 s_ = sacc[a][v] * dc4; \
                    _Pragma("unroll") for (int kk = 0; kk < 2; ++kk) s_ = mma16(fr##S[a * 2 + kk], vf[v][kk], s_); \
                    sacc[a][v] = s_; u32x2 o_; o_.x = pk2(s_[0], s_[1]); o_.y = pk2(s_[2], s_[3]); \
                    *(LAS u32x2*)(STn + (v * 16 + l15) * STS + (wq * 4 + a) * 16 + quad * 4) = o_; } } \
            if (dw) *(LAS u32x4*)(DC + (buf ^ 1) * 256 + lane * 4) = vr##SN; } while (0)
        S_LOAD(A, 0); S_LOAD(B, 1);
        if (dw) *(LAS u32x4*)(DC + lane * 4) = vrA;
        for (int n0 = 0; n0 < NC; n0 += 3) {
            S_STEP(A, B, C, n0);
            if (n0 + 1 < NC) S_STEP(B, C, A, n0 + 1);
            if (n0 + 2 < NC) S_STEP(C, A, B, n0 + 2);
        }
#undef S_LOAD
#undef S_STEP
    }
    asm volatile("s_waitcnt vmcnt(0)" ::: "memory");
    __syncthreads();
}

template <int NH, int GOFF, bool DRY>
__device__ __forceinline__ void fin_phase(bf16* Pb, const float* SS, int gw, int ngw, int lane, int never) {
    for (int item = gw; item < T * NH; item += ngw) {
        const int tok = item / NH, h = item % NH;
        float s = (lane < 32) ? __builtin_nontemporal_load(SS + (size_t)item * 32 + lane) : 0.f; s = wave_sum(s);
        const float rstd = rsqrtf(s * (1.f / 512.f) + 1e-6f);
        bf16* rowp = Pb + (size_t)tok * LD + GOFF + h * 512 + lane * 8;
        const u32x4 o = *(const u32x4*)rowp;
        u32x4 r;
#pragma unroll
        for (int e = 0; e < 4; ++e) r[e] = pk2(bflo(o[e]) * rstd, bfhi(o[e]) * rstd);
        if (!DRY || never) *(u32x4*)rowp = r;
    }
}

__device__ __forceinline__ void lr_phase(const bf16* H, const bf16* WLRT, float* LR, int gw, int ngw, int lane) {
    const int l15 = lane & 15, quad = lane >> 4;
    for (int tile = gw; tile < T / 16; tile += ngw) {
        f32x4 acc = {0.f, 0.f, 0.f, 0.f};
        const bf16* ap = H + (size_t)(tile * 16 + l15) * DM + quad * 8; const bf16* bp = WLRT + (size_t)l15 * DM + quad * 8;
#pragma unroll 8
        for (int kk = 0; kk < 64; ++kk) acc = mma16(*(const bf16x8*)(ap + kk * 32), *(const bf16x8*)(bp + kk * 32), acc);
#pragma unroll
        for (int e = 0; e < 4; ++e) LR[(size_t)(tile * 16 + quad * 4 + e) * 16 + l15] = acc[e];
    }
}

template <bool DRY> __device__ __forceinline__ void glapre_unit(LAS unsigned char* lds, bf16* Pb, const float* LR, const float* w_lr, const float* b_lr, bf16* SC, float* DEC, int u, int tid, int never) {
    const int h = u & 7, n = (u >> 3) & 127, b = u >> 10;
    const int r0 = b * SEQ + n * 64;
    LAS bf16* Qs = (LAS bf16*)lds; LAS bf16* Ks = Qs + 64 * 264;
    LAS float* lrs = (LAS float*)(lds + 2 * 64 * 264 * 2); LAS float* tot = lrs + 1024;
    const int c = tid & 255, half = tid >> 8;
    const int wv = tid >> 6, lane = tid & 63, l15 = lane & 15, quad = lane >> 4;
    if (tid < 256) ((LAS f32x4*)lrs)[tid] = ((const f32x4*)(LR + (size_t)r0 * 16))[tid];
    float wl[16];
#pragma unroll
    for (int r = 0; r < 16; ++r) wl[r] = w_lr[r * 2048 + h * 256 + c];
    const float bb = b_lr[h * 256 + c];
    __syncthreads();
    float bc[32]; float run = 0.f;
#pragma unroll
    for (int i = 0; i < 32; ++i) { const int t = half * 32 + i; float z = bb;
#pragma unroll
        for (int r4 = 0; r4 < 4; ++r4) { const f32x4 l = ((const LAS f32x4*)lrs)[t * 4 + r4]; z += (l.x * wl[4 * r4] + l.y * wl[4 * r4 + 1]) + (l.z * wl[4 * r4 + 2] + l.w * wl[4 * r4 + 3]); }
        const float a = -(fmaxf(-z, 0.f) + __logf(1.f + __expf(-fabsf(z)))) * 0.0625f;
        run += a; bc[i] = run; }
    tot[half * 256 + c] = run;
    __syncthreads();
    const float t0 = tot[c], t1 = tot[256 + c]; const float blast = t0 + t1, off = half ? t0 : 0.f; const float eb = __expf(blast);
    LAS float* ebs = tot + 512;
    const bf16* gq = Pb + (size_t)(r0 + half * 32) * LD + h * 256 + c;
#pragma unroll
    for (int i = 0; i < 32; ++i) { const int t = half * 32 + i; const float bcv = bc[i] + off;
        const float q = bf2f(gq[(size_t)i * LD + Q1]), k = bf2f(gq[(size_t)i * LD + K1]);
        const float e = __expf(bcv), ei = __expf(-bcv);
        Qs[t * 264 + c] = (bf16)f2bf(q * 0.0625f * e); Ks[t * 264 + c] = (bf16)f2bf(k * ei); }
    if (half == 0) { ebs[c] = eb; if (!DRY || never) DEC[(size_t)u * 256 + c] = eb; }
    __syncthreads();
    for (int it = tid; it < 2048; it += 512) {
        const int fb = it >> 6, L = it & 63, tt = fb >> 3, kk = fb & 7, fl = L & 15, fq = L >> 4;
        const u32x4 v = *(const LAS u32x4*)(Qs + (tt * 16 + fl) * 264 + kk * 32 + fq * 8);
        if (!DRY || never) *(u32x4*)(Pb + (size_t)(r0 + 2 * fb + (L >> 5)) * LD + Q1 + h * 256 + (L & 31) * 8) = v;
    }
    for (int it = tid; it < 2048; it += 512) {
        const int fb = it >> 6, L = it & 63, kt = fb >> 1, kk = fb & 1, fl = L & 15, fq = L >> 4; const int k = kt * 16 + fl; const float ek = ebs[k];
        u32x4 o;
#pragma unroll
        for (int e2 = 0; e2 < 4; ++e2) { const int s_ = kk * 32 + fq * 8 + e2 * 2; o[e2] = pk2(bf2f(Ks[s_ * 264 + k]) * ek, bf2f(Ks[(s_ + 1) * 264 + k]) * ek); }
        if (!DRY || never) *(u32x4*)(Pb + (size_t)(r0 + 2 * fb + (L >> 5)) * LD + K1 + h * 256 + (L & 31) * 8) = o;
    }
#pragma unroll
    for (int tl = 0; tl < 2; ++tl) { const int tile = 2 * wv + tl, ti = tile >> 2, si = tile & 3; const int t = ti * 16 + l15;
        u32x2 w; w.x = 0u; w.y = 0u;
        if (si <= ti) { f32x4 acc = {0.f, 0.f, 0.f, 0.f};
#pragma unroll
            for (int kk = 0; kk < 8; ++kk) { const bf16x8 qf = *(const LAS bf16x8*)(Qs + t * 264 + kk * 32 + quad * 8); const bf16x8 kf = *(const LAS bf16x8*)(Ks + (si * 16 + l15) * 264 + kk * 32 + quad * 8); acc = mma16(kf, qf, acc); }
            float v[4];
#pragma unroll
            for (int e = 0; e < 4; ++e) { const int s = si * 16 + quad * 4 + e; v[e] = (s <= t) ? acc[e] : 0.f; }
            w.x = pk2(v[0], v[1]); w.y = pk2(v[2], v[3]); }
        if (!DRY || never) *(u32x2*)(SC + (size_t)u * 4096 + ((ti * 2 + (si >> 1)) * 64 + ((si & 1) * 2 + (quad >> 1)) * 16 + l15) * 8 + (quad & 1) * 4) = w; }
    __syncthreads();
}

#define RLX_AGENT __ATOMIC_RELAXED, __HIP_MEMORY_SCOPE_AGENT
#define XB_TMO      128
#define XB_XCNT(j)  (256  + 64 * (j))
#define XB_XSUB(j)  (1280 + 64 * (j))
#define XB_XGEN(j)  (2304 + 64 * (j))
#define XB_TOP      3328
#define XB_TOPGEN   3392
#define XCD_BAR_WORDS 3456
#define XB_SPIN_CAP (1u << 18)

__device__ __forceinline__ unsigned xb_ld(unsigned* p)              { return __hip_atomic_load(p, __ATOMIC_RELAXED, __HIP_MEMORY_SCOPE_AGENT); }
__device__ __forceinline__ unsigned xb_add(unsigned* p, unsigned v) { return __hip_atomic_fetch_add(p, v, __ATOMIC_RELAXED, __HIP_MEMORY_SCOPE_AGENT); }
__device__ __forceinline__ unsigned xb_xcc_id() { return (unsigned)__builtin_amdgcn_s_getreg((3 << 11) | 20) & 0xFu; }
#define XB_SPIN(cond, bar) do { unsigned _sp = 0; while (cond) { __builtin_amdgcn_s_sleep(1); \
    if ((++_sp & 255u) == 0u) { if (xb_ld(&(bar)[XB_TMO])) break; if (_sp > XB_SPIN_CAP) { atomicAdd(&(bar)[XB_TMO], 1u); break; } } } } while (0)

struct XcdBarrier {
    unsigned* bar; unsigned x;
    volatile LAS unsigned* st;
};

__device__ __forceinline__ XcdBarrier xcd_barrier_post(unsigned* bar, volatile LAS unsigned* st) {
    XcdBarrier b; b.bar = bar; b.x = xb_xcc_id(); b.st = st;
    if (threadIdx.x == 0) (void)xb_add(&bar[XB_XCNT(b.x)], 1u);
    return b;
}
__device__ __forceinline__ void xcd_barrier_complete(unsigned* bar, unsigned x, unsigned& nloc, unsigned& nx) {
    const unsigned G = gridDim.x * gridDim.y * gridDim.z;
    unsigned sum, cnt, mine, sp = 0u;
    for (;;) {
        sum = 0u; cnt = 0u; mine = 0u;
#pragma unroll
        for (unsigned j = 0; j < 16; ++j) { const unsigned c = xb_ld(&bar[XB_XCNT(j)]); sum += c; cnt += (c > 0u) ? 1u : 0u; mine = (j == x) ? c : mine; }
        if (sum == G) break;
        __builtin_amdgcn_s_sleep(1);
        if ((++sp & 255u) == 0u) { if (xb_ld(&bar[XB_TMO])) break; if (sp > XB_SPIN_CAP) { atomicAdd(&bar[XB_TMO], 1u); break; } }
    }
    nloc = mine > 0u ? mine : 1u; nx = cnt > 0u ? cnt : 1u;
}

__device__ __forceinline__ void xcd_barrier(const XcdBarrier& b) {
    asm volatile("s_waitcnt vmcnt(0)" ::: "memory");
    __syncthreads();
    if (threadIdx.x == 0) {
        unsigned* bar = b.bar;
        __builtin_amdgcn_s_waitcnt(0);
        unsigned nloc = b.st[0], nx = b.st[1];
        if (nloc == 0u) { xcd_barrier_complete(bar, b.x, nloc, nx); b.st[0] = nloc; b.st[1] = nx; }
        const unsigned old = xb_add(&bar[XB_XSUB(b.x)], 1u);
        const unsigned gen = old / nloc;
        if (old + 1u == (gen + 1u) * nloc) {
            __builtin_amdgcn_fence(__ATOMIC_RELEASE, "agent");
            asm volatile("s_waitcnt vmcnt(0)" ::: "memory");
            const unsigned og = xb_add(&bar[XB_TOP], 1u);
            const unsigned tg = og / nx;
            if (og + 1u == (tg + 1u) * nx) xb_add(&bar[XB_TOPGEN], 1u);
            else XB_SPIN(xb_ld(&bar[XB_TOPGEN]) == tg, bar);
            __builtin_amdgcn_fence(__ATOMIC_ACQUIRE, "agent");
            xb_add(&bar[XB_XGEN(b.x)], 1u);
            asm volatile("s_waitcnt vmcnt(0)" ::: "memory");
        } else {
            XB_SPIN(xb_ld(&bar[XB_XGEN(b.x)]) == gen, bar);
            __builtin_amdgcn_fence(__ATOMIC_ACQUIRE, "agent");
            asm volatile("s_waitcnt vmcnt(0)" ::: "memory");
        }
    }
    __syncthreads();
}

template <int NH>
__device__ __forceinline__ void build_hs_table(LAS float* tab, const float* SS, int pm, int tid) {
    for (int it = tid; it < 256 * NH; it += 512) { const int row = it / NH, h = it % NH;
        const f32x4* sp = (const f32x4*)(SS + ((size_t)(pm * 256 + row) * NH + h) * 32);
        float s = 0.f;
#pragma unroll
        for (int i = 0; i < 8; ++i) { const f32x4 v = sp[i]; s += (v.x + v.y) + (v.z + v.w); }
        tab[h * 256 + row] = rsqrtf(s * (1.f / 512.f) + 1e-6f); }
    __syncthreads();
    float f[NH / 2];
#pragma unroll
    for (int k = 0; k < NH / 2; ++k) { const int it = tid + 512 * k, j = it >> 8, row = it & 255; f[k] = (j < NH - 1) ? tab[j * 256 + row] / tab[(j + 1) * 256 + row] : tab[j * 256 + row]; }
    __syncthreads();
#pragma unroll
    for (int k = 0; k < NH / 2; ++k) tab[tid + 512 * k] = f[k];
    __syncthreads();
}

struct Args { const float* x; const int* pos; const float* ev_norm; const float* ev_w_in; const float* sgu_gain; const float* sgu_w_s; const float* sgu_b; const float* ev_w_out;
              const float* od_norm; const float* od_w_in; const float* gla_w_lr; const float* gla_b_lr; const float* od_w_out; const float* final_norm; float* out; unsigned char* ws; int never; int pad; };

__global__ void __launch_bounds__(512, 2) trunk_fwd(Args a) {
    extern __shared__ __attribute__((aligned(16))) unsigned char lds_raw[];
    LAS unsigned char* lds = (LAS unsigned char*)lds_raw;
    cg::grid_group grid = cg::this_grid();
    volatile LAS unsigned* xbst = (volatile LAS unsigned*)(lds + 131072 + 8 * 2304);
    if (threadIdx.x < 2) xbst[threadIdx.x] = 0u;
    __syncthreads();
    XcdBarrier xbar = xcd_barrier_post((unsigned*)a.ws, xbst);
    const int G = gridDim.x, bid = blockIdx.x, ngw = G * 8;
#define PH_BEGIN int t_ = threadIdx.x; asm volatile("" : "+v"(t_)); const int tid = t_, lane = tid & 63, wave = __builtin_amdgcn_readfirstlane(tid >> 6), gw = bid * 8 + wave; LAS float* scr = (LAS float*)(lds + wave * 16384); (void)lane; (void)gw; (void)scr;
    unsigned char* ws = a.ws;
    float* LR = (float*)(ws + WS_LR); bf16* WLRT = (bf16*)(ws + WS_WLRT); float* DEC = (float*)(ws + WS_DEC);
    bf16* WA = (bf16*)(ws + WS_WA); bf16* H = (bf16*)(ws + WS_H); bf16* Pb = (bf16*)(ws + WS_P);
    bf16* SC = (bf16*)(ws + WS_SC); float* SS = (float*)(ws + WS_SS); bf16* WO0 = (bf16*)(ws + WS_WO0);

    { PH_BEGIN
    for (int rep = 0; rep < 1 + ((PROBE >> 11) & 1); ++rep) {
    transpose_all<true>(a.ev_w_in, 12288, 2048, 12288, WA, scr, gw, ngw, lane);
    for (int m = gw; m < T; m += ngw) rms_row_bf16(a.x + (size_t)m * DM, a.ev_norm, H + (size_t)m * DM, lane);
    }
    }
    grid.sync();
    { PH_BEGIN
    if ((PROBE >> 15) & 1) { pg8::Gemm g{H, WA, T, 12288, 2048, 2048}; pg8::StaticOrder S; S.init(T, 12288, G, bid); pg8::EpiHot E{(bf16*)a.out};
      pg8::gemm_phase<pg8::EpiHot, pg8::StaticOrder, true, true>(lds, g, S, E); }
    for (int rep = 0; rep < 1 + ((PROBE >> 1) & 1); ++rep)
    { pg8::Gemm g{H, WA, T, 12288, 2048, 2048}; pg8::StaticOrder S; S.init(T, 12288, G, bid); pg8::EpiBf16W E{Pb, LD, lds + 131072};
      pg8::gemm_phase<pg8::EpiBf16W, pg8::StaticOrder, true, true>(lds, g, S, E); }
    }
    xcd_barrier(xbar);
    { PH_BEGIN
    if ((PROBE >> 2) & 1) for (int u = bid; u < 1024; u += G) retpre_unit<true>(lds, Pb, a.pos, SC, DEC, u, tid, a.never);
    for (int u = bid; u < 1024; u += G) retpre_unit<false>(lds, Pb, a.pos, SC, DEC, u, tid, a.never);
    }
    xcd_barrier(xbar);
    { PH_BEGIN
    for (int v = bid; v < 256; v += G) { const int xcd = v & 7, idx = v >> 3;
        if (idx < 16) { const int wk = xcd * 16 + idx;
            if ((PROBE >> 4) & 1) scan_worker<4, Q0, K0, V0, GR0, true>(lds, Pb, SC, DEC, SS, wk, tid, a.never);
            scan_worker<4, Q0, K0, V0, GR0, false>(lds, Pb, SC, DEC, SS, wk, tid, a.never);
        } else { const int hi = (idx - 16) * 8 + xcd;
            if ((PROBE >> 3) & 1) for (int u = hi; u < 1024; u += 128) sgu_unit<true>(lds, Pb, a.sgu_gain, a.sgu_w_s, a.sgu_b, u, tid, a.never);
            for (int u = hi; u < 1024; u += 128) sgu_unit<false>(lds, Pb, a.sgu_gain, a.sgu_w_s, a.sgu_b, u, tid, a.never);
            transpose_all<false>(a.ev_w_out, 2048, 4096, 2048, WO0, scr, hi * 8 + wave, 128 * 8, lane);
            transpose_all<false>(a.od_w_in, 12304, 2048, 12288, WA, scr, hi * 8 + wave, 128 * 8, lane);
        } }
    }
    xcd_barrier(xbar);
    if (G != 256) {
    { PH_BEGIN
    if ((PROBE >> 5) & 1) fin_phase<4, GR0, true>(Pb, SS, gw, ngw, lane, a.never);
    fin_phase<4, GR0, false>(Pb, SS, gw, ngw, lane, a.never);
    }
    xcd_barrier(xbar);
    }
    { PH_BEGIN
    { pg8::Gemm g{Pb + MIXC, WO0, T, 2048, 4096, LD}; pg8::StaticOrder S; S.init(T, 2048, G, bid); pg8::EpiBf16W E{(bf16*)a.out, 2 * DM, lds + 131072};
      if (G == 256) { pg8::Unit u0; S.next(0, u0); LAS float* tab = (LAS float*)(lds + HS_OFF); build_hs_table<4>(tab, SS, u0.pm, tid);
        pg8::gemm_phase<pg8::EpiBf16W, pg8::StaticOrder, true, true, 4>(lds, g, S, E, tab); }
      else pg8::gemm_phase<pg8::EpiBf16W, pg8::StaticOrder, true, true>(lds, g, S, E); }
    }
    xcd_barrier(xbar);
    { PH_BEGIN
    for (int m = gw; m < T; m += ngw) res_rms_row_bf16(a.x + (size_t)m * DM, (const bf16*)a.out + (size_t)m * 2 * DM, a.od_norm, H + (size_t)m * DM, lane);
    for (int i = bid * 512 + tid; i < 16 * 2048; i += G * 512) { const int r = i >> 11, k = i & 2047; WLRT[i] = (bf16)f2bf(a.od_w_in[(size_t)k * 12304 + 12288 + r]); }
    }
    xcd_barrier(xbar);
    { PH_BEGIN
    lr_phase(H, WLRT, LR, gw, ngw, lane);
    { pg8::Gemm g{H, WA, T, 12288, 2048, 2048}; pg8::StaticOrder S; S.init(T, 12288, G, bid); pg8::EpiBf16W E{Pb, LD, lds + 131072};
      pg8::gemm_phase<pg8::EpiBf16W, pg8::StaticOrder, true, true>(lds, g, S, E); }
    }
    xcd_barrier(xbar);
    { PH_BEGIN
    if ((PROBE >> 8) & 1) for (int u = bid; u < 2048; u += G) glapre_unit<true>(lds, Pb, LR, a.gla_w_lr, a.gla_b_lr, SC, DEC, u, tid, a.never);
    for (int u = bid; u < 2048; u += G) glapre_unit<false>(lds, Pb, LR, a.gla_w_lr, a.gla_b_lr, SC, DEC, u, tid, a.never);
    transpose_all<false>(a.od_w_out, 2048, 4096, 2048, WA, scr, gw, ngw, lane);
    }
    xcd_barrier(xbar);
    { PH_BEGIN
    for (int v = bid; v < 256; v += G) { const int xcd = v & 7, idx = v >> 3; const int wk = (xcd * 2 + (idx >> 4)) * 16 + (idx & 15);
        if ((PROBE >> 9) & 1) scan_worker<8, Q1, K1, V1, G1, true>(lds, Pb, SC, DEC, SS, wk, tid, a.never);
        scan_worker<8, Q1, K1, V1, G1, false>(lds, Pb, SC, DEC, SS, wk, tid, a.never); }
    }
    xcd_barrier(xbar);
    if (G != 256) {
    { PH_BEGIN
    if ((PROBE >> 10) & 1) fin_phase<8, G1, true>(Pb, SS, gw, ngw, lane, a.never);
    fin_phase<8, G1, false>(Pb, SS, gw, ngw, lane, a.never);
    }
    xcd_barrier(xbar);
    }
    { PH_BEGIN
    { pg8::Gemm g{Pb + MIXC, WA, T, 2048, 4096, LD}; pg8::StaticOrder S; S.init(T, 2048, G, bid); pg8::EpiBf16W E{Pb, LD, lds + 131072};
      if (G == 256) { pg8::Unit u0; S.next(0, u0); LAS float* tab = (LAS float*)(lds + HS_OFF); build_hs_table<8>(tab, SS, u0.pm, tid);
        pg8::gemm_phase<pg8::EpiBf16W, pg8::StaticOrder, true, true, 8>(lds, g, S, E, tab); }
      else pg8::gemm_phase<pg8::EpiBf16W, pg8::StaticOrder, true, true>(lds, g, S, E); }
    }
    xcd_barrier(xbar);
    if ((PROBE >> 12) & 1) { for (int rep = 0; rep < 12; ++rep) xcd_barrier(xbar); }
    { PH_BEGIN
    for (int m = gw; m < T; m += ngw) res_rms_row_f32(a.x + (size_t)m * DM, a.out + (size_t)m * DM, Pb + (size_t)m * LD, a.final_norm, lane);
    }
}

extern "C" void kernel_launch(void* const* d_in, const int* in_sizes, int n_in, void* d_out, int out_size, void* d_ws, size_t ws_size, hipStream_t stream) {
    static int grid = 0;
    if (grid == 0) {
        if (n_in != 14 || out_size != T * DM || ws_size < WS_END) { fprintf(stderr, "kernel_launch: unexpected shapes (n_in %d out %d ws %zu)\n", n_in, out_size, ws_size); grid = -1; return; }
        int dev = 0, cus = 0, per_cu = 0;
        (void)hipGetDevice(&dev);
        (void)hipDeviceGetAttribute(&cus, hipDeviceAttributeMultiprocessorCount, dev);
        (void)hipFuncSetAttribute((const void*)trunk_fwd, hipFuncAttributeMaxDynamicSharedMemorySize, LDS_BYTES);
        (void)hipOccupancyMaxActiveBlocksPerMultiprocessor(&per_cu, (const void*)trunk_fwd, 512, LDS_BYTES);
        if (per_cu < 1) per_cu = 1;
        grid = cus * per_cu;
    }
    if (grid < 0) return;
    (void)hipMemsetAsync(d_ws, 0, 16384, stream);
    Args a{};
    a.x = (const float*)d_in[0]; a.pos = (const int*)d_in[1]; a.ev_norm = (const float*)d_in[2]; a.ev_w_in = (const float*)d_in[3]; a.sgu_gain = (const float*)d_in[4];
    a.sgu_w_s = (const float*)d_in[5]; a.sgu_b = (const float*)d_in[6]; a.ev_w_out = (const float*)d_in[7]; a.od_norm = (const float*)d_in[8]; a.od_w_in = (const float*)d_in[9];
    a.gla_w_lr = (const float*)d_in[10]; a.gla_b_lr = (const float*)d_in[11]; a.od_w_out = (const float*)d_in[12]; a.final_norm = (const float*)d_in[13];
    a.out = (float*)d_out; a.ws = (unsigned char*)d_ws;
    void* args[] = {&a};
    hipError_t e = hipLaunchCooperativeKernel((void*)trunk_fwd, dim3(grid), dim3(512), args, LDS_BYTES, stream);
    if (e != hipSuccess) fprintf(stderr, "kernel_launch: cooperative launch failed: %s (grid %d)\n", hipGetErrorString(e), grid);
}
```

```cpp
#include <hip/hip_runtime.h>
#include <hip/hip_cooperative_groups.h>
#include <cstdio>
#include <cstdint>
namespace cg = cooperative_groups;

namespace pg8 {
#define PG8_LAS __attribute__((address_space(3)))
typedef unsigned short bf16_t;
typedef short bf16x8 __attribute__((ext_vector_type(8)));
typedef float f32x4 __attribute__((ext_vector_type(4)));
typedef unsigned u32x4 __attribute__((ext_vector_type(4)));
constexpr int BM = 256, BK = 64, HALF = 128, HTB = HALF * BK * 2, STAGE_BYTES = 8 * HTB, NXCD = 8, WGM = 8;
__host__ __device__ __forceinline__ int lds_byte(int r, int c) { const int st = (r >> 4) * 2 + (c >> 5), rr = r & 15, cc = c & 31, ob = rr * 64 + cc * 2; return st * 1024 + (ob ^ (((ob >> 9) & 1) << 5)); }
__host__ __device__ __forceinline__ void stage_rc(int b, int& R, int& C) { const int st = b / 1024, sb = b % 1024, swz = sb ^ (((sb >> 9) & 1) << 5); R = (st >> 1) * 16 + swz / 64; C = (st & 1) * 32 + (swz % 64) / 2; }
__host__ __device__ __forceinline__ int perm32(int rho) { const int n = rho >> 4, i = rho & 15; return 8 * (i >> 2) + 4 * n + (i & 3); }
struct Unit { int pm, pn; };
struct Gemm { const bf16_t* A; const bf16_t* Bt; int M, N, K, lda; };
struct StaticOrder {
    int nM, nN, nwg, G, c;
    __host__ __device__ void init(int M, int N, int G_, int c_) { nM = M / BM; nN = N / BM; nwg = nM * nN; G = G_; c = c_; }
    __host__ __device__ bool next(int i, Unit& u) const {
        const long L = (long)i * G + c; if (L >= nwg) return false;
        int wgid = (int)L; { const int q = nwg / NXCD, r = nwg % NXCD, xcd = wgid % NXCD, off = wgid / NXCD; wgid = (xcd < r ? xcd * (q + 1) : r * (q + 1) + (xcd - r) * q) + off; }
        const int nig = WGM * nN, gid = wgid / nig, fm = gid * WGM, gsz = (nM - fm) < WGM ? (nM - fm) : WGM;
        u.pm = fm + ((wgid % nig) % gsz); u.pn = (wgid % nig) / gsz; return true;
    }
    __device__ __forceinline__ void a_ready(const Unit&) const {}
    __device__ __forceinline__ void done(const Unit&) const {}
};
typedef float f32x2c __attribute__((ext_vector_type(2)));
typedef __bf16 bf16x2c __attribute__((ext_vector_type(2)));
__device__ __forceinline__ unsigned cvt_pk_bf16(float lo, float hi) { const f32x2c v = {lo, hi}; const bf16x2c b = __builtin_convertvector(v, bf16x2c); return __builtin_bit_cast(unsigned, b); }
struct EpiBf16P {
    static constexpr bool PERM = true, WIDE = false, AFTER_DRAIN = false;
    bf16_t* O; int ldc;
    __device__ __forceinline__ void operator()(const f32x4 (&acc)[2][2][4][2], const Unit& u, int wr, int wc, int fr, int fq) const {
        const int row0 = u.pm * BM + wr * 64 + fr, col0 = u.pn * BM + wc * 32 + 8 * fq;
#pragma unroll
        for (int ai = 0; ai < 2; ++ai)
#pragma unroll
            for (int m = 0; m < 4; ++m) { bf16_t* rowp = O + (size_t)(row0 + ai * HALF + m * 16) * ldc + col0;
#pragma unroll
                for (int bj = 0; bj < 2; ++bj) { const f32x4 v0 = acc[ai][bj][m][0], v1 = acc[ai][bj][m][1];
                    u32x4 w; w.x = cvt_pk_bf16(v0[0], v0[1]); w.y = cvt_pk_bf16(v0[2], v0[3]); w.z = cvt_pk_bf16(v1[0], v1[1]); w.w = cvt_pk_bf16(v1[2], v1[3]);
                    *(u32x4*)(rowp + bj * HALF) = w; } }
    }
};
struct EpiNull {
    static constexpr bool PERM = false, WIDE = false, AFTER_DRAIN = false;
    float* out; int never;
    __device__ __forceinline__ void operator()(const f32x4 (&acc)[2][2][4][2], const Unit& u, int wr, int wc, int fr, int fq) const {
        f32x4 s = {0.f, 0.f, 0.f, 0.f};
#pragma unroll
        for (int ai = 0; ai < 2; ++ai)
#pragma unroll
            for (int bj = 0; bj < 2; ++bj)
#pragma unroll
                for (int m = 0; m < 4; ++m)
#pragma unroll
                    for (int n = 0; n < 2; ++n) s += acc[ai][bj][m][n];
        if (never) *(f32x4*)(out + (size_t)(u.pm * BM + wr * 64 + fr) * 2048 + u.pn * BM + wc * 32 + 4 * fq) = s;
    }
};
struct EpiBf16W {
    static constexpr bool PERM = true, WIDE = true, AFTER_DRAIN = false;
    bf16_t* O; int ldc; PG8_LAS unsigned char* stg;
    __device__ __forceinline__ void operator()(const f32x4 (&acc)[2][2][4][2], const Unit& u, int wr, int wc, int fr, int fq) const {
        PG8_LAS unsigned char* my = stg + (wr * 4 + wc) * 2304;
        const int lane = fq * 16 + fr, rrow = lane >> 3, rc8 = lane & 7;
        bf16_t* obase = O + (size_t)(u.pm * BM + wr * 64 + rrow) * ldc + u.pn * BM + wc * 64 + rc8 * 8;
#pragma unroll
        for (int ai = 0; ai < 2; ++ai)
#pragma unroll
            for (int m = 0; m < 4; ++m) {
                u32x4 w0, w1;
                w0.x = cvt_pk_bf16(acc[ai][0][m][0][0], acc[ai][0][m][0][1]); w0.y = cvt_pk_bf16(acc[ai][0][m][0][2], acc[ai][0][m][0][3]);
                w0.z = cvt_pk_bf16(acc[ai][0][m][1][0], acc[ai][0][m][1][1]); w0.w = cvt_pk_bf16(acc[ai][0][m][1][2], acc[ai][0][m][1][3]);
                w1.x = cvt_pk_bf16(acc[ai][1][m][0][0], acc[ai][1][m][0][1]); w1.y = cvt_pk_bf16(acc[ai][1][m][0][2], acc[ai][1][m][0][3]);
                w1.z = cvt_pk_bf16(acc[ai][1][m][1][0], acc[ai][1][m][1][1]); w1.w = cvt_pk_bf16(acc[ai][1][m][1][2], acc[ai][1][m][1][3]);
                *(PG8_LAS u32x4*)(my + fr * 144 + fq * 32) = w0; *(PG8_LAS u32x4*)(my + fr * 144 + fq * 32 + 16) = w1;
                asm volatile("s_waitcnt lgkmcnt(0)" ::: "memory");
                const u32x4 r0 = *(const PG8_LAS u32x4*)(my + rrow * 144 + rc8 * 16), r1 = *(const PG8_LAS u32x4*)(my + (8 + rrow) * 144 + rc8 * 16);
                asm volatile("s_waitcnt lgkmcnt(0)" ::: "memory");
                bf16_t* op = obase + (size_t)(ai * HALF + m * 16) * ldc;
                __builtin_nontemporal_store(r0, (u32x4*)op); __builtin_nontemporal_store(r1, (u32x4*)(op + (size_t)8 * ldc));
            }
    }
};
struct EpiHot {
    static constexpr bool PERM = true, WIDE = false, AFTER_DRAIN = false;
    bf16_t* O;
    __device__ __forceinline__ void operator()(const f32x4 (&acc)[2][2][4][2], const Unit& u, int wr, int wc, int fr, int fq) const {
        const int row0 = wr * 64 + fr, col0 = wc * 32 + 8 * fq;
#pragma unroll
        for (int ai = 0; ai < 2; ++ai)
#pragma unroll
            for (int m = 0; m < 4; ++m) { bf16_t* rowp = O + (size_t)blockIdx.x * 65536 + (size_t)(row0 + ai * HALF + m * 16) * 256 + col0;
#pragma unroll
                for (int bj = 0; bj < 2; ++bj) { const f32x4 v0 = acc[ai][bj][m][0], v1 = acc[ai][bj][m][1];
                    u32x4 w; w.x = cvt_pk_bf16(v0[0], v0[1]); w.y = cvt_pk_bf16(v0[2], v0[3]); w.z = cvt_pk_bf16(v1[0], v1[1]); w.w = cvt_pk_bf16(v1[2], v1[3]);
                    *(u32x4*)(rowp + bj * HALF) = w; } }
    }
};
struct EpiF32P {
    static constexpr bool PERM = true, WIDE = false, AFTER_DRAIN = false;
    float* out; int ldc;
    __device__ __forceinline__ void operator()(const f32x4 (&acc)[2][2][4][2], const Unit& u, int wr, int wc, int fr, int fq) const {
        const int row0 = u.pm * BM + wr * 64 + fr, col0 = u.pn * BM + wc * 32 + 8 * fq;
#pragma unroll
        for (int ai = 0; ai < 2; ++ai)
#pragma unroll
            for (int m = 0; m < 4; ++m) { float* rowp = out + (size_t)(row0 + ai * HALF + m * 16) * ldc + col0;
#pragma unroll
                for (int bj = 0; bj < 2; ++bj) { *(f32x4*)(rowp + bj * HALF) = acc[ai][bj][m][0]; *(f32x4*)(rowp + bj * HALF + 4) = acc[ai][bj][m][1]; } }
    }
};
template <class Epi, class Sched, bool ALIGN_EPI = false, bool SP2 = false, int NHS = 0>
__device__ __forceinline__ void gemm_phase(PG8_LAS unsigned char* lds, const Gemm g, const Sched& S, const Epi& E, const PG8_LAS float* hs = nullptr) {
    int tid_ = threadIdx.x; asm volatile("" : "+v"(tid_));
    const int tid = tid_, wid = __builtin_amdgcn_readfirstlane(tid >> 6), lane = tid & 63, wr = wid >> 2, wc = wid & 3, fr = lane & 15, fq = lane >> 4;
    const int K = g.K, nt = K / BK;
    unsigned voffA[2], voffB[2];
#pragma unroll
    for (int i = 0; i < 2; ++i) { int R, C; stage_rc(tid * 16 + i * 8192, R, C); const int Rb = Epi::WIDE ? (64 * (R >> 5) + 16 * ((R & 15) >> 2) + 4 * ((R >> 4) & 1) + (R & 3)) : (Epi::PERM ? ((R & ~31) + perm32(R & 31)) : R);
        voffA[i] = (unsigned)(R * g.lda + C) * 2u; voffB[i] = (unsigned)(Rb * K + C) * 2u; }
    const size_t kstep = (size_t)(BK * 2);
    const size_t hstepA = (size_t)HALF * g.lda * 2, hstepB = Epi::WIDE ? (size_t)8 * K * 2 : (size_t)HALF * K * 2;
    const size_t tstepA = 2 * hstepA, tstepB = (size_t)BM * K * 2;
    const unsigned ldsw = (unsigned)wid * 1024u;
    const int aoff = lds_byte(wr * 64 + fr, fq * 8), boff = lds_byte(wc * 32 + fr, fq * 8);
#define PG8_SA(b, h) (((b) * 2 + (h)) * HTB)
#define PG8_SB(b, h) ((4 + (b) * 2 + (h)) * HTB)
#define PG8_STAGE(bufoff, gbase, voff) do { _Pragma("unroll") for (int _i = 0; _i < 2; ++_i) \
        __builtin_amdgcn_global_load_lds((const unsigned*)((const char*)(gbase) + (voff)[_i]), (PG8_LAS unsigned*)(lds + (bufoff) + ldsw + _i * 8192), 16, 0, 0); } while (0)
#define PG8_LDA(dst, b, h) do { _Pragma("unroll") for (int m = 0; m < 4; ++m) _Pragma("unroll") for (int k = 0; k < 2; ++k) dst[m][k] = *(const PG8_LAS bf16x8*)(lds + PG8_SA(b, h) + aoff + m * 2048 + k * 1024); } while (0)
#define PG8_LDB(dst, b, h) do { _Pragma("unroll") for (int n = 0; n < 2; ++n) _Pragma("unroll") for (int k = 0; k < 2; ++k) dst[n][k] = *(const PG8_LAS bf16x8*)(lds + PG8_SB(b, h) + boff + n * 2048 + k * 1024); } while (0)
#define PG8_MMA(ai, bj, At, Bt) do { __builtin_amdgcn_s_setprio(1); _Pragma("unroll") for (int m = 0; m < 4; ++m) _Pragma("unroll") for (int n = 0; n < 2; ++n) _Pragma("unroll") for (int k = 0; k < 2; ++k) \
        acc[ai][bj][m][n] = __builtin_amdgcn_mfma_f32_16x16x32_bf16(Bt[n][k], At[m][k], acc[ai][bj][m][n], 0, 0, 0); __builtin_amdgcn_s_setprio(0); } while (0)
#define PG8_WAIT_V(n) asm volatile("s_waitcnt vmcnt(" #n ")" ::: "memory")
#define PG8_WAIT_L(n) asm volatile("s_waitcnt lgkmcnt(" #n ")" ::: "memory")
#define PG8_BAR __builtin_amdgcn_s_barrier()
#define PG8_SCHED __builtin_amdgcn_sched_barrier(0)
    Unit cur, nxt; int ui = 0;
    if (!S.next(0, cur)) return;
    f32x4 acc[2][2][4][2];
#pragma unroll
    for (int a = 0; a < 2; ++a)
#pragma unroll
        for (int b = 0; b < 2; ++b)
#pragma unroll
            for (int m = 0; m < 4; ++m)
#pragma unroll
                for (int n = 0; n < 2; ++n) acc[a][b][m][n] = (f32x4){0.f, 0.f, 0.f, 0.f};
    bf16x8 At[4][2], B0[2][2], B1[2][2];
    const char* cA = (const char*)g.A + (size_t)cur.pm * tstepA; const char* cB = (const char*)g.Bt + (size_t)cur.pn * tstepB;
    S.a_ready(cur);
    if constexpr (SP2) {
        PG8_STAGE(PG8_SB(0, 0), cB, voffB); PG8_STAGE(PG8_SB(0, 1), cB + hstepB, voffB); PG8_STAGE(PG8_SA(0, 0), cA, voffA); PG8_STAGE(PG8_SA(0, 1), cA + hstepA, voffA);
        if (wr == 1) PG8_BAR;
        PG8_WAIT_V(2); PG8_BAR;
        PG8_STAGE(PG8_SB(1, 0), cB + kstep, voffB); PG8_STAGE(PG8_SA(1, 0), cA + kstep, voffA); PG8_STAGE(PG8_SB(1, 1), cB + hstepB + kstep, voffB);
        PG8_WAIT_V(6); PG8_BAR;
    } else {
        PG8_STAGE(PG8_SB(0, 0), cB, voffB); PG8_STAGE(PG8_SA(0, 0), cA, voffA); PG8_STAGE(PG8_SB(0, 1), cB + hstepB, voffB); PG8_STAGE(PG8_SA(0, 1), cA + hstepA, voffA);
        if (wr == 1) PG8_BAR;
        PG8_WAIT_V(4); PG8_BAR;
        PG8_STAGE(PG8_SB(1, 0), cB + kstep, voffB); PG8_STAGE(PG8_SA(1, 0), cA + kstep, voffA); PG8_STAGE(PG8_SB(1, 1), cB + hstepB + kstep, voffB);
        PG8_WAIT_V(6); PG8_BAR;
    }
    for (;;) {
        const bool has_next = S.next(ui + 1, nxt);
        const char* nA = has_next ? (const char*)g.A + (size_t)nxt.pm * tstepA : cA; const char* nB = has_next ? (const char*)g.Bt + (size_t)nxt.pn * tstepB : cB;
        for (int t = 0; t < nt; t += 2) {
            const bool last = (t == nt - 2);
            const char* a1 = cA + (size_t)(t + 1) * kstep;
            const char* a2 = last ? nA : cA + (size_t)(t + 2) * kstep; const char* b2 = last ? nB : cB + (size_t)(t + 2) * kstep;
            const char* a3 = a2 + kstep; const char* b3 = b2 + kstep;
            if (last && has_next) S.a_ready(nxt);
            if constexpr (SP2) {
            PG8_LDB(B0, 0, 0); PG8_LDB(B1, 0, 1); PG8_SCHED; PG8_LDA(At, 0, 0); PG8_STAGE(PG8_SA(1, 1), a1 + hstepA, voffA);
            PG8_WAIT_V(8); PG8_WAIT_L(0); PG8_BAR; PG8_MMA(0, 0, At, B0); PG8_MMA(0, 1, At, B1); PG8_BAR; PG8_SCHED;
            PG8_LDA(At, 0, 1); PG8_STAGE(PG8_SB(0, 0), b2, voffB); PG8_STAGE(PG8_SB(0, 1), b2 + hstepB, voffB); PG8_STAGE(PG8_SA(0, 0), a2, voffA);
            PG8_WAIT_V(8); PG8_WAIT_L(0); PG8_BAR; PG8_MMA(1, 0, At, B0); PG8_MMA(1, 1, At, B1); PG8_BAR; PG8_SCHED;
            PG8_LDB(B0, 1, 0); PG8_LDB(B1, 1, 1); PG8_SCHED; PG8_LDA(At, 1, 0); PG8_STAGE(PG8_SA(0, 1), a2 + hstepA, voffA);
            PG8_WAIT_V(8); PG8_WAIT_L(0); PG8_BAR; PG8_MMA(0, 0, At, B0); PG8_MMA(0, 1, At, B1); PG8_BAR; PG8_SCHED;
            PG8_LDA(At, 1, 1); PG8_STAGE(PG8_SB(1, 0), b3, voffB); PG8_STAGE(PG8_SB(1, 1), b3 + hstepB, voffB); PG8_STAGE(PG8_SA(1, 0), a3, voffA);
            PG8_WAIT_V(8); PG8_WAIT_L(0); PG8_BAR; PG8_MMA(1, 0, At, B0); PG8_MMA(1, 1, At, B1); PG8_BAR; PG8_SCHED;
            if constexpr (NHS > 0) {
                if (((t + 2) & 7) == 0 && ((t + 2) >> 3) <= NHS) { const PG8_LAS float* tp = hs + (((t + 2) >> 3) - 1) * 256 + wr * 64 + fr;
#pragma unroll
                    for (int ai = 0; ai < 2; ++ai)
#pragma unroll
                        for (int m = 0; m < 4; ++m) { const float f = tp[ai * HALF + m * 16];
#pragma unroll
                            for (int bj = 0; bj < 2; ++bj)
#pragma unroll
                                for (int n = 0; n < 2; ++n) acc[ai][bj][m][n] *= f; }
                    PG8_SCHED; }
            }
            } else {
            PG8_LDB(B0, 0, 0); PG8_SCHED; PG8_LDA(At, 0, 0); PG8_STAGE(PG8_SA(1, 1), a1 + hstepA, voffA);
            PG8_WAIT_L(8); PG8_BAR; PG8_WAIT_L(0); PG8_MMA(0, 0, At, B0); PG8_BAR; PG8_SCHED;
            PG8_LDB(B1, 0, 1); PG8_STAGE(PG8_SB(0, 0), b2, voffB);
            PG8_BAR; PG8_WAIT_L(0); PG8_MMA(0, 1, At, B1); PG8_BAR;
            PG8_LDA(At, 0, 1); PG8_STAGE(PG8_SA(0, 0), a2, voffA);
            PG8_BAR; PG8_WAIT_L(0); PG8_MMA(1, 0, At, B0); PG8_BAR; PG8_SCHED;
            PG8_STAGE(PG8_SB(0, 1), b2 + hstepB, voffB);
            PG8_WAIT_V(6); PG8_BAR; PG8_MMA(1, 1, At, B1); PG8_BAR;
            PG8_LDB(B0, 1, 0); PG8_SCHED; PG8_LDA(At, 1, 0); PG8_STAGE(PG8_SA(0, 1), a2 + hstepA, voffA);
            PG8_WAIT_L(8); PG8_BAR; PG8_WAIT_L(0); PG8_MMA(0, 0, At, B0); PG8_BAR; PG8_SCHED;
            PG8_LDB(B1, 1, 1); PG8_STAGE(PG8_SB(1, 0), b3, voffB);
            PG8_BAR; PG8_WAIT_L(0); PG8_MMA(0, 1, At, B1); PG8_BAR;
            PG8_LDA(At, 1, 1); PG8_STAGE(PG8_SA(1, 0), a3, voffA);
            PG8_BAR; PG8_WAIT_L(0); PG8_MMA(1, 0, At, B0); PG8_BAR; PG8_SCHED;
            PG8_STAGE(PG8_SB(1, 1), b3 + hstepB, voffB);
            PG8_WAIT_V(6); PG8_BAR; PG8_MMA(1, 1, At, B1); PG8_BAR;
            }
        }
        if constexpr (ALIGN_EPI) { if (wr == 0) PG8_BAR; }
        if constexpr (!Epi::AFTER_DRAIN) { E(acc, cur, wr, wc, fr, fq); S.done(cur); }
        if (!has_next) break;
#pragma unroll
        for (int a = 0; a < 2; ++a)
#pragma unroll
            for (int b = 0; b < 2; ++b)
#pragma unroll
                for (int m = 0; m < 4; ++m)
#pragma unroll
                    for (int n = 0; n < 2; ++n) acc[a][b][m][n] = (f32x4){0.f, 0.f, 0.f, 0.f};
        cur = nxt; cA = nA; cB = nB; ++ui;
        if constexpr (ALIGN_EPI) { if (wr == 1) PG8_BAR; }
    }
    PG8_WAIT_V(0);
    if constexpr (!ALIGN_EPI) { if (wr == 0) PG8_BAR; }
    PG8_BAR;
    if constexpr (Epi::AFTER_DRAIN) { E.fused(acc, cur, wr, wc, fr, fq, lds, wid, lane); S.done(cur); }
#undef PG8_SA
#undef PG8_SB
#undef PG8_STAGE
#undef PG8_LDA
#undef PG8_LDB
#undef PG8_MMA
#undef PG8_WAIT_V
#undef PG8_WAIT_L
#undef PG8_BAR
#undef PG8_SCHED
}
}

constexpr int T = 16384, SEQ = 8192, DM = 2048, LD = 12288 + 64;
constexpr int Q0 = 0, K0 = 1024, V0 = 2048, U0 = 4096, VS0 = 6144, GR0 = 8192, GS0 = 10240;
constexpr int Q1 = 0, K1 = 2048, V1 = 4096, G1 = 8192;
constexpr int MIXC = 8192;
constexpr size_t MiB = 1u << 20;
constexpr size_t WS_LR = 1 * MiB, WS_WLRT = 2 * MiB, WS_DEC = 3 * MiB, WS_WA = 8 * MiB, WS_H = 56 * MiB, WS_P = 120 * MiB, WS_END = 512 * MiB;
static_assert(WS_P + (size_t)T * LD * 2 <= WS_END, "d_ws map");
constexpr size_t WS_SC = WS_H, WS_SS = WS_H + 16 * MiB, WS_WO0 = WS_H + 32 * MiB;
constexpr int HS_OFF = 131072 + 8 * 2304 + 256;
constexpr int LDS_BYTES = HS_OFF + 8192;
#ifndef PROBE
#define PROBE 0
#endif

#define LAS __attribute__((address_space(3)))
typedef unsigned short bf16;
typedef short bf16x8 __attribute__((ext_vector_type(8)));
typedef float f32x4 __attribute__((ext_vector_type(4)));
typedef unsigned u32x4 __attribute__((ext_vector_type(4)));
typedef unsigned u32x2 __attribute__((ext_vector_type(2)));
#define LDS_WAIT() asm volatile("s_waitcnt lgkmcnt(0)" ::: "memory")
typedef float f32x2_t __attribute__((ext_vector_type(2)));
typedef __bf16 bf16x2_t __attribute__((ext_vector_type(2)));
__device__ __forceinline__ unsigned pk2(float lo, float hi) { const f32x2_t v = {lo, hi}; const bf16x2_t b = __builtin_convertvector(v, bf16x2_t); return __builtin_bit_cast(unsigned, b); }
__device__ __forceinline__ unsigned f2bf(float f) { return pk2(f, 0.f) & 0xffffu; }
__device__ __forceinline__ float bflo(unsigned w) { return __builtin_bit_cast(float, w << 16); }
__device__ __forceinline__ float bfhi(unsigned w) { return __builtin_bit_cast(float, w & 0xffff0000u); }
__device__ __forceinline__ float bf2f(bf16 b) { return __builtin_bit_cast(float, ((unsigned)b) << 16); }
__device__ __forceinline__ f32x4 mma16(bf16x8 a, bf16x8 b, f32x4 c) { return __builtin_amdgcn_mfma_f32_16x16x32_bf16(a, b, c, 0, 0, 0); }
__device__ __forceinline__ float wave_sum(float v) {
#pragma unroll
    for (int o = 1; o < 64; o <<= 1) v += __shfl_xor(v, o);
    return v;
}
__device__ __forceinline__ float silu(float g) { return g / (1.f + __expf(-g)); }

__device__ __forceinline__ void transpose_item(const float* W, int ldw, int K, bf16* WT, int k0, int n0, int drow0, LAS float* scr, int lane) {
#pragma unroll 8
    for (int i = 0; i < 32; ++i) { const int kk = 2 * i + (lane >> 5); scr[kk * 33 + (lane & 31)] = __builtin_nontemporal_load(W + (size_t)(k0 + kk) * ldw + n0 + (lane & 31)); }
    LDS_WAIT(); asm volatile("" ::: "memory");
    const int c = lane & 7;
#pragma unroll
    for (int j = 0; j < 4; ++j) { const int n = (lane >> 3) + 8 * j; const LAS float* s = scr + (8 * c) * 33 + n;
        u32x4 o; o.x = pk2(s[0 * 33], s[1 * 33]); o.y = pk2(s[2 * 33], s[3 * 33]); o.z = pk2(s[4 * 33], s[5 * 33]); o.w = pk2(s[6 * 33], s[7 * 33]);
        *(u32x4*)(WT + (size_t)(drow0 + n) * K + k0 + 8 * c) = o; }
    LDS_WAIT(); asm volatile("" ::: "memory");
}
__device__ __forceinline__ int perm0(int n) { return n < 4096 ? n : (n < 6144 ? n + 4096 : (n < 10240 ? n - 2048 : n)); }
template <bool PERM> __device__ __forceinline__ void transpose_all(const float* W, int ldw, int K, int N, bf16* WT, LAS float* scr, int gw, int ngw, int lane) {
    const int nblk = N / 32, nitems = (K / 64) * nblk;
    for (int it = gw; it < nitems; it += ngw) { const int kb = it / nblk, nb = it % nblk; const int n0 = nb * 32;
        transpose_item(W, ldw, K, WT, kb * 64, n0, PERM ? perm0(n0) : n0, scr, lane); }
}
__device__ __forceinline__ void rms_row_bf16(const float* xrow, const float* g, bf16* orow, int lane) {
    f32x4 v[8]; float s = 0.f;
#pragma unroll
    for (int j = 0; j < 8; ++j) { v[j] = __builtin_nontemporal_load((const f32x4*)xrow + 64 * j + lane); s += (v[j].x * v[j].x + v[j].y * v[j].y) + (v[j].z * v[j].z + v[j].w * v[j].w); }
    const float r = rsqrtf(wave_sum(s) * (1.f / DM) + 1e-6f);
#pragma unroll
    for (int j = 0; j < 8; ++j) { const f32x4 gg = ((const f32x4*)g)[64 * j + lane]; const f32x4 o = v[j] * r * gg;
        u32x2 w; w.x = pk2(o.x, o.y); w.y = pk2(o.z, o.w); ((u32x2*)orow)[64 * j + lane] = w; }
}
__device__ __forceinline__ void res_rms_row_bf16(const float* xrow, const bf16* acc, const float* g, bf16* orow, int lane) {
    f32x4 v[8]; float s = 0.f;
#pragma unroll
    for (int j = 0; j < 8; ++j) { const u32x2 a = ((const u32x2*)acc)[64 * j + lane]; v[j] = __builtin_nontemporal_load((const f32x4*)xrow + 64 * j + lane) + (f32x4){bflo(a.x), bfhi(a.x), bflo(a.y), bfhi(a.y)};
        s += (v[j].x * v[j].x + v[j].y * v[j].y) + (v[j].z * v[j].z + v[j].w * v[j].w); }
    const float r = rsqrtf(wave_sum(s) * (1.f / DM) + 1e-6f);
#pragma unroll
    for (int j = 0; j < 8; ++j) { const f32x4 gg = ((const f32x4*)g)[64 * j + lane]; const f32x4 o = v[j] * r * gg;
        u32x2 w; w.x = pk2(o.x, o.y); w.y = pk2(o.z, o.w); ((u32x2*)orow)[64 * j + lane] = w; }
}
__device__ __forceinline__ void res_rms_row_f32(const float* xrow, float* io, const bf16* acc2, const float* g, int lane) {
    f32x4 v[8]; float s = 0.f;
#pragma unroll
    for (int j = 0; j < 8; ++j) { const u32x2 a1 = __builtin_nontemporal_load((const u32x2*)io + 64 * j + lane), a2 = __builtin_nontemporal_load((const u32x2*)acc2 + 64 * j + lane);
        v[j] = (__builtin_nontemporal_load((const f32x4*)xrow + 64 * j + lane) + (f32x4){bflo(a1.x), bfhi(a1.x), bflo(a1.y), bfhi(a1.y)}) + (f32x4){bflo(a2.x), bfhi(a2.x), bflo(a2.y), bfhi(a2.y)};
        s += (v[j].x * v[j].x + v[j].y * v[j].y) + (v[j].z * v[j].z + v[j].w * v[j].w); }
    const float r = rsqrtf(wave_sum(s) * (1.f / DM) + 1e-6f);
#pragma unroll
    for (int j = 0; j < 8; ++j) { const f32x4 gg = ((const f32x4*)g)[64 * j + lane]; __builtin_nontemporal_store(v[j] * r * gg, (f32x4*)io + 64 * j + lane); }
}

template <bool DRY> __device__ __forceinline__ void retpre_unit(LAS unsigned char* lds, bf16* Pb, const int* pos, bf16* SC, float* DEC, int u, int tid, int never) {
    const int h = u & 3, n = (u >> 2) & 127, b = u >> 9;
    const int r0 = b * SEQ + n * 64;
    LAS bf16* Qs = (LAS bf16*)lds; LAS bf16* Ks = Qs + 64 * 264;
    const float lg2 = __log2f(1.f - exp2f(-5.f - (float)h));
    const int wv = tid >> 6, lane = tid & 63, l15 = lane & 15, quad = lane >> 4;
    for (int it = tid; it < 1024; it += 512) {
        const int t = it >> 4, j8 = it & 15;
        const float p = (float)pos[r0 + t];
        const bf16* qr = Pb + (size_t)(r0 + t) * LD + Q0 + h * 256 + j8 * 8;
        const bf16* kr = Pb + (size_t)(r0 + t) * LD + K0 + h * 256 + j8 * 8;
        const u32x4 q1 = *(const u32x4*)qr, q2 = *(const u32x4*)(qr + 128), k1 = *(const u32x4*)kr, k2 = *(const u32x4*)(kr + 128);
        u32x4 oq1, oq2, ok1, ok2;
#pragma unroll
        for (int e2 = 0; e2 < 4; ++e2) {
            float cs[2], sn[2];
#pragma unroll
            for (int z = 0; z < 2; ++z) { const float j = (float)(j8 * 8 + e2 * 2 + z);
                const float cj = exp2f(j * -0.10381025296523008f) * 0.15915494309189535f;
                const float hi = p * cj, lo = fmaf(p, cj, -hi); const float fr = (hi - floorf(hi)) + lo;
                sn[z] = __builtin_amdgcn_sinf(fr); cs[z] = __builtin_amdgcn_cosf(fr); }
            const float a0 = bflo(q1[e2]), a1 = bfhi(q1[e2]), b0 = bflo(q2[e2]), b1 = bfhi(q2[e2]);
            oq1[e2] = pk2((a0 * cs[0] - b0 * sn[0]) * 0.0625f, (a1 * cs[1] - b1 * sn[1]) * 0.0625f);
            oq2[e2] = pk2((a0 * sn[0] + b0 * cs[0]) * 0.0625f, (a1 * sn[1] + b1 * cs[1]) * 0.0625f);
            const float c0 = bflo(k1[e2]), c1 = bfhi(k1[e2]), d0 = bflo(k2[e2]), d1 = bfhi(k2[e2]);
            ok1[e2] = pk2(c0 * cs[0] - d0 * sn[0], c1 * cs[1] - d1 * sn[1]);
            ok2[e2] = pk2(c0 * sn[0] + d0 * cs[0], c1 * sn[1] + d1 * cs[1]);
        }
        *(LAS u32x4*)(Qs + t * 264 + j8 * 8) = oq1; *(LAS u32x4*)(Qs + t * 264 + 128 + j8 * 8) = oq2;
        *(LAS u32x4*)(Ks + t * 264 + j8 * 8) = ok1; *(LAS u32x4*)(Ks + t * 264 + 128 + j8 * 8) = ok2;
    }
    __syncthreads();
#pragma unroll
    for (int tl = 0; tl < 2; ++tl) { const int tile = 2 * wv + tl, ti = tile >> 2, si = tile & 3; const int t = ti * 16 + l15;
        u32x2 w; w.x = 0u; w.y = 0u;
        if (si <= ti) { f32x4 acc = {0.f, 0.f, 0.f, 0.f};
#pragma unroll
            for (int kk = 0; kk < 8; ++kk) { const bf16x8 qf = *(const LAS bf16x8*)(Qs + t * 264 + kk * 32 + quad * 8); const bf16x8 kf = *(const LAS bf16x8*)(Ks + (si * 16 + l15) * 264 + kk * 32 + quad * 8); acc = mma16(kf, qf, acc); }
            float v[4];
#pragma unroll
            for (int e = 0; e < 4; ++e) { const int s_ = si * 16 + quad * 4 + e; v[e] = (s_ <= t) ? acc[e] * exp2f((float)(t - s_) * lg2) : 0.f; }
            w.x = pk2(v[0], v[1]); w.y = pk2(v[2], v[3]); }
        if (!DRY || never) *(u32x2*)(SC + (size_t)u * 4096 + ((ti * 2 + (si >> 1)) * 64 + ((si & 1) * 2 + (quad >> 1)) * 16 + l15) * 8 + (quad & 1) * 4) = w; }
    for (int it = tid; it < 2048; it += 512) {
        const int fb = it >> 6, L = it & 63, tt = fb >> 3, kk = fb & 7, fl = L & 15, fq = L >> 4; const int t = tt * 16 + fl;
        const u32x4 v = *(const LAS u32x4*)(Qs + t * 264 + kk * 32 + fq * 8); const float f = exp2f((float)(t + 1) * lg2);
        u32x4 o;
#pragma unroll
        for (int e = 0; e < 4; ++e) o[e] = pk2(bflo(v[e]) * f, bfhi(v[e]) * f);
        if (!DRY || never) *(u32x4*)(Pb + (size_t)(r0 + 2 * fb + (L >> 5)) * LD + Q0 + h * 256 + (L & 31) * 8) = o;
    }
    for (int it = tid; it < 2048; it += 512) {
        const int fb = it >> 6, L = it & 63, kt = fb >> 1, kk = fb & 1, fl = L & 15, fq = L >> 4; const int k = kt * 16 + fl;
        u32x4 o;
#pragma unroll
        for (int e2 = 0; e2 < 4; ++e2) { const int s_ = kk * 32 + fq * 8 + e2 * 2;
            o[e2] = pk2(bf2f(Ks[s_ * 264 + k]) * exp2f((float)(63 - s_) * lg2), bf2f(Ks[(s_ + 1) * 264 + k]) * exp2f((float)(62 - s_) * lg2)); }
        if (!DRY || never) *(u32x4*)(Pb + (size_t)(r0 + 2 * fb + (L >> 5)) * LD + K0 + h * 256 + (L & 31) * 8) = o;
    }
    if ((!DRY || never) && tid < 256) DEC[(size_t)u * 256 + tid] = exp2f(64.f * lg2);
    __syncthreads();
}

template <bool DRY> __device__ __forceinline__ void sgu_unit(LAS unsigned char* lds, bf16* Pb, const float* gain, const float* w_s, const float* b_s, int u, int tid, int never) {
    const int g = u & 7, n = (u >> 3) & 63, b = u >> 9;
    const int r0 = b * SEQ + n * 128;
    LAS bf16* VnT = (LAS bf16*)lds;
    LAS bf16* Ws = VnT + 256 * 136;
    const int wv = tid >> 6, lane = tid & 63, l15 = lane & 15, quad = lane >> 4;
    for (int it = tid; it < 4096; it += 512) {
        const int t = it >> 5, s4 = (it & 31) * 4;
        const f32x4 w = *(const f32x4*)(w_s + (size_t)g * 16384 + t * 128 + s4);
        u32x2 o; o.x = pk2(s4 <= t ? w.x : 0.f, s4 + 1 <= t ? w.y : 0.f); o.y = pk2(s4 + 2 <= t ? w.z : 0.f, s4 + 3 <= t ? w.w : 0.f);
        *(LAS u32x2*)(Ws + t * 136 + s4) = o;
    }
    {
        const int row = tid >> 2, part = tid & 3;
        const bf16* src = Pb + (size_t)(r0 + row) * LD + VS0 + g * 256 + part * 64;
        u32x4 x[8]; float s = 0.f, s2 = 0.f;
#pragma unroll
        for (int j = 0; j < 8; ++j) { x[j] = *(const u32x4*)(src + j * 8);
#pragma unroll
            for (int e = 0; e < 4; ++e) { const float a = bflo(x[j][e]), c = bfhi(x[j][e]); s += a + c; s2 += a * a + c * c; } }
        s += __shfl_xor(s, 1); s2 += __shfl_xor(s2, 1); s += __shfl_xor(s, 2); s2 += __shfl_xor(s2, 2);
        const float mean = s * (1.f / 256.f); const float var = fmaxf(s2 * (1.f / 256.f) - mean * mean, 0.f); const float rstd = rsqrtf(var + 1e-6f);
        const float* gp = gain + g * 256 + part * 64;
#pragma unroll
        for (int j = 0; j < 8; ++j)
#pragma unroll
            for (int e = 0; e < 4; ++e) { const int c = part * 64 + j * 8 + e * 2;
                VnT[c * 136 + row] = (bf16)f2bf((bflo(x[j][e]) - mean) * rstd * gp[j * 8 + e * 2]);
                VnT[(c + 1) * 136 + row] = (bf16)f2bf((bfhi(x[j][e]) - mean) * rstd * gp[j * 8 + e * 2 + 1]); }
    }
    __syncthreads();
    {
        const int t = wv * 16 + l15; const int nk = (wv >> 1) + 1;
        bf16x8 wf[4];
#pragma unroll
        for (int kk = 0; kk < 4; ++kk) wf[kk] = *(const LAS bf16x8*)(Ws + t * 136 + kk * 32 + quad * 8);
        const float bias = b_s[g * 128 + t];
        bf16* rowp = Pb + (size_t)(r0 + t) * LD + g * 256 + quad * 4;
        for (int ci = 0; ci < 16; ++ci) {
            f32x4 acc = {0.f, 0.f, 0.f, 0.f};
#pragma unroll
            for (int kk = 0; kk < 4; ++kk) if (kk < nk) { const bf16x8 vf = *(const LAS bf16x8*)(VnT + (ci * 16 + l15) * 136 + kk * 32 + quad * 8); acc = mma16(vf, wf[kk], acc); }
            const u32x2 uu = *(const u32x2*)(rowp + U0 + ci * 16), gs = *(const u32x2*)(rowp + GS0 + ci * 16);
            u32x2 o;
            o.x = pk2(bflo(uu.x) * (acc[0] + bias) * silu(bflo(gs.x)), bfhi(uu.x) * (acc[1] + bias) * silu(bfhi(gs.x)));
            o.y = pk2(bflo(uu.y) * (acc[2] + bias) * silu(bflo(gs.y)), bfhi(uu.y) * (acc[3] + bias) * silu(bfhi(gs.y)));
            if (!DRY || never) *(u32x2*)(rowp + GS0 + ci * 16) = o;
        }
    }
    __syncthreads();
}

#define LBAR() do { asm volatile("s_waitcnt lgkmcnt(0)" ::: "memory"); __builtin_amdgcn_s_barrier(); asm volatile("" ::: "memory"); } while (0)
template <int NH, int QOFF, int KOFF, int VOFF, int GOFF, bool DRY>
__device__ __forceinline__ void scan_worker(LAS unsigned char* lds, bf16* Pb, const bf16* SC, const float* DEC, float* SS, int wk, int tid, int never) {
    constexpr int C = 64, NC = SEQ / C, VTS = C + 8, STS = 264;
    constexpr int ST_ELEMS = 32 * STS, VT_ELEMS = 32 * VTS;
    const int w = __builtin_amdgcn_readfirstlane(tid >> 6), lane = tid & 63, l15 = lane & 15, quad = lane >> 4;
    const int bh = wk >> 4, sl = wk & 15, b = bh / NH, h = bh % NH;
    LAS bf16* ST = (LAS bf16*)lds;
    LAS bf16* VT = ST + 2 * ST_ELEMS;
    LAS float* DC = (LAS float*)(VT + 2 * VT_ELEMS);
    const int vcol = VOFF + h * 512 + sl * 32;
    const int wq = w & 3;
    for (int i = tid; i < ST_ELEMS / 2; i += 512) ((LAS unsigned*)ST)[i] = 0u;
    if (w < 4) {
        const int vs_s = tid >> 2, vs_p = tid & 3;
        const unsigned offQ = (unsigned)((wq * 16 + (lane >> 5)) * LD + QOFF + h * 256 + (lane & 31) * 8), offP = (unsigned)(wq * 1024 + lane * 8);
        const unsigned offV = (unsigned)(vs_s * LD + vcol + vs_p * 8);
        const unsigned offO = (unsigned)((wq * 16 + l15) * LD + (vcol - VOFF + GOFF) + quad * 4), offS = (unsigned)(((wq * 16 + l15) * NH + h) * 32 + sl * 2);
        bf16x8 frA[10], frB[10], frC[10]; u32x4 vrA, vrB, vrC; u32x2 g0A, g1A, g0B, g1B, g0C, g1C;
#define O_LOAD(S, nn) do { const bf16* cb_ = Pb + (size_t)(b * SEQ + (nn) * C) * LD; const bf16* sb_ = SC + (size_t)((b * NC + (nn)) * NH + h) * (C * C); \
            _Pragma("unroll") for (int kk = 0; kk < 8; ++kk) { const bf16* ck_ = cb_ + kk * 2 * LD; fr##S[kk] = *(const bf16x8*)(ck_ + offQ); } \
            _Pragma("unroll") for (int kk = 0; kk < 2; ++kk) fr##S[8 + kk] = *(const bf16x8*)(sb_ + offP + kk * 512); \
            vr##S = *(const u32x4*)(cb_ + offV); g0##S = *(const u32x2*)(cb_ + offO); g1##S = *(const u32x2*)(cb_ + offO + 16); } while (0)
#define O_VT_WRITE(S, VTp) do { _Pragma("unroll") for (int e = 0; e < 4; ++e) { (VTp)[(vs_p * 8 + 2 * e) * VTS + vs_s] = (bf16)(vr##S[e] & 0xffffu); (VTp)[(vs_p * 8 + 2 * e + 1) * VTS + vs_s] = (bf16)(vr##S[e] >> 16); } } while (0)
#define O_STEP(S, SN, SL, n_) do { const int n = (n_); const int buf = n & 1; const int r0 = b * SEQ + n * C; \
            LAS bf16* STb = ST + buf * ST_ELEMS; LAS bf16* VTb = VT + buf * VT_ELEMS; LAS bf16* VTn = VT + (buf ^ 1) * VT_ELEMS; \
            LBAR(); \
            { const int nn_ = (n + 2 < NC) ? n + 2 : NC - 1; O_LOAD(SL, nn_); } \
            f32x4 o0 = {0.f, 0.f, 0.f, 0.f}, o1 = {0.f, 0.f, 0.f, 0.f}; \
            _Pragma("unroll") for (int kk = 0; kk < 8; ++kk) { const bf16x8 s0 = *(const LAS bf16x8*)(STb + l15 * STS + kk * 32 + quad * 8); const bf16x8 s1 = *(const LAS bf16x8*)(STb + (16 + l15) * STS + kk * 32 + quad * 8); \
                o0 = mma16(s0, fr##S[kk], o0); o1 = mma16(s1, fr##S[kk], o1); } \
            _Pragma("unroll") for (int kk = 0; kk < 2; ++kk) { const bf16x8 v0 = *(const LAS bf16x8*)(VTb + l15 * VTS + kk * 32 + quad * 8); const bf16x8 v1 = *(const LAS bf16x8*)(VTb + (16 + l15) * VTS + kk * 32 + quad * 8); \
                o0 = mma16(v0, fr##S[8 + kk], o0); o1 = mma16(v1, fr##S[8 + kk], o1); } \
            u32x2 p0, p1; p0.x = pk2(o0[0] * silu(bflo(g0##S.x)), o0[1] * silu(bfhi(g0##S.x))); p0.y = pk2(o0[2] * silu(bflo(g0##S.y)), o0[3] * silu(bfhi(g0##S.y))); \
            p1.x = pk2(o1[0] * silu(bflo(g1##S.x)), o1[1] * silu(bfhi(g1##S.x))); p1.y = pk2(o1[2] * silu(bflo(g1##S.y)), o1[3] * silu(bfhi(g1##S.y))); \
            bf16* op = Pb + (size_t)r0 * LD + offO; \
            if (!DRY || never) { *(u32x2*)op = p0; *(u32x2*)(op + 16) = p1; } \
            float ss0 = (o0[0] * o0[0] + o0[1] * o0[1]) + (o0[2] * o0[2] + o0[3] * o0[3]), ss1 = (o1[0] * o1[0] + o1[1] * o1[1]) + (o1[2] * o1[2] + o1[3] * o1[3]); \
            ss0 += __shfl_xor(ss0, 16); ss1 += __shfl_xor(ss1, 16); ss0 += __shfl_xor(ss0, 32); ss1 += __shfl_xor(ss1, 32); \
            if ((!DRY || never) && quad == 0) { float* sp = SS + (size_t)r0 * NH * 32 + offS; sp[0] = ss0; sp[1] = ss1; } \
            O_VT_WRITE(SN, VTn); } while (0)
        O_LOAD(A, 0); O_LOAD(B, 1);
        O_VT_WRITE(A, VT);
        for (int n0 = 0; n0 < NC; n0 += 3) {
            O_STEP(A, B, C, n0);
            if (n0 + 1 < NC) O_STEP(B, C, A, n0 + 1);
            if (n0 + 2 < NC) O_STEP(C, A, B, n0 + 2);
        }
#undef O_LOAD
#undef O_VT_WRITE
#undef O_STEP
    } else {
        const unsigned offK = (unsigned)((wq * 16 + (lane >> 5)) * LD + KOFF + h * 256 + (lane & 31) * 8);
        const unsigned offD = (unsigned)(lane * 4);
        const bool dw = (w == 4);
        f32x4 sacc[4][2];
#pragma unroll
        for (int a = 0; a < 4; ++a)
#pragma unroll
            for (int v = 0; v < 2; ++v) sacc[a][v] = (f32x4){0.f, 0.f, 0.f, 0.f};
        bf16x8 frA[8], frB[8], frC[8]; u32x4 vrA = {0u, 0u, 0u, 0u}, vrB = vrA, vrC = vrA;
#define S_LOAD(S, nn) do { const bf16* cb_ = Pb + (size_t)(b * SEQ + (nn) * C) * LD; \
            _Pragma("unroll") for (int a = 0; a < 4; ++a) _Pragma("unroll") for (int kk = 0; kk < 2; ++kk) { const bf16* ca_ = cb_ + (a * 4 + kk * 2) * LD; fr##S[a * 2 + kk] = *(const bf16x8*)(ca_ + offK); } \
            if (dw) vr##S = *(const u32x4*)(DEC + (size_t)((b * NC + (nn)) * NH + h) * 256 + offD); } while (0)
#define S_STEP(S, SN, SL, n_) do { const int n = (n_); const int buf = n & 1; \
            LAS bf16* VTb = VT + buf * VT_ELEMS; LAS bf16* STn = ST + (buf ^ 1) * ST_ELEMS; LAS float* DCb = DC + buf * 256; \
            LBAR(); \
            { const int nn_ = (n + 2 < NC) ? n + 2 : NC - 1; S_LOAD(SL, nn_); } \
            bf16x8 vf[2][2]; \
            _Pragma("unroll") for (int v = 0; v < 2; ++v) _Pragma("unroll") for (int kk = 0; kk < 2; ++kk) vf[v][kk] = *(const LAS bf16x8*)(VTb + (v * 16 + l15) * VTS + kk * 32 + quad * 8); \
            _Pragma("unroll") for (int a = 0; a < 4; ++a) { const f32x4 dc4 = *(const LAS f32x4*)(DCb + (wq * 4 + a) * 16 + quad * 4); \
                _Pragma("unroll") for (int v = 0; v < 2; ++v) { \
                    f32x4 s_ = sacc[a][v] * dc4; \
                    _Pragma("unroll") for (int kk = 0; kk < 2; ++kk) s_ = mma16(fr##S[a * 2 + kk], vf[v][kk], s_); \
                    sacc[a][v] = s_; u32x2 o_; o_.x = pk2(s_[0], s_[1]); o_.y = pk2(s_[2], s_[3]); \
                    *(LAS u32x2*)(STn + (v * 16 + l15) * STS + (wq * 4 + a) * 16 + quad * 4) = o_; } } \
            if (dw) *(LAS u32x4*)(DC + (buf ^ 1) * 256 + lane * 4) = vr##SN; } while (0)
        S_LOAD(A, 0); S_LOAD(B, 1);
        if (dw) *(LAS u32x4*)(DC + lane * 4) = vrA;
        for (int n0 = 0; n0 < NC; n0 += 3) {
            S_STEP(A, B, C, n0);
            if (n0 + 1 < NC) S_STEP(B, C, A, n0 + 1);
            if (n0 + 2 < NC) S_STEP(C, A, B, n0 + 2);
        }
#undef S_LOAD
#undef S_STEP
    }
    asm volatile("s_waitcnt vmcnt(0)" ::: "memory");
    __syncthreads();
}

template <int NH, int GOFF, bool DRY>
__device__ __forceinline__ void fin_phase(bf16* Pb, const float* SS, int gw, int ngw, int lane, int never) {
    for (int item = gw; item < T * NH; item += ngw) {
        const int tok = item / NH, h = item % NH;
        float s = (lane < 32) ? __builtin_nontemporal_load(SS + (size_t)item * 32 + lane) : 0.f; s = wave_sum(s);
        const float rstd = rsqrtf(s * (1.f / 512.f) + 1e-6f);
        bf16* rowp = Pb + (size_t)tok * LD + GOFF + h * 512 + lane * 8;
        const u32x4 o = *(const u32x4*)rowp;
        u32x4 r;
#pragma unroll
        for (int e = 0; e < 4; ++e) r[e] = pk2(bflo(o[e]) * rstd, bfhi(o[e]) * rstd);
        if (!DRY || never) *(u32x4*)rowp = r;
    }
}

__device__ __forceinline__ void lr_phase(const bf16* H, const bf16* WLRT, float* LR, int gw, int ngw, int lane) {
    const int l15 = lane & 15, quad = lane >> 4;
    for (int tile = gw; tile < T / 16; tile += ngw) {
        f32x4 acc = {0.f, 0.f, 0.f, 0.f};
        const bf16* ap = H + (size_t)(tile * 16 + l15) * DM + quad * 8; const bf16* bp = WLRT + (size_t)l15 * DM + quad * 8;
#pragma unroll 8
        for (int kk = 0; kk < 64; ++kk) acc = mma16(*(const bf16x8*)(ap + kk * 32), *(const bf16x8*)(bp + kk * 32), acc);
#pragma unroll
        for (int e = 0; e < 4; ++e) LR[(size_t)(tile * 16 + quad * 4 + e) * 16 + l15] = acc[e];
    }
}

template <bool DRY> __device__ __forceinline__ void glapre_unit(LAS unsigned char* lds, bf16* Pb, const float* LR, const float* w_lr, const float* b_lr, bf16* SC, float* DEC, int u, int tid, int never) {
    const int h = u & 7, n = (u >> 3) & 127, b = u >> 10;
    const int r0 = b * SEQ + n * 64;
    LAS bf16* Qs = (LAS bf16*)lds; LAS bf16* Ks = Qs + 64 * 264;
    LAS float* lrs = (LAS float*)(lds + 2 * 64 * 264 * 2); LAS float* tot = lrs + 1024;
    const int c = tid & 255, half = tid >> 8;
    const int wv = tid >> 6, lane = tid & 63, l15 = lane & 15, quad = lane >> 4;
    if (tid < 256) ((LAS f32x4*)lrs)[tid] = ((const f32x4*)(LR + (size_t)r0 * 16))[tid];
    float wl[16];
#pragma unroll
    for (int r = 0; r < 16; ++r) wl[r] = w_lr[r * 2048 + h * 256 + c];
    const float bb = b_lr[h * 256 + c];
    __syncthreads();
    float bc[32]; float run = 0.f;
#pragma unroll
    for (int i = 0; i < 32; ++i) { const int t = half * 32 + i; float z = bb;
#pragma unroll
        for (int r4 = 0; r4 < 4; ++r4) { const f32x4 l = ((const LAS f32x4*)lrs)[t * 4 + r4]; z += (l.x * wl[4 * r4] + l.y * wl[4 * r4 + 1]) + (l.z * wl[4 * r4 + 2] + l.w * wl[4 * r4 + 3]); }
        const float a = -(fmaxf(-z, 0.f) + __logf(1.f + __expf(-fabsf(z)))) * 0.0625f;
        run += a; bc[i] = run; }
    tot[half * 256 + c] = run;
    __syncthreads();
    const float t0 = tot[c], t1 = tot[256 + c]; const float blast = t0 + t1, off = half ? t0 : 0.f; const float eb = __expf(blast);
    LAS float* ebs = tot + 512;
    const bf16* gq = Pb + (size_t)(r0 + half * 32) * LD + h * 256 + c;
#pragma unroll
    for (int i = 0; i < 32; ++i) { const int t = half * 32 + i; const float bcv = bc[i] + off;
        const float q = bf2f(gq[(size_t)i * LD + Q1]), k = bf2f(gq[(size_t)i * LD + K1]);
        const float e = __expf(bcv), ei = __expf(-bcv);
        Qs[t * 264 + c] = (bf16)f2bf(q * 0.0625f * e); Ks[t * 264 + c] = (bf16)f2bf(k * ei); }
    if (half == 0) { ebs[c] = eb; if (!DRY || never) DEC[(size_t)u * 256 + c] = eb; }
    __syncthreads();
    for (int it = tid; it < 2048; it += 512) {
        const int fb = it >> 6, L = it & 63, tt = fb >> 3, kk = fb & 7, fl = L & 15, fq = L >> 4;
        const u32x4 v = *(const LAS u32x4*)(Qs + (tt * 16 + fl) * 264 + kk * 32 + fq * 8);
        if (!DRY || never) *(u32x4*)(Pb + (size_t)(r0 + 2 * fb + (L >> 5)) * LD + Q1 + h * 256 + (L & 31) * 8) = v;
    }
    for (int it = tid; it < 2048; it += 512) {
        const int fb = it >> 6, L = it & 63, kt = fb >> 1, kk = fb & 1, fl = L & 15, fq = L >> 4; const int k = kt * 16 + fl; const float ek = ebs[k];
        u32x4 o;
#pragma unroll
        for (int e2 = 0; e2 < 4; ++e2) { const int s_ = kk * 32 + fq * 8 + e2 * 2; o[e2] = pk2(bf2f(Ks[s_ * 264 + k]) * ek, bf2f(Ks[(s_ + 1) * 264 + k]) * ek); }
        if (!DRY || never) *(u32x4*)(Pb + (size_t)(r0 + 2 * fb + (L >> 5)) * LD + K1 + h * 256 + (L & 31) * 8) = o;
    }
#pragma unroll
    for (int tl = 0; tl < 2; ++tl) { const int tile = 2 * wv + tl, ti = tile >> 2, si = tile & 3; const int t = ti * 16 + l15;
        u32x2 w; w.x = 0u; w.y = 0u;
        if (si <= ti) { f32x4 acc = {0.f, 0.f, 0.f, 0.f};
#pragma unroll
            for (int kk = 0; kk < 8; ++kk) { const bf16x8 qf = *(const LAS bf16x8*)(Qs + t * 264 + kk * 32 + quad * 8); const bf16x8 kf = *(const LAS bf16x8*)(Ks + (si * 16 + l15) * 264 + kk * 32 + quad * 8); acc = mma16(kf, qf, acc); }
            float v[4];
#pragma unroll
            for (int e = 0; e < 4; ++e) { const int s = si * 16 + quad * 4 + e; v[e] = (s <= t) ? acc[e] : 0.f; }
            w.x = pk2(v[0], v[1]); w.y = pk2(v[2], v[3]); }
        if (!DRY || never) *(u32x2*)(SC + (size_t)u * 4096 + ((ti * 2 + (si >> 1)) * 64 + ((si & 1) * 2 + (quad >> 1)) * 16 + l15) * 8 + (quad & 1) * 4) = w; }
    __syncthreads();
}

#define RLX_AGENT __ATOMIC_RELAXED, __HIP_MEMORY_SCOPE_AGENT
#define XB_TMO      128
#define XB_XCNT(j)  (256  + 64 * (j))
#define XB_XSUB(j)  (1280 + 64 * (j))
#define XB_XGEN(j)  (2304 + 64 * (j))
#define XB_TOP      3328
#define XB_TOPGEN   3392
#define XCD_BAR_WORDS 3456
#define XB_SPIN_CAP (1u << 18)

__device__ __forceinline__ unsigned xb_ld(unsigned* p)              { return __hip_atomic_load(p, __ATOMIC_RELAXED, __HIP_MEMORY_SCOPE_AGENT); }
__device__ __forceinline__ unsigned xb_add(unsigned* p, unsigned v) { return __hip_atomic_fetch_add(p, v, __ATOMIC_RELAXED, __HIP_MEMORY_SCOPE_AGENT); }
__device__ __forceinline__ unsigned xb_xcc_id() { return (unsigned)__builtin_amdgcn_s_getreg((3 << 11) | 20) & 0xFu; }
#define XB_SPIN(cond, bar) do { unsigned _sp = 0; while (cond) { __builtin_amdgcn_s_sleep(1); \
    if ((++_sp & 255u) == 0u) { if (xb_ld(&(bar)[XB_TMO])) break; if (_sp > XB_SPIN_CAP) { atomicAdd(&(bar)[XB_TMO], 1u); break; } } } } while (0)

struct XcdBarrier {
    unsigned* bar; unsigned x;
    volatile LAS unsigned* st;
};

__device__ __forceinline__ XcdBarrier xcd_barrier_post(unsigned* bar, volatile LAS unsigned* st) {
    XcdBarrier b; b.bar = bar; b.x = xb_xcc_id(); b.st = st;
    if (threadIdx.x == 0) (void)xb_add(&bar[XB_XCNT(b.x)], 1u);
    return b;
}
__device__ __forceinline__ void xcd_barrier_complete(unsigned* bar, unsigned x, unsigned& nloc, unsigned& nx) {
    const unsigned G = gridDim.x * gridDim.y * gridDim.z;
    unsigned sum, cnt, mine, sp = 0u;
    for (;;) {
        sum = 0u; cnt = 0u; mine = 0u;
#pragma unroll
        for (unsigned j = 0; j < 16; ++j) { const unsigned c = xb_ld(&bar[XB_XCNT(j)]); sum += c; cnt += (c > 0u) ? 1u : 0u; mine = (j == x) ? c : mine; }
        if (sum == G) break;
        __builtin_amdgcn_s_sleep(1);
        if ((++sp & 255u) == 0u) { if (xb_ld(&bar[XB_TMO])) break; if (sp > XB_SPIN_CAP) { atomicAdd(&bar[XB_TMO], 1u); break; } }
    }
    nloc = mine > 0u ? mine : 1u; nx = cnt > 0u ? cnt : 1u;
}

__device__ __forceinline__ void xcd_barrier(const XcdBarrier& b) {
    asm volatile("s_waitcnt vmcnt(0)" ::: "memory");
    __syncthreads();
    if (threadIdx.x == 0) {
        unsigned* bar = b.bar;
        __builtin_amdgcn_s_waitcnt(0);
        unsigned nloc = b.st[0], nx = b.st[1];
        if (nloc == 0u) { xcd_barrier_complete(bar, b.x, nloc, nx); b.st[0] = nloc; b.st[1] = nx; }
        const unsigned old = xb_add(&bar[XB_XSUB(b.x)], 1u);
        const unsigned gen = old / nloc;
        if (old + 1u == (gen + 1u) * nloc) {
            __builtin_amdgcn_fence(__ATOMIC_RELEASE, "agent");
            asm volatile("s_waitcnt vmcnt(0)" ::: "memory");
            const unsigned og = xb_add(&bar[XB_TOP], 1u);
            const unsigned tg = og / nx;
            if (og + 1u == (tg + 1u) * nx) xb_add(&bar[XB_TOPGEN], 1u);
            else XB_SPIN(xb_ld(&bar[XB_TOPGEN]) == tg, bar);
            __builtin_amdgcn_fence(__ATOMIC_ACQUIRE, "agent");
            xb_add(&bar[XB_XGEN(b.x)], 1u);
            asm volatile("s_waitcnt vmcnt(0)" ::: "memory");
        } else {
            XB_SPIN(xb_ld(&bar[XB_XGEN(b.x)]) == gen, bar);
            __builtin_amdgcn_fence(__ATOMIC_ACQUIRE, "agent");
            asm volatile("s_waitcnt vmcnt(0)" ::: "memory");
        }
    }
    __syncthreads();
}

template <int NH>
__device__ __forceinline__ void build_hs_table(LAS float* tab, const float* SS, int pm, int tid) {
    for (int it = tid; it < 256 * NH; it += 512) { const int row = it / NH, h = it % NH;
        const f32x4* sp = (const f32x4*)(SS + ((size_t)(pm * 256 + row) * NH + h) * 32);
        float s = 0.f;
#pragma unroll
        for (int i = 0; i < 8; ++i) { const f32x4 v = sp[i]; s += (v.x + v.y) + (v.z + v.w); }
        tab[h * 256 + row] = rsqrtf(s * (1.f / 512.f) + 1e-6f); }
    __syncthreads();
    float f[NH / 2];
#pragma unroll
    for (int k = 0; k < NH / 2; ++k) { const int it = tid + 512 * k, j = it >> 8, row = it & 255; f[k] = (j < NH - 1) ? tab[j * 256 + row] / tab[(j + 1) * 256 + row] : tab[j * 256 + row]; }
    __syncthreads();
#pragma unroll
    for (int k = 0; k < NH / 2; ++k) tab[tid + 512 * k] = f[k];
    __syncthreads();
}

struct Args { const float* x; const int* pos; const float* ev_norm; const float* ev_w_in; const float* sgu_gain; const float* sgu_w_s; const float* sgu_b; const float* ev_w_out;
              const float* od_norm; const float* od_w_in; const float* gla_w_lr; const float* gla_b_lr; const float* od_w_out; const float* final_norm; float* out; unsigned char* ws; int never; int pad; };

__global__ void __launch_bounds__(512, 2) trunk_fwd(Args a) {
    extern __shared__ __attribute__((aligned(16))) unsigned char lds_raw[];
    LAS unsigned char* lds = (LAS unsigned char*)lds_raw;
    cg::grid_group grid = cg::this_grid();
    volatile LAS unsigned* xbst = (volatile LAS unsigned*)(lds + 131072 + 8 * 2304);
    if (threadIdx.x < 2) xbst[threadIdx.x] = 0u;
    __syncthreads();
    XcdBarrier xbar = xcd_barrier_post((unsigned*)a.ws, xbst);
    const int G = gridDim.x, bid = blockIdx.x, ngw = G * 8;
#define PH_BEGIN int t_ = threadIdx.x; asm volatile("" : "+v"(t_)); const int tid = t_, lane = tid & 63, wave = __builtin_amdgcn_readfirstlane(tid >> 6), gw = bid * 8 + wave; LAS float* scr = (LAS float*)(lds + wave * 16384); (void)lane; (void)gw; (void)scr;
    unsigned char* ws = a.ws;
    float* LR = (float*)(ws + WS_LR); bf16* WLRT = (bf16*)(ws + WS_WLRT); float* DEC = (float*)(ws + WS_DEC);
    bf16* WA = (bf16*)(ws + WS_WA); bf16* H = (bf16*)(ws + WS_H); bf16* Pb = (bf16*)(ws + WS_P);
    bf16* SC = (bf16*)(ws + WS_SC); float* SS = (float*)(ws + WS_SS); bf16* WO0 = (bf16*)(ws + WS_WO0);

    { PH_BEGIN
    for (int rep = 0; rep < 1 + ((PROBE >> 11) & 1); ++rep) {
    transpose_all<true>(a.ev_w_in, 12288, 2048, 12288, WA, scr, gw, ngw, lane);
    for (int m = gw; m < T; m += ngw) rms_row_bf16(a.x + (size_t)m * DM, a.ev_norm, H + (size_t)m * DM, lane);
    }
    }
    xcd_barrier(xbar);
    { PH_BEGIN
    if ((PROBE >> 15) & 1) { pg8::Gemm g{H, WA, T, 12288, 2048, 2048}; pg8::StaticOrder S; S.init(T, 12288, G, bid); pg8::EpiHot E{(bf16*)a.out};
      pg8::gemm_phase<pg8::EpiHot, pg8::StaticOrder, true, true>(lds, g, S, E); }
    for (int rep = 0; rep < 1 + ((PROBE >> 1) & 1); ++rep)
    { pg8::Gemm g{H, WA, T, 12288, 2048, 2048}; pg8::StaticOrder S; S.init(T, 12288, G, bid); pg8::EpiBf16W E{Pb, LD, lds + 131072};
      pg8::gemm_phase<pg8::EpiBf16W, pg8::StaticOrder, true, true>(lds, g, S, E); }
    }
    xcd_barrier(xbar);
    { PH_BEGIN
    if ((PROBE >> 2) & 1) for (int u = bid; u < 1024; u += G) retpre_unit<true>(lds, Pb, a.pos, SC, DEC, u, tid, a.never);
    for (int u = bid; u < 1024; u += G) retpre_unit<false>(lds, Pb, a.pos, SC, DEC, u, tid, a.never);
    }
    xcd_barrier(xbar);
    { PH_BEGIN
    for (int v = bid; v < 256; v += G) { const int xcd = v & 7, idx = v >> 3;
        if (idx < 16) { const int wk = xcd * 16 + idx;
            if ((PROBE >> 4) & 1) scan_worker<4, Q0, K0, V0, GR0, true>(lds, Pb, SC, DEC, SS, wk, tid, a.never);
            scan_worker<4, Q0, K0, V0, GR0, false>(lds, Pb, SC, DEC, SS, wk, tid, a.never);
        } else { const int hi = (idx - 16) * 8 + xcd;
            if ((PROBE >> 3) & 1) for (int u = hi; u < 1024; u += 128) sgu_unit<true>(lds, Pb, a.sgu_gain, a.sgu_w_s, a.sgu_b, u, tid, a.never);
            for (int u = hi; u < 1024; u += 128) sgu_unit<false>(lds, Pb, a.sgu_gain, a.sgu_w_s, a.sgu_b, u, tid, a.never);
            transpose_all<false>(a.ev_w_out, 2048, 4096, 2048, WO0, scr, hi * 8 + wave, 128 * 8, lane);
            transpose_all<false>(a.od_w_in, 12304, 2048, 12288, WA, scr, hi * 8 + wave, 128 * 8, lane);
        } }
    }
    grid.sync();
    if (G != 256) {
    { PH_BEGIN
    if ((PROBE >> 5) & 1) fin_phase<4, GR0, true>(Pb, SS, gw, ngw, lane, a.never);
    fin_phase<4, GR0, false>(Pb, SS, gw, ngw, lane, a.never);
    }
    xcd_barrier(xbar);
    }
    { PH_BEGIN
    { pg8::Gemm g{Pb + MIXC, WO0, T, 2048, 4096, LD}; pg8::StaticOrder S; S.init(T, 2048, G, bid); pg8::EpiBf16W E{(bf16*)a.out, 2 * DM, lds + 131072};
      if (G == 256) { pg8::Unit u0; S.next(0, u0); LAS float* tab = (LAS float*)(lds + HS_OFF); build_hs_table<4>(tab, SS, u0.pm, tid);
        pg8::gemm_phase<pg8::EpiBf16W, pg8::StaticOrder, true, true, 4>(lds, g, S, E, tab); }
      else pg8::gemm_phase<pg8::EpiBf16W, pg8::StaticOrder, true, true>(lds, g, S, E); }
    }
    xcd_barrier(xbar);
    { PH_BEGIN
    for (int m = gw; m < T; m += ngw) res_rms_row_bf16(a.x + (size_t)m * DM, (const bf16*)a.out + (size_t)m * 2 * DM, a.od_norm, H + (size_t)m * DM, lane);
    for (int i = bid * 512 + tid; i < 16 * 2048; i += G * 512) { const int r = i >> 11, k = i & 2047; WLRT[i] = (bf16)f2bf(a.od_w_in[(size_t)k * 12304 + 12288 + r]); }
    }
    xcd_barrier(xbar);
    { PH_BEGIN
    lr_phase(H, WLRT, LR, gw, ngw, lane);
    { pg8::Gemm g{H, WA, T, 12288, 2048, 2048}; pg8::StaticOrder S; S.init(T, 12288, G, bid); pg8::EpiBf16W E{Pb, LD, lds + 131072};
      pg8::gemm_phase<pg8::EpiBf16W, pg8::StaticOrder, true, true>(lds, g, S, E); }
    }
    xcd_barrier(xbar);
    { PH_BEGIN
    if ((PROBE >> 8) & 1) for (int u = bid; u < 2048; u += G) glapre_unit<true>(lds, Pb, LR, a.gla_w_lr, a.gla_b_lr, SC, DEC, u, tid, a.never);
    for (int u = bid; u < 2048; u += G) glapre_unit<false>(lds, Pb, LR, a.gla_w_lr, a.gla_b_lr, SC, DEC, u, tid, a.never);
    transpose_all<false>(a.od_w_out, 2048, 4096, 2048, WA, scr, gw, ngw, lane);
    }
    xcd_barrier(xbar);
    { PH_BEGIN
    for (int v = bid; v < 256; v += G) { const int xcd = v & 7, idx = v >> 3; const int wk = (xcd * 2 + (idx >> 4)) * 16 + (idx & 15);
        if ((PROBE >> 9) & 1) scan_worker<8, Q1, K1, V1, G1, true>(lds, Pb, SC, DEC, SS, wk, tid, a.never);
        scan_worker<8, Q1, K1, V1, G1, false>(lds, Pb, SC, DEC, SS, wk, tid, a.never); }
    }
    xcd_barrier(xbar);
    if (G != 256) {
    { PH_BEGIN
    if ((PROBE >> 10) & 1) fin_phase<8, G1, true>(Pb, SS, gw, ngw, lane, a.never);
    fin_phase<8, G1, false>(Pb, SS, gw, ngw, lane, a.never);
    }
    xcd_barrier(xbar);
    }
    { PH_BEGIN
    { pg8::Gemm g{Pb + MIXC, WA, T, 2048, 4096, LD}; pg8::StaticOrder S; S.init(T, 2048, G, bid); pg8::EpiBf16W E{Pb, LD, lds + 131072};
      if (G == 256) { pg8::Unit u0; S.next(0, u0); LAS float* tab = (LAS float*)(lds + HS_OFF); build_hs_table<8>(tab, SS, u0.pm, tid);
        pg8::gemm_phase<pg8::EpiBf16W, pg8::StaticOrder, true, true, 8>(lds, g, S, E, tab); }
      else pg8::gemm_phase<pg8::EpiBf16W, pg8::StaticOrder, true, true>(lds, g, S, E); }
    }
    xcd_barrier(xbar);
    if ((PROBE >> 12) & 1) { for (int rep = 0; rep < 12; ++rep) xcd_barrier(xbar); }
    { PH_BEGIN
    for (int m = gw; m < T; m += ngw) res_rms_row_f32(a.x + (size_t)m * DM, a.out + (size_t)m * DM, Pb + (size_t)m * LD, a.final_norm, lane);
    }
}

extern "C" void kernel_launch(void* const* d_in, const int* in_sizes, int n_in, void* d_out, int out_size, void* d_ws, size_t ws_size, hipStream_t stream) {
    static int grid = 0;
    if (grid == 0) {
        if (n_in != 14 || out_size != T * DM || ws_size < WS_END) { fprintf(stderr, "kernel_launch: unexpected shapes (n_in %d out %d ws %zu)\n", n_in, out_size, ws_size); grid = -1; return; }
        int dev = 0, cus = 0, per_cu = 0;
        (void)hipGetDevice(&dev);
        (void)hipDeviceGetAttribute(&cus, hipDeviceAttributeMultiprocessorCount, dev);
        (void)hipFuncSetAttribute((const void*)trunk_fwd, hipFuncAttributeMaxDynamicSharedMemorySize, LDS_BYTES);
        (void)hipOccupancyMaxActiveBlocksPerMultiprocessor(&per_cu, (const void*)trunk_fwd, 512, LDS_BYTES);
        if (per_cu < 1) per_cu = 1;
        grid = cus * per_cu;
    }
    if (grid < 0) return;
    (void)hipMemsetAsync(d_ws, 0, 16384, stream);
    Args a{};
    a.x = (const float*)d_in[0]; a.pos = (const int*)d_in[1]; a.ev_norm = (const float*)d_in[2]; a.ev_w_in = (const float*)d_in[3]; a.sgu_gain = (const float*)d_in[4];
    a.sgu_w_s = (const float*)d_in[5]; a.sgu_b = (const float*)d_in[6]; a.ev_w_out = (const float*)d_in[7]; a.od_norm = (const float*)d_in[8]; a.od_w_in = (const float*)d_in[9];
    a.gla_w_lr = (const float*)d_in[10]; a.gla_b_lr = (const float*)d_in[11]; a.od_w_out = (const float*)d_in[12]; a.final_norm = (const float*)d_in[13];
    a.out = (float*)d_out; a.ws = (unsigned char*)d_ws;
    void* args[] = {&a};
    hipError_t e = hipLaunchCooperativeKernel((void*)trunk_fwd, dim3(grid), dim3(512), args, LDS_BYTES, stream);
    if (e != hipSuccess) fprintf(stderr, "kernel_launch: cooperative launch failed: %s (grid %d)\n", hipGetErrorString(e), grid);
}
```

```cpp
#include <hip/hip_runtime.h>
#include <hip/hip_cooperative_groups.h>
#include <cstdio>
#include <cstdint>
namespace cg = cooperative_groups;

namespace pg8 {
#define PG8_LAS __attribute__((address_space(3)))
typedef unsigned short bf16_t;
typedef short bf16x8 __attribute__((ext_vector_type(8)));
typedef float f32x4 __attribute__((ext_vector_type(4)));
typedef unsigned u32x4 __attribute__((ext_vector_type(4)));
constexpr int BM = 256, BK = 64, HALF = 128, HTB = HALF * BK * 2, STAGE_BYTES = 8 * HTB, NXCD = 8, WGM = 8;
__host__ __device__ __forceinline__ int lds_byte(int r, int c) { const int st = (r >> 4) * 2 + (c >> 5), rr = r & 15, cc = c & 31, ob = rr * 64 + cc * 2; return st * 1024 + (ob ^ (((ob >> 9) & 1) << 5)); }
__host__ __device__ __forceinline__ void stage_rc(int b, int& R, int& C) { const int st = b / 1024, sb = b % 1024, swz = sb ^ (((sb >> 9) & 1) << 5); R = (st >> 1) * 16 + swz / 64; C = (st & 1) * 32 + (swz % 64) / 2; }
__host__ __device__ __forceinline__ int perm32(int rho) { const int n = rho >> 4, i = rho & 15; return 8 * (i >> 2) + 4 * n + (i & 3); }
struct Unit { int pm, pn; };
struct Gemm { const bf16_t* A; const bf16_t* Bt; int M, N, K, lda; };
struct StaticOrder {
    int nM, nN, nwg, G, c;
    __host__ __device__ void init(int M, int N, int G_, int c_) { nM = M / BM; nN = N / BM; nwg = nM * nN; G = G_; c = c_; }
    __host__ __device__ bool next(int i, Unit& u) const {
        const long L = (long)i * G + c; if (L >= nwg) return false;
        int wgid = (int)L; { const int q = nwg / NXCD, r = nwg % NXCD, xcd = wgid % NXCD, off = wgid / NXCD; wgid = (xcd < r ? xcd * (q + 1) : r * (q + 1) + (xcd - r) * q) + off; }
        const int nig = WGM * nN, gid = wgid / nig, fm = gid * WGM, gsz = (nM - fm) < WGM ? (nM - fm) : WGM;
        u.pm = fm + ((wgid % nig) % gsz); u.pn = (wgid % nig) / gsz; return true;
    }
    __device__ __forceinline__ void a_ready(const Unit&) const {}
    __device__ __forceinline__ void done(const Unit&) const {}
};
typedef float f32x2c __attribute__((ext_vector_type(2)));
typedef __bf16 bf16x2c __attribute__((ext_vector_type(2)));
__device__ __forceinline__ unsigned cvt_pk_bf16(float lo, float hi) { const f32x2c v = {lo, hi}; const bf16x2c b = __builtin_convertvector(v, bf16x2c); return __builtin_bit_cast(unsigned, b); }
struct EpiBf16P {
    static constexpr bool PERM = true, WIDE = false, AFTER_DRAIN = false;
    bf16_t* O; int ldc;
    __device__ __forceinline__ void operator()(const f32x4 (&acc)[2][2][4][2], const Unit& u, int wr, int wc, int fr, int fq) const {
        const int row0 = u.pm * BM + wr * 64 + fr, col0 = u.pn * BM + wc * 32 + 8 * fq;
#pragma unroll
        for (int ai = 0; ai < 2; ++ai)
#pragma unroll
            for (int m = 0; m < 4; ++m) { bf16_t* rowp = O + (size_t)(row0 + ai * HALF + m * 16) * ldc + col0;
#pragma unroll
                for (int bj = 0; bj < 2; ++bj) { const f32x4 v0 = acc[ai][bj][m][0], v1 = acc[ai][bj][m][1];
                    u32x4 w; w.x = cvt_pk_bf16(v0[0], v0[1]); w.y = cvt_pk_bf16(v0[2], v0[3]); w.z = cvt_pk_bf16(v1[0], v1[1]); w.w = cvt_pk_bf16(v1[2], v1[3]);
                    *(u32x4*)(rowp + bj * HALF) = w; } }
    }
};
struct EpiNull {
    static constexpr bool PERM = false, WIDE = false, AFTER_DRAIN = false;
    float* out; int never;
    __device__ __forceinline__ void operator()(const f32x4 (&acc)[2][2][4][2], const Unit& u, int wr, int wc, int fr, int fq) const {
        f32x4 s = {0.f, 0.f, 0.f, 0.f};
#pragma unroll
        for (int ai = 0; ai < 2; ++ai)
#pragma unroll
            for (int bj = 0; bj < 2; ++bj)
#pragma unroll
                for (int m = 0; m < 4; ++m)
#pragma unroll
                    for (int n = 0; n < 2; ++n) s += acc[ai][bj][m][n];
        if (never) *(f32x4*)(out + (size_t)(u.pm * BM + wr * 64 + fr) * 2048 + u.pn * BM + wc * 32 + 4 * fq) = s;
    }
};
struct EpiBf16W {
    static constexpr bool PERM = true, WIDE = true, AFTER_DRAIN = false;
    bf16_t* O; int ldc; PG8_LAS unsigned char* stg;
    __device__ __forceinline__ void operator()(const f32x4 (&acc)[2][2][4][2], const Unit& u, int wr, int wc, int fr, int fq) const {
        PG8_LAS unsigned char* my = stg + (wr * 4 + wc) * 2304;
        const int lane = fq * 16 + fr, rrow = lane >> 3, rc8 = lane & 7;
        bf16_t* obase = O + (size_t)(u.pm * BM + wr * 64 + rrow) * ldc + u.pn * BM + wc * 64 + rc8 * 8;
#pragma unroll
        for (int ai = 0; ai < 2; ++ai)
#pragma unroll
            for (int m = 0; m < 4; ++m) {
                u32x4 w0, w1;
                w0.x = cvt_pk_bf16(acc[ai][0][m][0][0], acc[ai][0][m][0][1]); w0.y = cvt_pk_bf16(acc[ai][0][m][0][2], acc[ai][0][m][0][3]);
                w0.z = cvt_pk_bf16(acc[ai][0][m][1][0], acc[ai][0][m][1][1]); w0.w = cvt_pk_bf16(acc[ai][0][m][1][2], acc[ai][0][m][1][3]);
                w1.x = cvt_pk_bf16(acc[ai][1][m][0][0], acc[ai][1][m][0][1]); w1.y = cvt_pk_bf16(acc[ai][1][m][0][2], acc[ai][1][m][0][3]);
                w1.z = cvt_pk_bf16(acc[ai][1][m][1][0], acc[ai][1][m][1][1]); w1.w = cvt_pk_bf16(acc[ai][1][m][1][2], acc[ai][1][m][1][3]);
                *(PG8_LAS u32x4*)(my + fr * 144 + fq * 32) = w0; *(PG8_LAS u32x4*)(my + fr * 144 + fq * 32 + 16) = w1;
                asm volatile("s_waitcnt lgkmcnt(0)" ::: "memory");
                const u32x4 r0 = *(const PG8_LAS u32x4*)(my + rrow * 144 + rc8 * 16), r1 = *(const PG8_LAS u32x4*)(my + (8 + rrow) * 144 + rc8 * 16);
                asm volatile("s_waitcnt lgkmcnt(0)" ::: "memory");
                bf16_t* op = obase + (size_t)(ai * HALF + m * 16) * ldc;
                __builtin_nontemporal_store(r0, (u32x4*)op); __builtin_nontemporal_store(r1, (u32x4*)(op + (size_t)8 * ldc));
            }
    }
};
struct EpiHot {
    static constexpr bool PERM = true, WIDE = false, AFTER_DRAIN = false;
    bf16_t* O;
    __device__ __forceinline__ void operator()(const f32x4 (&acc)[2][2][4][2], const Unit& u, int wr, int wc, int fr, int fq) const {
        const int row0 = wr * 64 + fr, col0 = wc * 32 + 8 * fq;
#pragma unroll
        for (int ai = 0; ai < 2; ++ai)
#pragma unroll
            for (int m = 0; m < 4; ++m) { bf16_t* rowp = O + (size_t)blockIdx.x * 65536 + (size_t)(row0 + ai * HALF + m * 16) * 256 + col0;
#pragma unroll
                for (int bj = 0; bj < 2; ++bj) { const f32x4 v0 = acc[ai][bj][m][0], v1 = acc[ai][bj][m][1];
                    u32x4 w; w.x = cvt_pk_bf16(v0[0], v0[1]); w.y = cvt_pk_bf16(v0[2], v0[3]); w.z = cvt_pk_bf16(v1[0], v1[1]); w.w = cvt_pk_bf16(v1[2], v1[3]);
                    *(u32x4*)(rowp + bj * HALF) = w; } }
    }
};
struct EpiF32P {
    static constexpr bool PERM = true, WIDE = false, AFTER_DRAIN = false;
    float* out; int ldc;
    __device__ __forceinline__ void operator()(const f32x4 (&acc)[2][2][4][2], const Unit& u, int wr, int wc, int fr, int fq) const {
        const int row0 = u.pm * BM + wr * 64 + fr, col0 = u.pn * BM + wc * 32 + 8 * fq;
#pragma unroll
        for (int ai = 0; ai < 2; ++ai)
#pragma unroll
            for (int m = 0; m < 4; ++m) { float* rowp = out + (size_t)(row0 + ai * HALF + m * 16) * ldc + col0;
#pragma unroll
                for (int bj = 0; bj < 2; ++bj) { *(f32x4*)(rowp + bj * HALF) = acc[ai][bj][m][0]; *(f32x4*)(rowp + bj * HALF + 4) = acc[ai][bj][m][1]; } }
    }
};
template <class Epi, class Sched, bool ALIGN_EPI = false, bool SP2 = false, int NHS = 0>
__device__ __forceinline__ void gemm_phase(PG8_LAS unsigned char* lds, const Gemm g, const Sched& S, const Epi& E, const PG8_LAS float* hs = nullptr) {
    int tid_ = threadIdx.x; asm volatile("" : "+v"(tid_));
    const int tid = tid_, wid = __builtin_amdgcn_readfirstlane(tid >> 6), lane = tid & 63, wr = wid >> 2, wc = wid & 3, fr = lane & 15, fq = lane >> 4;
    const int K = g.K, nt = K / BK;
    unsigned voffA[2], voffB[2];
#pragma unroll
    for (int i = 0; i < 2; ++i) { int R, C; stage_rc(tid * 16 + i * 8192, R, C); const int Rb = Epi::WIDE ? (64 * (R >> 5) + 16 * ((R & 15) >> 2) + 4 * ((R >> 4) & 1) + (R & 3)) : (Epi::PERM ? ((R & ~31) + perm32(R & 31)) : R);
        voffA[i] = (unsigned)(R * g.lda + C) * 2u; voffB[i] = (unsigned)(Rb * K + C) * 2u; }
    const size_t kstep = (size_t)(BK * 2);
    const size_t hstepA = (size_t)HALF * g.lda * 2, hstepB = Epi::WIDE ? (size_t)8 * K * 2 : (size_t)HALF * K * 2;
    const size_t tstepA = 2 * hstepA, tstepB = (size_t)BM * K * 2;
    const unsigned ldsw = (unsigned)wid * 1024u;
    const int aoff = lds_byte(wr * 64 + fr, fq * 8), boff = lds_byte(wc * 32 + fr, fq * 8);
#define PG8_SA(b, h) (((b) * 2 + (h)) * HTB)
#define PG8_SB(b, h) ((4 + (b) * 2 + (h)) * HTB)
#define PG8_STAGE(bufoff, gbase, voff) do { _Pragma("unroll") for (int _i = 0; _i < 2; ++_i) \
        __builtin_amdgcn_global_load_lds((const unsigned*)((const char*)(gbase) + (voff)[_i]), (PG8_LAS unsigned*)(lds + (bufoff) + ldsw + _i * 8192), 16, 0, 0); } while (0)
#define PG8_LDA(dst, b, h) do { _Pragma("unroll") for (int m = 0; m < 4; ++m) _Pragma("unroll") for (int k = 0; k < 2; ++k) dst[m][k] = *(const PG8_LAS bf16x8*)(lds + PG8_SA(b, h) + aoff + m * 2048 + k * 1024); } while (0)
#define PG8_LDB(dst, b, h) do { _Pragma("unroll") for (int n = 0; n < 2; ++n) _Pragma("unroll") for (int k = 0; k < 2; ++k) dst[n][k] = *(const PG8_LAS bf16x8*)(lds + PG8_SB(b, h) + boff + n * 2048 + k * 1024); } while (0)
#define PG8_MMA(ai, bj, At, Bt) do { __builtin_amdgcn_s_setprio(1); _Pragma("unroll") for (int m = 0; m < 4; ++m) _Pragma("unroll") for (int n = 0; n < 2; ++n) _Pragma("unroll") for (int k = 0; k < 2; ++k) \
        acc[ai][bj][m][n] = __builtin_amdgcn_mfma_f32_16x16x32_bf16(Bt[n][k], At[m][k], acc[ai][bj][m][n], 0, 0, 0); __builtin_amdgcn_s_setprio(0); } while (0)
#define PG8_WAIT_V(n) asm volatile("s_waitcnt vmcnt(" #n ")" ::: "memory")
#define PG8_WAIT_L(n) asm volatile("s_waitcnt lgkmcnt(" #n ")" ::: "memory")
#define PG8_BAR __builtin_amdgcn_s_barrier()
#define PG8_SCHED __builtin_amdgcn_sched_barrier(0)
    Unit cur, nxt; int ui = 0;
    if (!S.next(0, cur)) return;
    f32x4 acc[2][2][4][2];
#pragma unroll
    for (int a = 0; a < 2; ++a)
#pragma unroll
        for (int b = 0; b < 2; ++b)
#pragma unroll
            for (int m = 0; m < 4; ++m)
#pragma unroll
                for (int n = 0; n < 2; ++n) acc[a][b][m][n] = (f32x4){0.f, 0.f, 0.f, 0.f};
    bf16x8 At[4][2], B0[2][2], B1[2][2];
    const char* cA = (const char*)g.A + (size_t)cur.pm * tstepA; const char* cB = (const char*)g.Bt + (size_t)cur.pn * tstepB;
    S.a_ready(cur);
    if constexpr (SP2) {
        PG8_STAGE(PG8_SB(0, 0), cB, voffB); PG8_STAGE(PG8_SB(0, 1), cB + hstepB, voffB); PG8_STAGE(PG8_SA(0, 0), cA, voffA); PG8_STAGE(PG8_SA(0, 1), cA + hstepA, voffA);
        if (wr == 1) PG8_BAR;
        PG8_WAIT_V(2); PG8_BAR;
        PG8_STAGE(PG8_SB(1, 0), cB + kstep, voffB); PG8_STAGE(PG8_SA(1, 0), cA + kstep, voffA); PG8_STAGE(PG8_SB(1, 1), cB + hstepB + kstep, voffB);
        PG8_WAIT_V(6); PG8_BAR;
    } else {
        PG8_STAGE(PG8_SB(0, 0), cB, voffB); PG8_STAGE(PG8_SA(0, 0), cA, voffA); PG8_STAGE(PG8_SB(0, 1), cB + hstepB, voffB); PG8_STAGE(PG8_SA(0, 1), cA + hstepA, voffA);
        if (wr == 1) PG8_BAR;
        PG8_WAIT_V(4); PG8_BAR;
        PG8_STAGE(PG8_SB(1, 0), cB + kstep, voffB); PG8_STAGE(PG8_SA(1, 0), cA + kstep, voffA); PG8_STAGE(PG8_SB(1, 1), cB + hstepB + kstep, voffB);
        PG8_WAIT_V(6); PG8_BAR;
    }
    for (;;) {
        const bool has_next = S.next(ui + 1, nxt);
        const char* nA = has_next ? (const char*)g.A + (size_t)nxt.pm * tstepA : cA; const char* nB = has_next ? (const char*)g.Bt + (size_t)nxt.pn * tstepB : cB;
        for (int t = 0; t < nt; t += 2) {
            const bool last = (t == nt - 2);
            const char* a1 = cA + (size_t)(t + 1) * kstep;
            const char* a2 = last ? nA : cA + (size_t)(t + 2) * kstep; const char* b2 = last ? nB : cB + (size_t)(t + 2) * kstep;
            const char* a3 = a2 + kstep; const char* b3 = b2 + kstep;
            if (last && has_next) S.a_ready(nxt);
            if constexpr (SP2) {
            PG8_LDB(B0, 0, 0); PG8_LDB(B1, 0, 1); PG8_SCHED; PG8_LDA(At, 0, 0); PG8_STAGE(PG8_SA(1, 1), a1 + hstepA, voffA);
            PG8_WAIT_V(8); PG8_WAIT_L(0); PG8_BAR; PG8_MMA(0, 0, At, B0); PG8_MMA(0, 1, At, B1); PG8_BAR; PG8_SCHED;
            PG8_LDA(At, 0, 1); PG8_STAGE(PG8_SB(0, 0), b2, voffB); PG8_STAGE(PG8_SB(0, 1), b2 + hstepB, voffB); PG8_STAGE(PG8_SA(0, 0), a2, voffA);
            PG8_WAIT_V(8); PG8_WAIT_L(0); PG8_BAR; PG8_MMA(1, 0, At, B0); PG8_MMA(1, 1, At, B1); PG8_BAR; PG8_SCHED;
            PG8_LDB(B0, 1, 0); PG8_LDB(B1, 1, 1); PG8_SCHED; PG8_LDA(At, 1, 0); PG8_STAGE(PG8_SA(0, 1), a2 + hstepA, voffA);
            PG8_WAIT_V(8); PG8_WAIT_L(0); PG8_BAR; PG8_MMA(0, 0, At, B0); PG8_MMA(0, 1, At, B1); PG8_BAR; PG8_SCHED;
            PG8_LDA(At, 1, 1); PG8_STAGE(PG8_SB(1, 0), b3, voffB); PG8_STAGE(PG8_SB(1, 1), b3 + hstepB, voffB); PG8_STAGE(PG8_SA(1, 0), a3, voffA);
            PG8_WAIT_V(8); PG8_WAIT_L(0); PG8_BAR; PG8_MMA(1, 0, At, B0); PG8_MMA(1, 1, At, B1); PG8_BAR; PG8_SCHED;
            if constexpr (NHS > 0) {
                if (((t + 2) & 7) == 0 && ((t + 2) >> 3) <= NHS) { const PG8_LAS float* tp = hs + (((t + 2) >> 3) - 1) * 256 + wr * 64 + fr;
#pragma unroll
                    for (int ai = 0; ai < 2; ++ai)
#pragma unroll
                        for (int m = 0; m < 4; ++m) { const float f = tp[ai * HALF + m * 16];
#pragma unroll
                            for (int bj = 0; bj < 2; ++bj)
#pragma unroll
                                for (int n = 0; n < 2; ++n) acc[ai][bj][m][n] *= f; }
                    PG8_SCHED; }
            }
            } else {
            PG8_LDB(B0, 0, 0); PG8_SCHED; PG8_LDA(At, 0, 0); PG8_STAGE(PG8_SA(1, 1), a1 + hstepA, voffA);
            PG8_WAIT_L(8); PG8_BAR; PG8_WAIT_L(0); PG8_MMA(0, 0, At, B0); PG8_BAR; PG8_SCHED;
            PG8_LDB(B1, 0, 1); PG8_STAGE(PG8_SB(0, 0), b2, voffB);
            PG8_BAR; PG8_WAIT_L(0); PG8_MMA(0, 1, At, B1); PG8_BAR;
            PG8_LDA(At, 0, 1); PG8_STAGE(PG8_SA(0, 0), a2, voffA);
            PG8_BAR; PG8_WAIT_L(0); PG8_MMA(1, 0, At, B0); PG8_BAR; PG8_SCHED;
            PG8_STAGE(PG8_SB(0, 1), b2 + hstepB, voffB);
            PG8_WAIT_V(6); PG8_BAR; PG8_MMA(1, 1, At, B1); PG8_BAR;
            PG8_LDB(B0, 1, 0); PG8_SCHED; PG8_LDA(At, 1, 0); PG8_STAGE(PG8_SA(0, 1), a2 + hstepA, voffA);
            PG8_WAIT_L(8); PG8_BAR; PG8_WAIT_L(0); PG8_MMA(0, 0, At, B0); PG8_BAR; PG8_SCHED;
            PG8_LDB(B1, 1, 1); PG8_STAGE(PG8_SB(1, 0), b3, voffB);
            PG8_BAR; PG8_WAIT_L(0); PG8_MMA(0, 1, At, B1); PG8_BAR;
            PG8_LDA(At, 1, 1); PG8_STAGE(PG8_SA(1, 0), a3, voffA);
            PG8_BAR; PG8_WAIT_L(0); PG8_MMA(1, 0, At, B0); PG8_BAR; PG8_SCHED;
            PG8_STAGE(PG8_SB(1, 1), b3 + hstepB, voffB);
            PG8_WAIT_V(6); PG8_BAR; PG8_MMA(1, 1, At, B1); PG8_BAR;
            }
        }
        if constexpr (ALIGN_EPI) { if (wr == 0) PG8_BAR; }
        if constexpr (!Epi::AFTER_DRAIN) { E(acc, cur, wr, wc, fr, fq); S.done(cur); }
        if (!has_next) break;
#pragma unroll
        for (int a = 0; a < 2; ++a)
#pragma unroll
            for (int b = 0; b < 2; ++b)
#pragma unroll
                for (int m = 0; m < 4; ++m)
#pragma unroll
                    for (int n = 0; n < 2; ++n) acc[a][b][m][n] = (f32x4){0.f, 0.f, 0.f, 0.f};
        cur = nxt; cA = nA; cB = nB; ++ui;
        if constexpr (ALIGN_EPI) { if (wr == 1) PG8_BAR; }
    }
    PG8_WAIT_V(0);
    if constexpr (!ALIGN_EPI) { if (wr == 0) PG8_BAR; }
    PG8_BAR;
    if constexpr (Epi::AFTER_DRAIN) { E.fused(acc, cur, wr, wc, fr, fq, lds, wid, lane); S.done(cur); }
#undef PG8_SA
#undef PG8_SB
#undef PG8_STAGE
#undef PG8_LDA
#undef PG8_LDB
#undef PG8_MMA
#undef PG8_WAIT_V
#undef PG8_WAIT_L
#undef PG8_BAR
#undef PG8_SCHED
}
}

constexpr int T = 16384, SEQ = 8192, DM = 2048, LD = 12288 + 64;
constexpr int Q0 = 0, K0 = 1024, V0 = 2048, U0 = 4096, VS0 = 6144, GR0 = 8192, GS0 = 10240;
constexpr int Q1 = 0, K1 = 2048, V1 = 4096, G1 = 8192;
constexpr int MIXC = 8192;
constexpr size_t MiB = 1u << 20;
constexpr size_t WS_LR = 1 * MiB, WS_WLRT = 2 * MiB, WS_DEC = 3 * MiB, WS_WA = 8 * MiB, WS_H = 56 * MiB, WS_P = 120 * MiB, WS_END = 512 * MiB;
static_assert(WS_P + (size_t)T * LD * 2 <= WS_END, "d_ws map");
constexpr size_t WS_SC = WS_H, WS_SS = WS_H + 16 * MiB, WS_WO0 = WS_H + 32 * MiB;
constexpr int HS_OFF = 131072 + 8 * 2304 + 256;
constexpr int LDS_BYTES = HS_OFF + 8192;
#ifndef PROBE
#define PROBE 0
#endif

#define LAS __attribute__((address_space(3)))
typedef unsigned short bf16;
typedef short bf16x8 __attribute__((ext_vector_type(8)));
typedef float f32x4 __attribute__((ext_vector_type(4)));
typedef unsigned u32x4 __attribute__((ext_vector_type(4)));
typedef unsigned u32x2 __attribute__((ext_vector_type(2)));
#define LDS_WAIT() asm volatile("s_waitcnt lgkmcnt(0)" ::: "memory")
typedef float f32x2_t __attribute__((ext_vector_type(2)));
typedef __bf16 bf16x2_t __attribute__((ext_vector_type(2)));
__device__ __forceinline__ unsigned pk2(float lo, float hi) { const f32x2_t v = {lo, hi}; const bf16x2_t b = __builtin_convertvector(v, bf16x2_t); return __builtin_bit_cast(unsigned, b); }
__device__ __forceinline__ unsigned f2bf(float f) { return pk2(f, 0.f) & 0xffffu; }
__device__ __forceinline__ float bflo(unsigned w) { return __builtin_bit_cast(float, w << 16); }
__device__ __forceinline__ float bfhi(unsigned w) { return __builtin_bit_cast(float, w & 0xffff0000u); }
__device__ __forceinline__ float bf2f(bf16 b) { return __builtin_bit_cast(float, ((unsigned)b) << 16); }
__device__ __forceinline__ f32x4 mma16(bf16x8 a, bf16x8 b, f32x4 c) { return __builtin_amdgcn_mfma_f32_16x16x32_bf16(a, b, c, 0, 0, 0); }
__device__ __forceinline__ float wave_sum(float v) {
#pragma unroll
    for (int o = 1; o < 64; o <<= 1) v += __shfl_xor(v, o);
    return v;
}
__device__ __forceinline__ float silu(float g) { return g / (1.f + __expf(-g)); }

__device__ __forceinline__ void transpose_item(const float* W, int ldw, int K, bf16* WT, int k0, int n0, int drow0, LAS float* scr, int lane) {
#pragma unroll 8
    for (int i = 0; i < 32; ++i) { const int kk = 2 * i + (lane >> 5); scr[kk * 33 + (lane & 31)] = __builtin_nontemporal_load(W + (size_t)(k0 + kk) * ldw + n0 + (lane & 31)); }
    LDS_WAIT(); asm volatile("" ::: "memory");
    const int c = lane & 7;
#pragma unroll
    for (int j = 0; j < 4; ++j) { const int n = (lane >> 3) + 8 * j; const LAS float* s = scr + (8 * c) * 33 + n;
        u32x4 o; o.x = pk2(s[0 * 33], s[1 * 33]); o.y = pk2(s[2 * 33], s[3 * 33]); o.z = pk2(s[4 * 33], s[5 * 33]); o.w = pk2(s[6 * 33], s[7 * 33]);
        *(u32x4*)(WT + (size_t)(drow0 + n) * K + k0 + 8 * c) = o; }
    LDS_WAIT(); asm volatile("" ::: "memory");
}
__device__ __forceinline__ int perm0(int n) { return n < 4096 ? n : (n < 6144 ? n + 4096 : (n < 10240 ? n - 2048 : n)); }
template <bool PERM> __device__ __forceinline__ void transpose_all(const float* W, int ldw, int K, int N, bf16* WT, LAS float* scr, int gw, int ngw, int lane) {
    const int nblk = N / 32, nitems = (K / 64) * nblk;
    for (int it = gw; it < nitems; it += ngw) { const int kb = it / nblk, nb = it % nblk; const int n0 = nb * 32;
        transpose_item(W, ldw, K, WT, kb * 64, n0, PERM ? perm0(n0) : n0, scr, lane); }
}
__device__ __forceinline__ void rms_row_bf16(const float* xrow, const float* g, bf16* orow, int lane) {
    f32x4 v[8]; float s = 0.f;
#pragma unroll
    for (int j = 0; j < 8; ++j) { v[j] = __builtin_nontemporal_load((const f32x4*)xrow + 64 * j + lane); s += (v[j].x * v[j].x + v[j].y * v[j].y) + (v[j].z * v[j].z + v[j].w * v[j].w); }
    const float r = rsqrtf(wave_sum(s) * (1.f / DM) + 1e-6f);
#pragma unroll
    for (int j = 0; j < 8; ++j) { const f32x4 gg = ((const f32x4*)g)[64 * j + lane]; const f32x4 o = v[j] * r * gg;
        u32x2 w; w.x = pk2(o.x, o.y); w.y = pk2(o.z, o.w); ((u32x2*)orow)[64 * j + lane] = w; }
}
__device__ __forceinline__ void res_rms_row_bf16(const float* xrow, const bf16* acc, const float* g, bf16* orow, int lane) {
    f32x4 v[8]; float s = 0.f;
#pragma unroll
    for (int j = 0; j < 8; ++j) { const u32x2 a = ((const u32x2*)acc)[64 * j + lane]; v[j] = __builtin_nontemporal_load((const f32x4*)xrow + 64 * j + lane) + (f32x4){bflo(a.x), bfhi(a.x), bflo(a.y), bfhi(a.y)};
        s += (v[j].x * v[j].x + v[j].y * v[j].y) + (v[j].z * v[j].z + v[j].w * v[j].w); }
    const float r = rsqrtf(wave_sum(s) * (1.f / DM) + 1e-6f);
#pragma unroll
    for (int j = 0; j < 8; ++j) { const f32x4 gg = ((const f32x4*)g)[64 * j + lane]; const f32x4 o = v[j] * r * gg;
        u32x2 w; w.x = pk2(o.x, o.y); w.y = pk2(o.z, o.w); ((u32x2*)orow)[64 * j + lane] = w; }
}
__device__ __forceinline__ void res_rms_row_f32(const float* xrow, float* io, const bf16* acc2, const float* g, int lane) {
    f32x4 v[8]; float s = 0.f;
#pragma unroll
    for (int j = 0; j < 8; ++j) { const u32x2 a1 = __builtin_nontemporal_load((const u32x2*)io + 64 * j + lane), a2 = __builtin_nontemporal_load((const u32x2*)acc2 + 64 * j + lane);
        v[j] = (__builtin_nontemporal_load((const f32x4*)xrow + 64 * j + lane) + (f32x4){bflo(a1.x), bfhi(a1.x), bflo(a1.y), bfhi(a1.y)}) + (f32x4){bflo(a2.x), bfhi(a2.x), bflo(a2.y), bfhi(a2.y)};
        s += (v[j].x * v[j].x + v[j].y * v[j].y) + (v[j].z * v[j].z + v[j].w * v[j].w); }
    const float r = rsqrtf(wave_sum(s) * (1.f / DM) + 1e-6f);
#pragma unroll
    for (int j = 0; j < 8; ++j) { const f32x4 gg = ((const f32x4*)g)[64 * j + lane]; __builtin_nontemporal_store(v[j] * r * gg, (f32x4*)io + 64 * j + lane); }
}

template <bool DRY> __device__ __forceinline__ void retpre_unit(LAS unsigned char* lds, bf16* Pb, const int* pos, bf16* SC, float* DEC, int u, int tid, int never) {
    const int h = u & 3, n = (u >> 2) & 127, b = u >> 9;
    const int r0 = b * SEQ + n * 64;
    LAS bf16* Qs = (LAS bf16*)lds; LAS bf16* Ks = Qs + 64 * 264;
    const float lg2 = __log2f(1.f - exp2f(-5.f - (float)h));
    const int wv = tid >> 6, lane = tid & 63, l15 = lane & 15, quad = lane >> 4;
    for (int it = tid; it < 1024; it += 512) {
        const int t = it >> 4, j8 = it & 15;
        const float p = (float)pos[r0 + t];
        const bf16* qr = Pb + (size_t)(r0 + t) * LD + Q0 + h * 256 + j8 * 8;
        const bf16* kr = Pb + (size_t)(r0 + t) * LD + K0 + h * 256 + j8 * 8;
        const u32x4 q1 = *(const u32x4*)qr, q2 = *(const u32x4*)(qr + 128), k1 = *(const u32x4*)kr, k2 = *(const u32x4*)(kr + 128);
        u32x4 oq1, oq2, ok1, ok2;
#pragma unroll
        for (int e2 = 0; e2 < 4; ++e2) {
            float cs[2], sn[2];
#pragma unroll
            for (int z = 0; z < 2; ++z) { const float j = (float)(j8 * 8 + e2 * 2 + z);
                const float cj = exp2f(j * -0.10381025296523008f) * 0.15915494309189535f;
                const float hi = p * cj, lo = fmaf(p, cj, -hi); const float fr = (hi - floorf(hi)) + lo;
                sn[z] = __builtin_amdgcn_sinf(fr); cs[z] = __builtin_amdgcn_cosf(fr); }
            const float a0 = bflo(q1[e2]), a1 = bfhi(q1[e2]), b0 = bflo(q2[e2]), b1 = bfhi(q2[e2]);
            oq1[e2] = pk2((a0 * cs[0] - b0 * sn[0]) * 0.0625f, (a1 * cs[1] - b1 * sn[1]) * 0.0625f);
            oq2[e2] = pk2((a0 * sn[0] + b0 * cs[0]) * 0.0625f, (a1 * sn[1] + b1 * cs[1]) * 0.0625f);
            const float c0 = bflo(k1[e2]), c1 = bfhi(k1[e2]), d0 = bflo(k2[e2]), d1 = bfhi(k2[e2]);
            ok1[e2] = pk2(c0 * cs[0] - d0 * sn[0], c1 * cs[1] - d1 * sn[1]);
            ok2[e2] = pk2(c0 * sn[0] + d0 * cs[0], c1 * sn[1] + d1 * cs[1]);
        }
        *(LAS u32x4*)(Qs + t * 264 + j8 * 8) = oq1; *(LAS u32x4*)(Qs + t * 264 + 128 + j8 * 8) = oq2;
        *(LAS u32x4*)(Ks + t * 264 + j8 * 8) = ok1; *(LAS u32x4*)(Ks + t * 264 + 128 + j8 * 8) = ok2;
    }
    __syncthreads();
#pragma unroll
    for (int tl = 0; tl < 2; ++tl) { const int tile = 2 * wv + tl, ti = tile >> 2, si = tile & 3; const int t = ti * 16 + l15;
        u32x2 w; w.x = 0u; w.y = 0u;
        if (si <= ti) { f32x4 acc = {0.f, 0.f, 0.f, 0.f};
#pragma unroll
            for (int kk = 0; kk < 8; ++kk) { const bf16x8 qf = *(const LAS bf16x8*)(Qs + t * 264 + kk * 32 + quad * 8); const bf16x8 kf = *(const LAS bf16x8*)(Ks + (si * 16 + l15) * 264 + kk * 32 + quad * 8); acc = mma16(kf, qf, acc); }
            float v[4];
#pragma unroll
            for (int e = 0; e < 4; ++e) { const int s_ = si * 16 + quad * 4 + e; v[e] = (s_ <= t) ? acc[e] * exp2f((float)(t - s_) * lg2) : 0.f; }
            w.x = pk2(v[0], v[1]); w.y = pk2(v[2], v[3]); }
        if (!DRY || never) *(u32x2*)(SC + (size_t)u * 4096 + ((ti * 2 + (si >> 1)) * 64 + ((si & 1) * 2 + (quad >> 1)) * 16 + l15) * 8 + (quad & 1) * 4) = w; }
    for (int it = tid; it < 2048; it += 512) {
        const int fb = it >> 6, L = it & 63, tt = fb >> 3, kk = fb & 7, fl = L & 15, fq = L >> 4; const int t = tt * 16 + fl;
        const u32x4 v = *(const LAS u32x4*)(Qs + t * 264 + kk * 32 + fq * 8); const float f = exp2f((float)(t + 1) * lg2);
        u32x4 o;
#pragma unroll
        for (int e = 0; e < 4; ++e) o[e] = pk2(bflo(v[e]) * f, bfhi(v[e]) * f);
        if (!DRY || never) *(u32x4*)(Pb + (size_t)(r0 + 2 * fb + (L >> 5)) * LD + Q0 + h * 256 + (L & 31) * 8) = o;
    }
    for (int it = tid; it < 2048; it += 512) {
        const int fb = it >> 6, L = it & 63, kt = fb >> 1, kk = fb & 1, fl = L & 15, fq = L >> 4; const int k = kt * 16 + fl;
        u32x4 o;
#pragma unroll
        for (int e2 = 0; e2 < 4; ++e2) { const int s_ = kk * 32 + fq * 8 + e2 * 2;
            o[e2] = pk2(bf2f(Ks[s_ * 264 + k]) * exp2f((float)(63 - s_) * lg2), bf2f(Ks[(s_ + 1) * 264 + k]) * exp2f((float)(62 - s_) * lg2)); }
        if (!DRY || never) *(u32x4*)(Pb + (size_t)(r0 + 2 * fb + (L >> 5)) * LD + K0 + h * 256 + (L & 31) * 8) = o;
    }
    if ((!DRY || never) && tid < 256) DEC[(size_t)u * 256 + tid] = exp2f(64.f * lg2);
    __syncthreads();
}

template <bool DRY> __device__ __forceinline__ void sgu_unit(LAS unsigned char* lds, bf16* Pb, const float* gain, const float* w_s, const float* b_s, int u, int tid, int never) {
    const int g = u & 7, n = (u >> 3) & 63, b = u >> 9;
    const int r0 = b * SEQ + n * 128;
    LAS bf16* VnT = (LAS bf16*)lds;
    LAS bf16* Ws = VnT + 256 * 136;
    const int wv = tid >> 6, lane = tid & 63, l15 = lane & 15, quad = lane >> 4;
    for (int it = tid; it < 4096; it += 512) {
        const int t = it >> 5, s4 = (it & 31) * 4;
        const f32x4 w = *(const f32x4*)(w_s + (size_t)g * 16384 + t * 128 + s4);
        u32x2 o; o.x = pk2(s4 <= t ? w.x : 0.f, s4 + 1 <= t ? w.y : 0.f); o.y = pk2(s4 + 2 <= t ? w.z : 0.f, s4 + 3 <= t ? w.w : 0.f);
        *(LAS u32x2*)(Ws + t * 136 + s4) = o;
    }
    {
        const int row = tid >> 2, part = tid & 3;
        const bf16* src = Pb + (size_t)(r0 + row) * LD + VS0 + g * 256 + part * 64;
        u32x4 x[8]; float s = 0.f, s2 = 0.f;
#pragma unroll
        for (int j = 0; j < 8; ++j) { x[j] = *(const u32x4*)(src + j * 8);
#pragma unroll
            for (int e = 0; e < 4; ++e) { const float a = bflo(x[j][e]), c = bfhi(x[j][e]); s += a + c; s2 += a * a + c * c; } }
        s += __shfl_xor(s, 1); s2 += __shfl_xor(s2, 1); s += __shfl_xor(s, 2); s2 += __shfl_xor(s2, 2);
        const float mean = s * (1.f / 256.f); const float var = fmaxf(s2 * (1.f / 256.f) - mean * mean, 0.f); const float rstd = rsqrtf(var + 1e-6f);
        const float* gp = gain + g * 256 + part * 64;
#pragma unroll
        for (int j = 0; j < 8; ++j)
#pragma unroll
            for (int e = 0; e < 4; ++e) { const int c = part * 64 + j * 8 + e * 2;
                VnT[c * 136 + row] = (bf16)f2bf((bflo(x[j][e]) - mean) * rstd * gp[j * 8 + e * 2]);
                VnT[(c + 1) * 136 + row] = (bf16)f2bf((bfhi(x[j][e]) - mean) * rstd * gp[j * 8 + e * 2 + 1]); }
    }
    __syncthreads();
    {
        const int t = wv * 16 + l15; const int nk = (wv >> 1) + 1;
        bf16x8 wf[4];
#pragma unroll
        for (int kk = 0; kk < 4; ++kk) wf[kk] = *(const LAS bf16x8*)(Ws + t * 136 + kk * 32 + quad * 8);
        const float bias = b_s[g * 128 + t];
        bf16* rowp = Pb + (size_t)(r0 + t) * LD + g * 256 + quad * 4;
        for (int ci = 0; ci < 16; ++ci) {
            f32x4 acc = {0.f, 0.f, 0.f, 0.f};
#pragma unroll
            for (int kk = 0; kk < 4; ++kk) if (kk < nk) { const bf16x8 vf = *(const LAS bf16x8*)(VnT + (ci * 16 + l15) * 136 + kk * 32 + quad * 8); acc = mma16(vf, wf[kk], acc); }
            const u32x2 uu = *(const u32x2*)(rowp + U0 + ci * 16), gs = *(const u32x2*)(rowp + GS0 + ci * 16);
            u32x2 o;
            o.x = pk2(bflo(uu.x) * (acc[0] + bias) * silu(bflo(gs.x)), bfhi(uu.x) * (acc[1] + bias) * silu(bfhi(gs.x)));
            o.y = pk2(bflo(uu.y) * (acc[2] + bias) * silu(bflo(gs.y)), bfhi(uu.y) * (acc[3] + bias) * silu(bfhi(gs.y)));
            if (!DRY || never) *(u32x2*)(rowp + GS0 + ci * 16) = o;
        }
    }
    __syncthreads();
}

#define LBAR() do { asm volatile("s_waitcnt lgkmcnt(0)" ::: "memory"); __builtin_amdgcn_s_barrier(); asm volatile("" ::: "memory"); } while (0)
template <int NH, int QOFF, int KOFF, int VOFF, int GOFF, bool DRY>
__device__ __forceinline__ void scan_worker(LAS unsigned char* lds, bf16* Pb, const bf16* SC, const float* DEC, float* SS, int wk, int tid, int never) {
    constexpr int C = 64, NC = SEQ / C, VTS = C + 8, STS = 264;
    constexpr int ST_ELEMS = 32 * STS, VT_ELEMS = 32 * VTS;
    const int w = __builtin_amdgcn_readfirstlane(tid >> 6), lane = tid & 63, l15 = lane & 15, quad = lane >> 4;
    const int bh = wk >> 4, sl = wk & 15, b = bh / NH, h = bh % NH;
    LAS bf16* ST = (LAS bf16*)lds;
    LAS bf16* VT = ST + 2 * ST_ELEMS;
    LAS float* DC = (LAS float*)(VT + 2 * VT_ELEMS);
    const int vcol = VOFF + h * 512 + sl * 32;
    const int wq = w & 3;
    for (int i = tid; i < ST_ELEMS / 2; i += 512) ((LAS unsigned*)ST)[i] = 0u;
    if (w < 4) {
        const int vs_s = tid >> 2, vs_p = tid & 3;
        const unsigned offQ = (unsigned)((wq * 16 + (lane >> 5)) * LD + QOFF + h * 256 + (lane & 31) * 8), offP = (unsigned)(wq * 1024 + lane * 8);
        const unsigned offV = (unsigned)(vs_s * LD + vcol + vs_p * 8);
        const unsigned offO = (unsigned)((wq * 16 + l15) * LD + (vcol - VOFF + GOFF) + quad * 4), offS = (unsigned)(((wq * 16 + l15) * NH + h) * 32 + sl * 2);
        bf16x8 frA[10], frB[10], frC[10]; u32x4 vrA, vrB, vrC; u32x2 g0A, g1A, g0B, g1B, g0C, g1C;
#define O_LOAD(S, nn) do { const bf16* cb_ = Pb + (size_t)(b * SEQ + (nn) * C) * LD; const bf16* sb_ = SC + (size_t)((b * NC + (nn)) * NH + h) * (C * C); \
            _Pragma("unroll") for (int kk = 0; kk < 8; ++kk) { const bf16* ck_ = cb_ + kk * 2 * LD; fr##S[kk] = *(const bf16x8*)(ck_ + offQ); } \
            _Pragma("unroll") for (int kk = 0; kk < 2; ++kk) fr##S[8 + kk] = *(const bf16x8*)(sb_ + offP + kk * 512); \
            vr##S = *(const u32x4*)(cb_ + offV); g0##S = *(const u32x2*)(cb_ + offO); g1##S = *(const u32x2*)(cb_ + offO + 16); } while (0)
#define O_VT_WRITE(S, VTp) do { _Pragma("unroll") for (int e = 0; e < 4; ++e) { (VTp)[(vs_p * 8 + 2 * e) * VTS + vs_s] = (bf16)(vr##S[e] & 0xffffu); (VTp)[(vs_p * 8 + 2 * e + 1) * VTS + vs_s] = (bf16)(vr##S[e] >> 16); } } while (0)
#define O_STEP(S, SN, SL, n_) do { const int n = (n_); const int buf = n & 1; const int r0 = b * SEQ + n * C; \
            LAS bf16* STb = ST + buf * ST_ELEMS; LAS bf16* VTb = VT + buf * VT_ELEMS; LAS bf16* VTn = VT + (buf ^ 1) * VT_ELEMS; \
            LBAR(); \
            { const int nn_ = (n + 2 < NC) ? n + 2 : NC - 1; O_LOAD(SL, nn_); } \
            f32x4 o0 = {0.f, 0.f, 0.f, 0.f}, o1 = {0.f, 0.f, 0.f, 0.f}; \
            _Pragma("unroll") for (int kk = 0; kk < 8; ++kk) { const bf16x8 s0 = *(const LAS bf16x8*)(STb + l15 * STS + kk * 32 + quad * 8); const bf16x8 s1 = *(const LAS bf16x8*)(STb + (16 + l15) * STS + kk * 32 + quad * 8); \
                o0 = mma16(s0, fr##S[kk], o0); o1 = mma16(s1, fr##S[kk], o1); } \
            _Pragma("unroll") for (int kk = 0; kk < 2; ++kk) { const bf16x8 v0 = *(const LAS bf16x8*)(VTb + l15 * VTS + kk * 32 + quad * 8); const bf16x8 v1 = *(const LAS bf16x8*)(VTb + (16 + l15) * VTS + kk * 32 + quad * 8); \
                o0 = mma16(v0, fr##S[8 + kk], o0); o1 = mma16(v1, fr##S[8 + kk], o1); } \
            u32x2 p0, p1; p0.x = pk2(o0[0] * silu(bflo(g0##S.x)), o0[1] * silu(bfhi(g0##S.x))); p0.y = pk2(o0[2] * silu(bflo(g0##S.y)), o0[3] * silu(bfhi(g0##S.y))); \
            p1.x = pk2(o1[0] * silu(bflo(g1##S.x)), o1[1] * silu(bfhi(g1##S.x))); p1.y = pk2(o1[2] * silu(bflo(g1##S.y)), o1[3] * silu(bfhi(g1##S.y))); \
            bf16* op = Pb + (size_t)r0 * LD + offO; \
            if (!DRY || never) { *(u32x2*)op = p0; *(u32x2*)(op + 16) = p1; } \
            float ss0 = (o0[0] * o0[0] + o0[1] * o0[1]) + (o0[2] * o0[2] + o0[3] * o0[3]), ss1 = (o1[0] * o1[0] + o1[1] * o1[1]) + (o1[2] * o1[2] + o1[3] * o1[3]); \
            ss0 += __shfl_xor(ss0, 16); ss1 += __shfl_xor(ss1, 16); ss0 += __shfl_xor(ss0, 32); ss1 += __shfl_xor(ss1, 32); \
            if ((!DRY || never) && quad == 0) { float* sp = SS + (size_t)r0 * NH * 32 + offS; sp[0] = ss0; sp[1] = ss1; } \
            O_VT_WRITE(SN, VTn); } while (0)
        O_LOAD(A, 0); O_LOAD(B, 1);
        O_VT_WRITE(A, VT);
        for (int n0 = 0; n0 < NC; n0 += 3) {
            O_STEP(A, B, C, n0);
            if (n0 + 1 < NC) O_STEP(B, C, A, n0 + 1);
            if (n0 + 2 < NC) O_STEP(C, A, B, n0 + 2);
        }
#undef O_LOAD
#undef O_VT_WRITE
#undef O_STEP
    } else {
        const unsigned offK = (unsigned)((wq * 16 + (lane >> 5)) * LD + KOFF + h * 256 + (lane & 31) * 8);
        const unsigned offD = (unsigned)(lane * 4);
        const bool dw = (w == 4);
        f32x4 sacc[4][2];
#pragma unroll
        for (int a = 0; a < 4; ++a)
#pragma unroll
            for (int v = 0; v < 2; ++v) sacc[a][v] = (f32x4){0.f, 0.f, 0.f, 0.f};
        bf16x8 frA[8], frB[8], frC[8]; u32x4 vrA = {0u, 0u, 0u, 0u}, vrB = vrA, vrC = vrA;
#define S_LOAD(S, nn) do { const bf16* cb_ = Pb + (size_t)(b * SEQ + (nn) * C) * LD; \
            _Pragma("unroll") for (int a = 0; a < 4; ++a) _Pragma("unroll") for (int kk = 0; kk < 2; ++kk) { const bf16* ca_ = cb_ + (a * 4 + kk * 2) * LD; fr##S[a * 2 + kk] = *(const bf16x8*)(ca_ + offK); } \
            if (dw) vr##S = *(const u32x4*)(DEC + (size_t)((b * NC + (nn)) * NH + h) * 256 + offD); } while (0)
#define S_STEP(S, SN, SL, n_) do { const int n = (n_); const int buf = n & 1; \
            LAS bf16* VTb = VT + buf * VT_ELEMS; LAS bf16* STn = ST + (buf ^ 1) * ST_ELEMS; LAS float* DCb = DC + buf * 256; \
            LBAR(); \
            { const int nn_ = (n + 2 < NC) ? n + 2 : NC - 1; S_LOAD(SL, nn_); } \
            bf16x8 vf[2][2]; \
            _Pragma("unroll") for (int v = 0; v < 2; ++v) _Pragma("unroll") for (int kk = 0; kk < 2; ++kk) vf[v][kk] = *(const LAS bf16x8*)(VTb + (v * 16 + l15) * VTS + kk * 32 + quad * 8); \
            _Pragma("unroll") for (int a = 0; a < 4; ++a) { const f32x4 dc4 = *(const LAS f32x4*)(DCb + (wq * 4 + a) * 16 + quad * 4); \
                _Pragma("unroll") for (int v = 0; v < 2; ++v) { \
                    f32x4 s_ = sacc[a][v] * dc4; \
                    _Pragma("unroll") for (int kk = 0; kk < 2; ++kk) s_ = mma16(fr##S[a * 2 + kk], vf[v][kk], s_); \
                    sacc[a][v] = s_; u32x2 o_; o_.x = pk2(s_[0], s_[1]); o_.y = pk2(s_[2], s_[3]); \
                    *(LAS u32x2*)(STn + (v * 16 + l15) * STS + (wq * 4 + a) * 16 + quad * 4) = o_; } } \
            if (dw) *(LAS u32x4*)(DC + (buf ^ 1) * 256 + lane * 4) = vr##SN; } while (0)
        S_LOAD(A, 0); S_LOAD(B, 1);
        if (dw) *(LAS u32x4*)(DC + lane * 4) = vrA;
        for (int n0 = 0; n0 < NC; n0 += 3) {
            S_STEP(A, B, C, n0);
            if (n0 + 1 < NC) S_STEP(B, C, A, n0 + 1);
            if (n0 + 2 < NC) S_STEP(C, A, B, n0 + 2);
        }
#undef S_LOAD
#undef S_STEP
    }
    asm volatile("s_waitcnt vmcnt(0)" ::: "memory");
    __syncthreads();
}

template <int NH, int GOFF, bool DRY>
__device__ __forceinline__ void fin_phase(bf16* Pb, const float* SS, int gw, int ngw, int lane, int never) {
    for (int item = gw; item < T * NH; item += ngw) {
        const int tok = item / NH, h = item % NH;
        float s = (lane < 32) ? __builtin_nontemporal_load(SS + (size_t)item * 32 + lane) : 0.f; s = wave_sum(s);
        const float rstd = rsqrtf(s * (1.f / 512.f) + 1e-6f);
        bf16* rowp = Pb + (size_t)tok * LD + GOFF + h * 512 + lane * 8;
        const u32x4 o = *(const u32x4*)rowp;
        u32x4 r;
#pragma unroll
        for (int e = 0; e < 4; ++e) r[e] = pk2(bflo(o[e]) * rstd, bfhi(o[e]) * rstd);
        if (!DRY || never) *(u32x4*)rowp = r;
    }
}

__device__ __forceinline__ void lr_phase(const bf16* H, const bf16* WLRT, float* LR, int gw, int ngw, int lane) {
    const int l15 = lane & 15, quad = lane >> 4;
    for (int tile = gw; tile < T / 16; tile += ngw) {
        f32x4 acc = {0.f, 0.f, 0.f, 0.f};
        const bf16* ap = H + (size_t)(tile * 16 + l15) * DM + quad * 8; const bf16* bp = WLRT + (size_t)l15 * DM + quad * 8;
#pragma unroll 8
        for (int kk = 0; kk < 64; ++kk) acc = mma16(*(const bf16x8*)(ap + kk * 32), *(const bf16x8*)(bp + kk * 32), acc);
#pragma unroll
        for (int e = 0; e < 4; ++e) LR[(size_t)(tile * 16 + quad * 4 + e) * 16 + l15] = acc[e];
    }
}

template <bool DRY> __device__ __forceinline__ void glapre_unit(LAS unsigned char* lds, bf16* Pb, const float* LR, const float* w_lr, const float* b_lr, bf16* SC, float* DEC, int u, int tid, int never) {
    const int h = u & 7, n = (u >> 3) & 127, b = u >> 10;
    const int r0 = b * SEQ + n * 64;
    LAS bf16* Qs = (LAS bf16*)lds; LAS bf16* Ks = Qs + 64 * 264;
    LAS float* lrs = (LAS float*)(lds + 2 * 64 * 264 * 2); LAS float* tot = lrs + 1024;
    const int c = tid & 255, half = tid >> 8;
    const int wv = tid >> 6, lane = tid & 63, l15 = lane & 15, quad = lane >> 4;
    if (tid < 256) ((LAS f32x4*)lrs)[tid] = ((const f32x4*)(LR + (size_t)r0 * 16))[tid];
    float wl[16];
#pragma unroll
    for (int r = 0; r < 16; ++r) wl[r] = w_lr[r * 2048 + h * 256 + c];
    const float bb = b_lr[h * 256 + c];
    u32x4 qraw[4], kraw[4];
#pragma unroll
    for (int j = 0; j < 4; ++j) { const int it = tid + 512 * j, t_ = it >> 5, c8 = it & 31; const bf16* gp = Pb + (size_t)(r0 + t_) * LD + h * 256 + c8 * 8;
        qraw[j] = *(const u32x4*)(gp + Q1); kraw[j] = *(const u32x4*)(gp + K1); }
    __syncthreads();
    float bc[32]; float run = 0.f;
#pragma unroll
    for (int i = 0; i < 32; ++i) { const int t = half * 32 + i; float z = bb;
#pragma unroll
        for (int r4 = 0; r4 < 4; ++r4) { const f32x4 l = ((const LAS f32x4*)lrs)[t * 4 + r4]; z += (l.x * wl[4 * r4] + l.y * wl[4 * r4 + 1]) + (l.z * wl[4 * r4 + 2] + l.w * wl[4 * r4 + 3]); }
        const float a = -(fmaxf(-z, 0.f) + __logf(1.f + __expf(-fabsf(z)))) * 0.0625f;
        run += a; bc[i] = run; }
    tot[half * 256 + c] = run;
#pragma unroll
    for (int j = 0; j < 4; ++j) { const int it = tid + 512 * j, t_ = it >> 5, c8 = it & 31; *(LAS u32x4*)(Qs + t_ * 264 + c8 * 8) = qraw[j]; *(LAS u32x4*)(Ks + t_ * 264 + c8 * 8) = kraw[j]; }
    __syncthreads();
    const float t0 = tot[c], t1 = tot[256 + c]; const float blast = t0 + t1, off = half ? t0 : 0.f; const float eb = __expf(blast);
    LAS float* ebs = tot + 512;
#pragma unroll
    for (int i = 0; i < 32; ++i) { const int t = half * 32 + i; const float bcv = bc[i] + off;
        const float q = bf2f(Qs[t * 264 + c]), k = bf2f(Ks[t * 264 + c]);
        const float e = __expf(bcv), ei = __expf(-bcv);
        Qs[t * 264 + c] = (bf16)f2bf(q * 0.0625f * e); Ks[t * 264 + c] = (bf16)f2bf(k * ei); }
    if (half == 0) { ebs[c] = eb; if (!DRY || never) DEC[(size_t)u * 256 + c] = eb; }
    __syncthreads();
    for (int it = tid; it < 2048; it += 512) {
        const int fb = it >> 6, L = it & 63, tt = fb >> 3, kk = fb & 7, fl = L & 15, fq = L >> 4;
        const u32x4 v = *(const LAS u32x4*)(Qs + (tt * 16 + fl) * 264 + kk * 32 + fq * 8);
        if (!DRY || never) *(u32x4*)(Pb + (size_t)(r0 + 2 * fb + (L >> 5)) * LD + Q1 + h * 256 + (L & 31) * 8) = v;
    }
    for (int it = tid; it < 2048; it += 512) {
        const int fb = it >> 6, L = it & 63, kt = fb >> 1, kk = fb & 1, fl = L & 15, fq = L >> 4; const int k = kt * 16 + fl; const float ek = ebs[k];
        u32x4 o;
#pragma unroll
        for (int e2 = 0; e2 < 4; ++e2) { const int s_ = kk * 32 + fq * 8 + e2 * 2; o[e2] = pk2(bf2f(Ks[s_ * 264 + k]) * ek, bf2f(Ks[(s_ + 1) * 264 + k]) * ek); }
        if (!DRY || never) *(u32x4*)(Pb + (size_t)(r0 + 2 * fb + (L >> 5)) * LD + K1 + h * 256 + (L & 31) * 8) = o;
    }
#pragma unroll
    for (int tl = 0; tl < 2; ++tl) { const int tile = 2 * wv + tl, ti = tile >> 2, si = tile & 3; const int t = ti * 16 + l15;
        u32x2 w; w.x = 0u; w.y = 0u;
        if (si <= ti) { f32x4 acc = {0.f, 0.f, 0.f, 0.f};
#pragma unroll
            for (int kk = 0; kk < 8; ++kk) { const bf16x8 qf = *(const LAS bf16x8*)(Qs + t * 264 + kk * 32 + quad * 8); const bf16x8 kf = *(const LAS bf16x8*)(Ks + (si * 16 + l15) * 264 + kk * 32 + quad * 8); acc = mma16(kf, qf, acc); }
            float v[4];
#pragma unroll
            for (int e = 0; e < 4; ++e) { const int s = si * 16 + quad * 4 + e; v[e] = (s <= t) ? acc[e] : 0.f; }
            w.x = pk2(v[0], v[1]); w.y = pk2(v[2], v[3]); }
        if (!DRY || never) *(u32x2*)(SC + (size_t)u * 4096 + ((ti * 2 + (si >> 1)) * 64 + ((si & 1) * 2 + (quad >> 1)) * 16 + l15) * 8 + (quad & 1) * 4) = w; }
    __syncthreads();
}

#define RLX_AGENT __ATOMIC_RELAXED, __HIP_MEMORY_SCOPE_AGENT
#define XB_TMO      128
#define XB_XCNT(j)  (256  + 64 * (j))
#define XB_XSUB(j)  (1280 + 64 * (j))
#define XB_XGEN(j)  (2304 + 64 * (j))
#define XB_TOP      3328
#define XB_TOPGEN   3392
#define XCD_BAR_WORDS 3456
#define XB_SPIN_CAP (1u << 18)

__device__ __forceinline__ unsigned xb_ld(unsigned* p)              { return __hip_atomic_load(p, __ATOMIC_RELAXED, __HIP_MEMORY_SCOPE_AGENT); }
__device__ __forceinline__ unsigned xb_add(unsigned* p, unsigned v) { return __hip_atomic_fetch_add(p, v, __ATOMIC_RELAXED, __HIP_MEMORY_SCOPE_AGENT); }
__device__ __forceinline__ unsigned xb_xcc_id() { return (unsigned)__builtin_amdgcn_s_getreg((3 << 11) | 20) & 0xFu; }
#define XB_SPIN(cond, bar) do { unsigned _sp = 0; while (cond) { __builtin_amdgcn_s_sleep(1); \
    if ((++_sp & 255u) == 0u) { if (xb_ld(&(bar)[XB_TMO])) break; if (_sp > XB_SPIN_CAP) { atomicAdd(&(bar)[XB_TMO], 1u); break; } } } } while (0)

struct XcdBarrier {
    unsigned* bar; unsigned x;
    volatile LAS unsigned* st;
};

__device__ __forceinline__ XcdBarrier xcd_barrier_post(unsigned* bar, volatile LAS unsigned* st) {
    XcdBarrier b; b.bar = bar; b.x = xb_xcc_id(); b.st = st;
    if (threadIdx.x == 0) (void)xb_add(&bar[XB_XCNT(b.x)], 1u);
    return b;
}
__device__ __forceinline__ void xcd_barrier_complete(unsigned* bar, unsigned x, unsigned& nloc, unsigned& nx) {
    const unsigned G = gridDim.x * gridDim.y * gridDim.z;
    unsigned sum, cnt, mine, sp = 0u;
    for (;;) {
        sum = 0u; cnt = 0u; mine = 0u;
#pragma unroll
        for (unsigned j = 0; j < 16; ++j) { const unsigned c = xb_ld(&bar[XB_XCNT(j)]); sum += c; cnt += (c > 0u) ? 1u : 0u; mine = (j == x) ? c : mine; }
        if (sum == G) break;
        __builtin_amdgcn_s_sleep(1);
        if ((++sp & 255u) == 0u) { if (xb_ld(&bar[XB_TMO])) break; if (sp > XB_SPIN_CAP) { atomicAdd(&bar[XB_TMO], 1u); break; } }
    }
    nloc = mine > 0u ? mine : 1u; nx = cnt > 0u ? cnt : 1u;
}

__device__ __forceinline__ void xcd_barrier(const XcdBarrier& b) {
    asm volatile("s_waitcnt vmcnt(0)" ::: "memory");
    __syncthreads();
    if (threadIdx.x == 0) {
        unsigned* bar = b.bar;
        __builtin_amdgcn_s_waitcnt(0);
        unsigned nloc = b.st[0], nx = b.st[1];
        if (nloc == 0u) { xcd_barrier_complete(bar, b.x, nloc, nx); b.st[0] = nloc; b.st[1] = nx; }
        const unsigned old = xb_add(&bar[XB_XSUB(b.x)], 1u);
        const unsigned gen = old / nloc;
        if (old + 1u == (gen + 1u) * nloc) {
            __builtin_amdgcn_fence(__ATOMIC_RELEASE, "agent");
            asm volatile("s_waitcnt vmcnt(0)" ::: "memory");
            const unsigned og = xb_add(&bar[XB_TOP], 1u);
            const unsigned tg = og / nx;
            if (og + 1u == (tg + 1u) * nx) xb_add(&bar[XB_TOPGEN], 1u);
            else XB_SPIN(xb_ld(&bar[XB_TOPGEN]) == tg, bar);
            __builtin_amdgcn_fence(__ATOMIC_ACQUIRE, "agent");
            xb_add(&bar[XB_XGEN(b.x)], 1u);
            asm volatile("s_waitcnt vmcnt(0)" ::: "memory");
        } else {
            XB_SPIN(xb_ld(&bar[XB_XGEN(b.x)]) == gen, bar);
            __builtin_amdgcn_fence(__ATOMIC_ACQUIRE, "agent");
            asm volatile("s_waitcnt vmcnt(0)" ::: "memory");
        }
    }
    __syncthreads();
}

template <int NH>
__device__ __forceinline__ void build_hs_table(LAS float* tab, const float* SS, int pm, int tid) {
    for (int it = tid; it < 256 * NH; it += 512) { const int row = it / NH, h = it % NH;
        const f32x4* sp = (const f32x4*)(SS + ((size_t)(pm * 256 + row) * NH + h) * 32);
        float s = 0.f;
#pragma unroll
        for (int i = 0; i < 8; ++i) { const f32x4 v = sp[i]; s += (v.x + v.y) + (v.z + v.w); }
        tab[h * 256 + row] = rsqrtf(s * (1.f / 512.f) + 1e-6f); }
    __syncthreads();
    float f[NH / 2];
#pragma unroll
    for (int k = 0; k < NH / 2; ++k) { const int it = tid + 512 * k, j = it >> 8, row = it & 255; f[k] = (j < NH - 1) ? tab[j * 256 + row] / tab[(j + 1) * 256 + row] : tab[j * 256 + row]; }
    __syncthreads();
#pragma unroll
    for (int k = 0; k < NH / 2; ++k) tab[tid + 512 * k] = f[k];
    __syncthreads();
}

struct Args { const float* x; const int* pos; const float* ev_norm; const float* ev_w_in; const float* sgu_gain; const float* sgu_w_s; const float* sgu_b; const float* ev_w_out;
              const float* od_norm; const float* od_w_in; const float* gla_w_lr; const float* gla_b_lr; const float* od_w_out; const float* final_norm; float* out; unsigned char* ws; int never; int pad; };

__global__ void __launch_bounds__(512, 2) trunk_fwd(Args a) {
    extern __shared__ __attribute__((aligned(16))) unsigned char lds_raw[];
    LAS unsigned char* lds = (LAS unsigned char*)lds_raw;
    cg::grid_group grid = cg::this_grid();
    volatile LAS unsigned* xbst = (volatile LAS unsigned*)(lds + 131072 + 8 * 2304);
    if (threadIdx.x < 2) xbst[threadIdx.x] = 0u;
    __syncthreads();
    XcdBarrier xbar = xcd_barrier_post((unsigned*)a.ws, xbst);
    const int G = gridDim.x, bid = blockIdx.x, ngw = G * 8;
#define PH_BEGIN int t_ = threadIdx.x; asm volatile("" : "+v"(t_)); const int tid = t_, lane = tid & 63, wave = __builtin_amdgcn_readfirstlane(tid >> 6), gw = bid * 8 + wave; LAS float* scr = (LAS float*)(lds + wave * 16384); (void)lane; (void)gw; (void)scr;
    unsigned char* ws = a.ws;
    float* LR = (float*)(ws + WS_LR); bf16* WLRT = (bf16*)(ws + WS_WLRT); float* DEC = (float*)(ws + WS_DEC);
    bf16* WA = (bf16*)(ws + WS_WA); bf16* H = (bf16*)(ws + WS_H); bf16* Pb = (bf16*)(ws + WS_P);
    bf16* SC = (bf16*)(ws + WS_SC); float* SS = (float*)(ws + WS_SS); bf16* WO0 = (bf16*)(ws + WS_WO0);

    { PH_BEGIN
    for (int rep = 0; rep < 1 + ((PROBE >> 11) & 1); ++rep) {
    transpose_all<true>(a.ev_w_in, 12288, 2048, 12288, WA, scr, gw, ngw, lane);
    for (int m = gw; m < T; m += ngw) rms_row_bf16(a.x + (size_t)m * DM, a.ev_norm, H + (size_t)m * DM, lane);
    }
    }
    xcd_barrier(xbar);
    { PH_BEGIN
    if ((PROBE >> 15) & 1) { pg8::Gemm g{H, WA, T, 12288, 2048, 2048}; pg8::StaticOrder S; S.init(T, 12288, G, bid); pg8::EpiHot E{(bf16*)a.out};
      pg8::gemm_phase<pg8::EpiHot, pg8::StaticOrder, true, true>(lds, g, S, E); }
    for (int rep = 0; rep < 1 + ((PROBE >> 1) & 1); ++rep)
    { pg8::Gemm g{H, WA, T, 12288, 2048, 2048}; pg8::StaticOrder S; S.init(T, 12288, G, bid); pg8::EpiBf16W E{Pb, LD, lds + 131072};
      pg8::gemm_phase<pg8::EpiBf16W, pg8::StaticOrder, true, true>(lds, g, S, E); }
    }
    xcd_barrier(xbar);
    { PH_BEGIN
    if ((PROBE >> 2) & 1) for (int u = bid; u < 1024; u += G) retpre_unit<true>(lds, Pb, a.pos, SC, DEC, u, tid, a.never);
    for (int u = bid; u < 1024; u += G) retpre_unit<false>(lds, Pb, a.pos, SC, DEC, u, tid, a.never);
    }
    xcd_barrier(xbar);
    { PH_BEGIN
    for (int v = bid; v < 256; v += G) { const int xcd = v & 7, idx = v >> 3;
        if (idx < 16) { const int wk = xcd * 16 + idx;
            if ((PROBE >> 4) & 1) scan_worker<4, Q0, K0, V0, GR0, true>(lds, Pb, SC, DEC, SS, wk, tid, a.never);
            scan_worker<4, Q0, K0, V0, GR0, false>(lds, Pb, SC, DEC, SS, wk, tid, a.never);
        } else { const int hi = (idx - 16) * 8 + xcd;
            if ((PROBE >> 3) & 1) for (int u = hi; u < 1024; u += 128) sgu_unit<true>(lds, Pb, a.sgu_gain, a.sgu_w_s, a.sgu_b, u, tid, a.never);
            for (int u = hi; u < 1024; u += 128) sgu_unit<false>(lds, Pb, a.sgu_gain, a.sgu_w_s, a.sgu_b, u, tid, a.never);
            transpose_all<false>(a.ev_w_out, 2048, 4096, 2048, WO0, scr, hi * 8 + wave, 128 * 8, lane);
            transpose_all<false>(a.od_w_in, 12304, 2048, 12288, WA, scr, hi * 8 + wave, 128 * 8, lane);
        } }
    }
    grid.sync();
    if (G != 256) {
    { PH_BEGIN
    if ((PROBE >> 5) & 1) fin_phase<4, GR0, true>(Pb, SS, gw, ngw, lane, a.never);
    fin_phase<4, GR0, false>(Pb, SS, gw, ngw, lane, a.never);
    }
    xcd_barrier(xbar);
    }
    { PH_BEGIN
    { pg8::Gemm g{Pb + MIXC, WO0, T, 2048, 4096, LD}; pg8::StaticOrder S; S.init(T, 2048, G, bid); pg8::EpiBf16W E{(bf16*)a.out, 2 * DM, lds + 131072};
      if (G == 256) { pg8::Unit u0; S.next(0, u0); LAS float* tab = (LAS float*)(lds + HS_OFF); build_hs_table<4>(tab, SS, u0.pm, tid);
        pg8::gemm_phase<pg8::EpiBf16W, pg8::StaticOrder, true, true, 4>(lds, g, S, E, tab); }
      else pg8::gemm_phase<pg8::EpiBf16W, pg8::StaticOrder, true, true>(lds, g, S, E); }
    }
    xcd_barrier(xbar);
    { PH_BEGIN
    for (int m = gw; m < T; m += ngw) res_rms_row_bf16(a.x + (size_t)m * DM, (const bf16*)a.out + (size_t)m * 2 * DM, a.od_norm, H + (size_t)m * DM, lane);
    for (int i = bid * 512 + tid; i < 16 * 2048; i += G * 512) { const int r = i >> 11, k = i & 2047; WLRT[i] = (bf16)f2bf(a.od_w_in[(size_t)k * 12304 + 12288 + r]); }
    }
    xcd_barrier(xbar);
    { PH_BEGIN
    lr_phase(H, WLRT, LR, gw, ngw, lane);
    { pg8::Gemm g{H, WA, T, 12288, 2048, 2048}; pg8::StaticOrder S; S.init(T, 12288, G, bid); pg8::EpiBf16W E{Pb, LD, lds + 131072};
      pg8::gemm_phase<pg8::EpiBf16W, pg8::StaticOrder, true, true>(lds, g, S, E); }
    }
    xcd_barrier(xbar);
    { PH_BEGIN
    if ((PROBE >> 8) & 1) for (int u = bid; u < 2048; u += G) glapre_unit<true>(lds, Pb, LR, a.gla_w_lr, a.gla_b_lr, SC, DEC, u, tid, a.never);
    for (int u = bid; u < 2048; u += G) glapre_unit<false>(lds, Pb, LR, a.gla_w_lr, a.gla_b_lr, SC, DEC, u, tid, a.never);
    transpose_all<false>(a.od_w_out, 2048, 4096, 2048, WA, scr, gw, ngw, lane);
    }
    xcd_barrier(xbar);
    { PH_BEGIN
    for (int v = bid; v < 256; v += G) { const int xcd = v & 7, idx = v >> 3; const int wk = (xcd * 2 + (idx >> 4)) * 16 + (idx & 15);
        if ((PROBE >> 9) & 1) scan_worker<8, Q1, K1, V1, G1, true>(lds, Pb, SC, DEC, SS, wk, tid, a.never);
        scan_worker<8, Q1, K1, V1, G1, false>(lds, Pb, SC, DEC, SS, wk, tid, a.never); }
    }
    xcd_barrier(xbar);
    if (G != 256) {
    { PH_BEGIN
    if ((PROBE >> 10) & 1) fin_phase<8, G1, true>(Pb, SS, gw, ngw, lane, a.never);
    fin_phase<8, G1, false>(Pb, SS, gw, ngw, lane, a.never);
    }
    xcd_barrier(xbar);
    }
    { PH_BEGIN
    { pg8::Gemm g{Pb + MIXC, WA, T, 2048, 4096, LD}; pg8::StaticOrder S; S.init(T, 2048, G, bid); pg8::EpiBf16W E{Pb, LD, lds + 131072};
      if (G == 256) { pg8::Unit u0; S.next(0, u0); LAS float* tab = (LAS float*)(lds + HS_OFF); build_hs_table<8>(tab, SS, u0.pm, tid);
        pg8::gemm_phase<pg8::EpiBf16W, pg8::StaticOrder, true, true, 8>(lds, g, S, E, tab); }
      else pg8::gemm_phase<pg8::EpiBf16W, pg8::StaticOrder, true, true>(lds, g, S, E); }
    }
    xcd_barrier(xbar);
    if ((PROBE >> 12) & 1) { for (int rep = 0; rep < 12; ++rep) xcd_barrier(xbar); }
    { PH_BEGIN
    for (int m = gw; m < T; m += ngw) res_rms_row_f32(a.x + (size_t)m * DM, a.out + (size_t)m * DM, Pb + (size_t)m * LD, a.final_norm, lane);
    }
}

extern "C" void kernel_launch(void* const* d_in, const int* in_sizes, int n_in, void* d_out, int out_size, void* d_ws, size_t ws_size, hipStream_t stream) {
    static int grid = 0;
    if (grid == 0) {
        if (n_in != 14 || out_size != T * DM || ws_size < WS_END) { fprintf(stderr, "kernel_launch: unexpected shapes (n_in %d out %d ws %zu)\n", n_in, out_size, ws_size); grid = -1; return; }
        int dev = 0, cus = 0, per_cu = 0;
        (void)hipGetDevice(&dev);
        (void)hipDeviceGetAttribute(&cus, hipDeviceAttributeMultiprocessorCount, dev);
        (void)hipFuncSetAttribute((const void*)trunk_fwd, hipFuncAttributeMaxDynamicSharedMemorySize, LDS_BYTES);
        (void)hipOccupancyMaxActiveBlocksPerMultiprocessor(&per_cu, (const void*)trunk_fwd, 512, LDS_BYTES);
        if (per_cu < 1) per_cu = 1;
        grid = cus * per_cu;
    }
    if (grid < 0) return;
    (void)hipMemsetAsync(d_ws, 0, 16384, stream);
    Args a{};
    a.x = (const float*)d_in[0]; a.pos = (const int*)d_in[1]; a.ev_norm = (const float*)d_in[2]; a.ev_w_in = (const float*)d_in[3]; a.sgu_gain = (const float*)d_in[4];
    a.sgu_w_s = (const float*)d_in[5]; a.sgu_b = (const float*)d_in[6]; a.ev_w_out = (const float*)d_in[7]; a.od_norm = (const float*)d_in[8]; a.od_w_in = (const float*)d_in[9];
    a.gla_w_lr = (const float*)d_in[10]; a.gla_b_lr = (const float*)d_in[11]; a.od_w_out = (const float*)d_in[12]; a.final_norm = (const float*)d_in[13];
    a.out = (float*)d_out; a.ws = (unsigned char*)d_ws;
    void* args[] = {&a};
    hipError_t e = hipLaunchCooperativeKernel((void*)trunk_fwd, dim3(grid), dim3(512), args, LDS_BYTES, stream);
    if (e != hipSuccess) fprintf(stderr, "kernel_launch: cooperative launch failed: %s (grid %d)\n", hipGetErrorString(e), grid);
}
```

```cpp
#include <hip/hip_runtime.h>
#include <hip/hip_cooperative_groups.h>
#include <cstdio>
#include <cstdint>
namespace cg = cooperative_groups;

namespace pg8 {
#define PG8_LAS __attribute__((address_space(3)))
typedef unsigned short bf16_t;
typedef short bf16x8 __attribute__((ext_vector_type(8)));
typedef float f32x4 __attribute__((ext_vector_type(4)));
typedef unsigned u32x4 __attribute__((ext_vector_type(4)));
constexpr int BM = 256, BK = 64, HALF = 128, HTB = HALF * BK * 2, STAGE_BYTES = 8 * HTB, NXCD = 8, WGM = 8;
__host__ __device__ __forceinline__ int lds_byte(int r, int c) { const int st = (r >> 4) * 2 + (c >> 5), rr = r & 15, cc = c & 31, ob = rr * 64 + cc * 2; return st * 1024 + (ob ^ (((ob >> 9) & 1) << 5)); }
__host__ __device__ __forceinline__ void stage_rc(int b, int& R, int& C) { const int st = b / 1024, sb = b % 1024, swz = sb ^ (((sb >> 9) & 1) << 5); R = (st >> 1) * 16 + swz / 64; C = (st & 1) * 32 + (swz % 64) / 2; }
__host__ __device__ __forceinline__ int perm32(int rho) { const int n = rho >> 4, i = rho & 15; return 8 * (i >> 2) + 4 * n + (i & 3); }
struct Unit { int pm, pn; };
struct Gemm { const bf16_t* A; const bf16_t* Bt; int M, N, K, lda; };
struct StaticOrder {
    int nM, nN, nwg, G, c;
    __host__ __device__ void init(int M, int N, int G_, int c_) { nM = M / BM; nN = N / BM; nwg = nM * nN; G = G_; c = c_; }
    __host__ __device__ bool next(int i, Unit& u) const {
        const long L = (long)i * G + c; if (L >= nwg) return false;
        int wgid = (int)L; { const int q = nwg / NXCD, r = nwg % NXCD, xcd = wgid % NXCD, off = wgid / NXCD; wgid = (xcd < r ? xcd * (q + 1) : r * (q + 1) + (xcd - r) * q) + off; }
        const int nig = WGM * nN, gid = wgid / nig, fm = gid * WGM, gsz = (nM - fm) < WGM ? (nM - fm) : WGM;
        u.pm = fm + ((wgid % nig) % gsz); u.pn = (wgid % nig) / gsz; return true;
    }
    __device__ __forceinline__ void a_ready(const Unit&) const {}
    __device__ __forceinline__ void done(const Unit&) const {}
};
typedef float f32x2c __attribute__((ext_vector_type(2)));
typedef __bf16 bf16x2c __attribute__((ext_vector_type(2)));
__device__ __forceinline__ unsigned cvt_pk_bf16(float lo, float hi) { const f32x2c v = {lo, hi}; const bf16x2c b = __builtin_convertvector(v, bf16x2c); return __builtin_bit_cast(unsigned, b); }
struct EpiBf16P {
    static constexpr bool PERM = true, WIDE = false, AFTER_DRAIN = false;
    bf16_t* O; int ldc;
    __device__ __forceinline__ void operator()(const f32x4 (&acc)[2][2][4][2], const Unit& u, int wr, int wc, int fr, int fq) const {
        const int row0 = u.pm * BM + wr * 64 + fr, col0 = u.pn * BM + wc * 32 + 8 * fq;
#pragma unroll
        for (int ai = 0; ai < 2; ++ai)
#pragma unroll
            for (int m = 0; m < 4; ++m) { bf16_t* rowp = O + (size_t)(row0 + ai * HALF + m * 16) * ldc + col0;
#pragma unroll
                for (int bj = 0; bj < 2; ++bj) { const f32x4 v0 = acc[ai][bj][m][0], v1 = acc[ai][bj][m][1];
                    u32x4 w; w.x = cvt_pk_bf16(v0[0], v0[1]); w.y = cvt_pk_bf16(v0[2], v0[3]); w.z = cvt_pk_bf16(v1[0], v1[1]); w.w = cvt_pk_bf16(v1[2], v1[3]);
                    *(u32x4*)(rowp + bj * HALF) = w; } }
    }
};
struct EpiNull {
    static constexpr bool PERM = false, WIDE = false, AFTER_DRAIN = false;
    float* out; int never;
    __device__ __forceinline__ void operator()(const f32x4 (&acc)[2][2][4][2], const Unit& u, int wr, int wc, int fr, int fq) const {
        f32x4 s = {0.f, 0.f, 0.f, 0.f};
#pragma unroll
        for (int ai = 0; ai < 2; ++ai)
#pragma unroll
            for (int bj = 0; bj < 2; ++bj)
#pragma unroll
                for (int m = 0; m < 4; ++m)
#pragma unroll
                    for (int n = 0; n < 2; ++n) s += acc[ai][bj][m][n];
        if (never) *(f32x4*)(out + (size_t)(u.pm * BM + wr * 64 + fr) * 2048 + u.pn * BM + wc * 32 + 4 * fq) = s;
    }
};
struct EpiBf16W {
    static constexpr bool PERM = true, WIDE = true, AFTER_DRAIN = false;
    bf16_t* O; int ldc; PG8_LAS unsigned char* stg;
    __device__ __forceinline__ void operator()(const f32x4 (&acc)[2][2][4][2], const Unit& u, int wr, int wc, int fr, int fq) const {
        PG8_LAS unsigned char* my = stg + (wr * 4 + wc) * 2304;
        const int lane = fq * 16 + fr, rrow = lane >> 3, rc8 = lane & 7;
        bf16_t* obase = O + (size_t)(u.pm * BM + wr * 64 + rrow) * ldc + u.pn * BM + wc * 64 + rc8 * 8;
#pragma unroll
        for (int ai = 0; ai < 2; ++ai)
#pragma unroll
            for (int m = 0; m < 4; ++m) {
                u32x4 w0, w1;
                w0.x = cvt_pk_bf16(acc[ai][0][m][0][0], acc[ai][0][m][0][1]); w0.y = cvt_pk_bf16(acc[ai][0][m][0][2], acc[ai][0][m][0][3]);
                w0.z = cvt_pk_bf16(acc[ai][0][m][1][0], acc[ai][0][m][1][1]); w0.w = cvt_pk_bf16(acc[ai][0][m][1][2], acc[ai][0][m][1][3]);
                w1.x = cvt_pk_bf16(acc[ai][1][m][0][0], acc[ai][1][m][0][1]); w1.y = cvt_pk_bf16(acc[ai][1][m][0][2], acc[ai][1][m][0][3]);
                w1.z = cvt_pk_bf16(acc[ai][1][m][1][0], acc[ai][1][m][1][1]); w1.w = cvt_pk_bf16(acc[ai][1][m][1][2], acc[ai][1][m][1][3]);
                *(PG8_LAS u32x4*)(my + fr * 144 + fq * 32) = w0; *(PG8_LAS u32x4*)(my + fr * 144 + fq * 32 + 16) = w1;
                asm volatile("s_waitcnt lgkmcnt(0)" ::: "memory");
                const u32x4 r0 = *(const PG8_LAS u32x4*)(my + rrow * 144 + rc8 * 16), r1 = *(const PG8_LAS u32x4*)(my + (8 + rrow) * 144 + rc8 * 16);
                asm volatile("s_waitcnt lgkmcnt(0)" ::: "memory");
                bf16_t* op = obase + (size_t)(ai * HALF + m * 16) * ldc;
                __builtin_nontemporal_store(r0, (u32x4*)op); __builtin_nontemporal_store(r1, (u32x4*)(op + (size_t)8 * ldc));
            }
    }
};
struct EpiHot {
    static constexpr bool PERM = true, WIDE = false, AFTER_DRAIN = false;
    bf16_t* O;
    __device__ __forceinline__ void operator()(const f32x4 (&acc)[2][2][4][2], const Unit& u, int wr, int wc, int fr, int fq) const {
        const int row0 = wr * 64 + fr, col0 = wc * 32 + 8 * fq;
#pragma unroll
        for (int ai = 0; ai < 2; ++ai)
#pragma unroll
            for (int m = 0; m < 4; ++m) { bf16_t* rowp = O + (size_t)blockIdx.x * 65536 + (size_t)(row0 + ai * HALF + m * 16) * 256 + col0;
#pragma unroll
                for (int bj = 0; bj < 2; ++bj) { const f32x4 v0 = acc[ai][bj][m][0], v1 = acc[ai][bj][m][1];
                    u32x4 w; w.x = cvt_pk_bf16(v0[0], v0[1]); w.y = cvt_pk_bf16(v0[2], v0[3]); w.z = cvt_pk_bf16(v1[0], v1[1]); w.w = cvt_pk_bf16(v1[2], v1[3]);
                    *(u32x4*)(rowp + bj * HALF) = w; } }
    }
};
struct EpiF32P {
    static constexpr bool PERM = true, WIDE = false, AFTER_DRAIN = false;
    float* out; int ldc;
    __device__ __forceinline__ void operator()(const f32x4 (&acc)[2][2][4][2], const Unit& u, int wr, int wc, int fr, int fq) const {
        const int row0 = u.pm * BM + wr * 64 + fr, col0 = u.pn * BM + wc * 32 + 8 * fq;
#pragma unroll
        for (int ai = 0; ai < 2; ++ai)
#pragma unroll
            for (int m = 0; m < 4; ++m) { float* rowp = out + (size_t)(row0 + ai * HALF + m * 16) * ldc + col0;
#pragma unroll
                for (int bj = 0; bj < 2; ++bj) { *(f32x4*)(rowp + bj * HALF) = acc[ai][bj][m][0]; *(f32x4*)(rowp + bj * HALF + 4) = acc[ai][bj][m][1]; } }
    }
};
template <class Epi, class Sched, bool ALIGN_EPI = false, bool SP2 = false, int NHS = 0>
__device__ __forceinline__ void gemm_phase(PG8_LAS unsigned char* lds, const Gemm g, const Sched& S, const Epi& E, const PG8_LAS float* hs = nullptr) {
    int tid_ = threadIdx.x; asm volatile("" : "+v"(tid_));
    const int tid = tid_, wid = __builtin_amdgcn_readfirstlane(tid >> 6), lane = tid & 63, wr = wid >> 2, wc = wid & 3, fr = lane & 15, fq = lane >> 4;
    const int K = g.K, nt = K / BK;
    unsigned voffA[2], voffB[2];
#pragma unroll
    for (int i = 0; i < 2; ++i) { int R, C; stage_rc(tid * 16 + i * 8192, R, C); const int Rb = Epi::WIDE ? (64 * (R >> 5) + 16 * ((R & 15) >> 2) + 4 * ((R >> 4) & 1) + (R & 3)) : (Epi::PERM ? ((R & ~31) + perm32(R & 31)) : R);
        voffA[i] = (unsigned)(R * g.lda + C) * 2u; voffB[i] = (unsigned)(Rb * K + C) * 2u; }
    const size_t kstep = (size_t)(BK * 2);
    const size_t hstepA = (size_t)HALF * g.lda * 2, hstepB = Epi::WIDE ? (size_t)8 * K * 2 : (size_t)HALF * K * 2;
    const size_t tstepA = 2 * hstepA, tstepB = (size_t)BM * K * 2;
    const unsigned ldsw = (unsigned)wid * 1024u;
    const int aoff = lds_byte(wr * 64 + fr, fq * 8), boff = lds_byte(wc * 32 + fr, fq * 8);
#define PG8_SA(b, h) (((b) * 2 + (h)) * HTB)
#define PG8_SB(b, h) ((4 + (b) * 2 + (h)) * HTB)
#define PG8_STAGE(bufoff, gbase, voff) do { _Pragma("unroll") for (int _i = 0; _i < 2; ++_i) \
        __builtin_amdgcn_global_load_lds((const unsigned*)((const char*)(gbase) + (voff)[_i]), (PG8_LAS unsigned*)(lds + (bufoff) + ldsw + _i * 8192), 16, 0, 0); } while (0)
#define PG8_LDA(dst, b, h) do { _Pragma("unroll") for (int m = 0; m < 4; ++m) _Pragma("unroll") for (int k = 0; k < 2; ++k) dst[m][k] = *(const PG8_LAS bf16x8*)(lds + PG8_SA(b, h) + aoff + m * 2048 + k * 1024); } while (0)
#define PG8_LDB(dst, b, h) do { _Pragma("unroll") for (int n = 0; n < 2; ++n) _Pragma("unroll") for (int k = 0; k < 2; ++k) dst[n][k] = *(const PG8_LAS bf16x8*)(lds + PG8_SB(b, h) + boff + n * 2048 + k * 1024); } while (0)
#define PG8_MMA(ai, bj, At, Bt) do { __builtin_amdgcn_s_setprio(1); _Pragma("unroll") for (int m = 0; m < 4; ++m) _Pragma("unroll") for (int n = 0; n < 2; ++n) _Pragma("unroll") for (int k = 0; k < 2; ++k) \
        acc[ai][bj][m][n] = __builtin_amdgcn_mfma_f32_16x16x32_bf16(Bt[n][k], At[m][k], acc[ai][bj][m][n], 0, 0, 0); __builtin_amdgcn_s_setprio(0); } while (0)
#define PG8_WAIT_V(n) asm volatile("s_waitcnt vmcnt(" #n ")" ::: "memory")
#define PG8_WAIT_L(n) asm volatile("s_waitcnt lgkmcnt(" #n ")" ::: "memory")
#define PG8_BAR __builtin_amdgcn_s_barrier()
#define PG8_SCHED __builtin_amdgcn_sched_barrier(0)
    Unit cur, nxt; int ui = 0;
    if (!S.next(0, cur)) return;
    f32x4 acc[2][2][4][2];
#pragma unroll
    for (int a = 0; a < 2; ++a)
#pragma unroll
        for (int b = 0; b < 2; ++b)
#pragma unroll
            for (int m = 0; m < 4; ++m)
#pragma unroll
                for (int n = 0; n < 2; ++n) acc[a][b][m][n] = (f32x4){0.f, 0.f, 0.f, 0.f};
    bf16x8 At[4][2], B0[2][2], B1[2][2];
    const char* cA = (const char*)g.A + (size_t)cur.pm * tstepA; const char* cB = (const char*)g.Bt + (size_t)cur.pn * tstepB;
    S.a_ready(cur);
    if constexpr (SP2) {
        PG8_STAGE(PG8_SB(0, 0), cB, voffB); PG8_STAGE(PG8_SB(0, 1), cB + hstepB, voffB); PG8_STAGE(PG8_SA(0, 0), cA, voffA); PG8_STAGE(PG8_SA(0, 1), cA + hstepA, voffA);
        if (wr == 1) PG8_BAR;
        PG8_WAIT_V(2); PG8_BAR;
        PG8_STAGE(PG8_SB(1, 0), cB + kstep, voffB); PG8_STAGE(PG8_SA(1, 0), cA + kstep, voffA); PG8_STAGE(PG8_SB(1, 1), cB + hstepB + kstep, voffB);
        PG8_WAIT_V(6); PG8_BAR;
    } else {
        PG8_STAGE(PG8_SB(0, 0), cB, voffB); PG8_STAGE(PG8_SA(0, 0), cA, voffA); PG8_STAGE(PG8_SB(0, 1), cB + hstepB, voffB); PG8_STAGE(PG8_SA(0, 1), cA + hstepA, voffA);
        if (wr == 1) PG8_BAR;
        PG8_WAIT_V(4); PG8_BAR;
        PG8_STAGE(PG8_SB(1, 0), cB + kstep, voffB); PG8_STAGE(PG8_SA(1, 0), cA + kstep, voffA); PG8_STAGE(PG8_SB(1, 1), cB + hstepB + kstep, voffB);
        PG8_WAIT_V(6); PG8_BAR;
    }
    for (;;) {
        const bool has_next = S.next(ui + 1, nxt);
        const char* nA = has_next ? (const char*)g.A + (size_t)nxt.pm * tstepA : cA; const char* nB = has_next ? (const char*)g.Bt + (size_t)nxt.pn * tstepB : cB;
        for (int t = 0; t < nt; t += 2) {
            const bool last = (t == nt - 2);
            const char* a1 = cA + (size_t)(t + 1) * kstep;
            const char* a2 = last ? nA : cA + (size_t)(t + 2) * kstep; const char* b2 = last ? nB : cB + (size_t)(t + 2) * kstep;
            const char* a3 = a2 + kstep; const char* b3 = b2 + kstep;
            if (last && has_next) S.a_ready(nxt);
            if constexpr (SP2) {
            PG8_LDB(B0, 0, 0); PG8_LDB(B1, 0, 1); PG8_SCHED; PG8_LDA(At, 0, 0); PG8_STAGE(PG8_SA(1, 1), a1 + hstepA, voffA);
            PG8_WAIT_V(8); PG8_WAIT_L(0); PG8_BAR; PG8_MMA(0, 0, At, B0); PG8_MMA(0, 1, At, B1); PG8_BAR; PG8_SCHED;
            PG8_LDA(At, 0, 1); PG8_STAGE(PG8_SB(0, 0), b2, voffB); PG8_STAGE(PG8_SB(0, 1), b2 + hstepB, voffB); PG8_STAGE(PG8_SA(0, 0), a2, voffA);
            PG8_WAIT_V(8); PG8_WAIT_L(0); PG8_BAR; PG8_MMA(1, 0, At, B0); PG8_MMA(1, 1, At, B1); PG8_BAR; PG8_SCHED;
            PG8_LDB(B0, 1, 0); PG8_LDB(B1, 1, 1); PG8_SCHED; PG8_LDA(At, 1, 0); PG8_STAGE(PG8_SA(0, 1), a2 + hstepA, voffA);
            PG8_WAIT_V(8); PG8_WAIT_L(0); PG8_BAR; PG8_MMA(0, 0, At, B0); PG8_MMA(0, 1, At, B1); PG8_BAR; PG8_SCHED;
            PG8_LDA(At, 1, 1); PG8_STAGE(PG8_SB(1, 0), b3, voffB); PG8_STAGE(PG8_SB(1, 1), b3 + hstepB, voffB); PG8_STAGE(PG8_SA(1, 0), a3, voffA);
            PG8_WAIT_V(8); PG8_WAIT_L(0); PG8_BAR; PG8_MMA(1, 0, At, B0); PG8_MMA(1, 1, At, B1); PG8_BAR; PG8_SCHED;
            if constexpr (NHS > 0) {
                if (((t + 2) & 7) == 0 && ((t + 2) >> 3) <= NHS) { const PG8_LAS float* tp = hs + (((t + 2) >> 3) - 1) * 256 + wr * 64 + fr;
#pragma unroll
                    for (int ai = 0; ai < 2; ++ai)
#pragma unroll
                        for (int m = 0; m < 4; ++m) { const float f = tp[ai * HALF + m * 16];
#pragma unroll
                            for (int bj = 0; bj < 2; ++bj)
#pragma unroll
                                for (int n = 0; n < 2; ++n) acc[ai][bj][m][n] *= f; }
                    PG8_SCHED; }
            }
            } else {
            PG8_LDB(B0, 0, 0); PG8_SCHED; PG8_LDA(At, 0, 0); PG8_STAGE(PG8_SA(1, 1), a1 + hstepA, voffA);
            PG8_WAIT_L(8); PG8_BAR; PG8_WAIT_L(0); PG8_MMA(0, 0, At, B0); PG8_BAR; PG8_SCHED;
            PG8_LDB(B1, 0, 1); PG8_STAGE(PG8_SB(0, 0), b2, voffB);
            PG8_BAR; PG8_WAIT_L(0); PG8_MMA(0, 1, At, B1); PG8_BAR;
            PG8_LDA(At, 0, 1); PG8_STAGE(PG8_SA(0, 0), a2, voffA);
            PG8_BAR; PG8_WAIT_L(0); PG8_MMA(1, 0, At, B0); PG8_BAR; PG8_SCHED;
            PG8_STAGE(PG8_SB(0, 1), b2 + hstepB, voffB);
            PG8_WAIT_V(6); PG8_BAR; PG8_MMA(1, 1, At, B1); PG8_BAR;
            PG8_LDB(B0, 1, 0); PG8_SCHED; PG8_LDA(At, 1, 0); PG8_STAGE(PG8_SA(0, 1), a2 + hstepA, voffA);
            PG8_WAIT_L(8); PG8_BAR; PG8_WAIT_L(0); PG8_MMA(0, 0, At, B0); PG8_BAR; PG8_SCHED;
            PG8_LDB(B1, 1, 1); PG8_STAGE(PG8_SB(1, 0), b3, voffB);
            PG8_BAR; PG8_WAIT_L(0); PG8_MMA(0, 1, At, B1); PG8_BAR;
            PG8_LDA(At, 1, 1); PG8_STAGE(PG8_SA(1, 0), a3, voffA);
            PG8_BAR; PG8_WAIT_L(0); PG8_MMA(1, 0, At, B0); PG8_BAR; PG8_SCHED;
            PG8_STAGE(PG8_SB(1, 1), b3 + hstepB, voffB);
            PG8_WAIT_V(6); PG8_BAR; PG8_MMA(1, 1, At, B1); PG8_BAR;
            }
        }
        if constexpr (ALIGN_EPI) { if (wr == 0) PG8_BAR; }
        if constexpr (!Epi::AFTER_DRAIN) { E(acc, cur, wr, wc, fr, fq); S.done(cur); }
        if (!has_next) break;
#pragma unroll
        for (int a = 0; a < 2; ++a)
#pragma unroll
            for (int b = 0; b < 2; ++b)
#pragma unroll
                for (int m = 0; m < 4; ++m)
#pragma unroll
                    for (int n = 0; n < 2; ++n) acc[a][b][m][n] = (f32x4){0.f, 0.f, 0.f, 0.f};
        cur = nxt; cA = nA; cB = nB; ++ui;
        if constexpr (ALIGN_EPI) { if (wr == 1) PG8_BAR; }
    }
    PG8_WAIT_V(0);
    if constexpr (!ALIGN_EPI) { if (wr == 0) PG8_BAR; }
    PG8_BAR;
    if constexpr (Epi::AFTER_DRAIN) { E.fused(acc, cur, wr, wc, fr, fq, lds, wid, lane); S.done(cur); }
#undef PG8_SA
#undef PG8_SB
#undef PG8_STAGE
#undef PG8_LDA
#undef PG8_LDB
#undef PG8_MMA
#undef PG8_WAIT_V
#undef PG8_WAIT_L
#undef PG8_BAR
#undef PG8_SCHED
}
}

constexpr int T = 16384, SEQ = 8192, DM = 2048, LD = 12288 + 64;
constexpr int Q0 = 0, K0 = 1024, V0 = 2048, U0 = 4096, VS0 = 6144, GR0 = 8192, GS0 = 10240;
constexpr int Q1 = 0, K1 = 2048, V1 = 4096, G1 = 8192;
constexpr int MIXC = 8192;
constexpr size_t MiB = 1u << 20;
constexpr size_t WS_LR = 1 * MiB, WS_WLRT = 2 * MiB, WS_DEC = 3 * MiB, WS_WA = 8 * MiB, WS_H = 56 * MiB, WS_P = 120 * MiB, WS_END = 512 * MiB;
static_assert(WS_P + (size_t)T * LD * 2 <= WS_END, "d_ws map");
constexpr size_t WS_SC = WS_H, WS_SS = WS_H + 16 * MiB, WS_WO0 = WS_H + 32 * MiB;
constexpr int HS_OFF = 131072 + 8 * 2304 + 256;
constexpr int LDS_BYTES = HS_OFF + 8192;
#ifndef PROBE
#define PROBE 0
#endif

#define LAS __attribute__((address_space(3)))
typedef unsigned short bf16;
typedef short bf16x8 __attribute__((ext_vector_type(8)));
typedef float f32x4 __attribute__((ext_vector_type(4)));
typedef unsigned u32x4 __attribute__((ext_vector_type(4)));
typedef unsigned u32x2 __attribute__((ext_vector_type(2)));
#define LDS_WAIT() asm volatile("s_waitcnt lgkmcnt(0)" ::: "memory")
typedef float f32x2_t __attribute__((ext_vector_type(2)));
typedef __bf16 bf16x2_t __attribute__((ext_vector_type(2)));
__device__ __forceinline__ unsigned pk2(float lo, float hi) { const f32x2_t v = {lo, hi}; const bf16x2_t b = __builtin_convertvector(v, bf16x2_t); return __builtin_bit_cast(unsigned, b); }
__device__ __forceinline__ unsigned f2bf(float f) { return pk2(f, 0.f) & 0xffffu; }
__device__ __forceinline__ float bflo(unsigned w) { return __builtin_bit_cast(float, w << 16); }
__device__ __forceinline__ float bfhi(unsigned w) { return __builtin_bit_cast(float, w & 0xffff0000u); }
__device__ __forceinline__ float bf2f(bf16 b) { return __builtin_bit_cast(float, ((unsigned)b) << 16); }
__device__ __forceinline__ f32x4 mma16(bf16x8 a, bf16x8 b, f32x4 c) { return __builtin_amdgcn_mfma_f32_16x16x32_bf16(a, b, c, 0, 0, 0); }
__device__ __forceinline__ float wave_sum(float v) {
#pragma unroll
    for (int o = 1; o < 64; o <<= 1) v += __shfl_xor(v, o);
    return v;
}
__device__ __forceinline__ float silu(float g) { return g / (1.f + __expf(-g)); }

__device__ __forceinline__ void transpose_item(const float* W, int ldw, int K, bf16* WT, int k0, int n0, int drow0, LAS float* scr, int lane) {
#pragma unroll 8
    for (int i = 0; i < 32; ++i) { const int kk = 2 * i + (lane >> 5); scr[kk * 33 + (lane & 31)] = __builtin_nontemporal_load(W + (size_t)(k0 + kk) * ldw + n0 + (lane & 31)); }
    LDS_WAIT(); asm volatile("" ::: "memory");
    const int c = lane & 7;
#pragma unroll
    for (int j = 0; j < 4; ++j) { const int n = (lane >> 3) + 8 * j; const LAS float* s = scr + (8 * c) * 33 + n;
        u32x4 o; o.x = pk2(s[0 * 33], s[1 * 33]); o.y = pk2(s[2 * 33], s[3 * 33]); o.z = pk2(s[4 * 33], s[5 * 33]); o.w = pk2(s[6 * 33], s[7 * 33]);
        *(u32x4*)(WT + (size_t)(drow0 + n) * K + k0 + 8 * c) = o; }
    LDS_WAIT(); asm volatile("" ::: "memory");
}
__device__ __forceinline__ int perm0(int n) { return n < 4096 ? n : (n < 6144 ? n + 4096 : (n < 10240 ? n - 2048 : n)); }
template <bool PERM> __device__ __forceinline__ void transpose_all(const float* W, int ldw, int K, int N, bf16* WT, LAS float* scr, int gw, int ngw, int lane) {
    const int nblk = N / 32, nitems = (K / 64) * nblk;
    for (int it = gw; it < nitems; it += ngw) { const int kb = it / nblk, nb = it % nblk; const int n0 = nb * 32;
        transpose_item(W, ldw, K, WT, kb * 64, n0, PERM ? perm0(n0) : n0, scr, lane); }
}
__device__ __forceinline__ void rms_row_bf16(const float* xrow, const float* g, bf16* orow, int lane) {
    f32x4 v[8]; float s = 0.f;
#pragma unroll
    for (int j = 0; j < 8; ++j) { v[j] = __builtin_nontemporal_load((const f32x4*)xrow + 64 * j + lane); s += (v[j].x * v[j].x + v[j].y * v[j].y) + (v[j].z * v[j].z + v[j].w * v[j].w); }
    const float r = rsqrtf(wave_sum(s) * (1.f / DM) + 1e-6f);
#pragma unroll
    for (int j = 0; j < 8; ++j) { const f32x4 gg = ((const f32x4*)g)[64 * j + lane]; const f32x4 o = v[j] * r * gg;
        u32x2 w; w.x = pk2(o.x, o.y); w.y = pk2(o.z, o.w); ((u32x2*)orow)[64 * j + lane] = w; }
}
__device__ __forceinline__ void res_rms_row_bf16(const float* xrow, const bf16* acc, const float* g, bf16* orow, int lane) {
    f32x4 v[8]; float s = 0.f;
#pragma unroll
    for (int j = 0; j < 8; ++j) { const u32x2 a = ((const u32x2*)acc)[64 * j + lane]; v[j] = __builtin_nontemporal_load((const f32x4*)xrow + 64 * j + lane) + (f32x4){bflo(a.x), bfhi(a.x), bflo(a.y), bfhi(a.y)};
        s += (v[j].x * v[j].x + v[j].y * v[j].y) + (v[j].z * v[j].z + v[j].w * v[j].w); }
    const float r = rsqrtf(wave_sum(s) * (1.f / DM) + 1e-6f);
#pragma unroll
    for (int j = 0; j < 8; ++j) { const f32x4 gg = ((const f32x4*)g)[64 * j + lane]; const f32x4 o = v[j] * r * gg;
        u32x2 w; w.x = pk2(o.x, o.y); w.y = pk2(o.z, o.w); ((u32x2*)orow)[64 * j + lane] = w; }
}
__device__ __forceinline__ void res_rms_row_f32(const float* xrow, float* io, const bf16* acc2, const float* g, int lane) {
    f32x4 v[8]; float s = 0.f;
#pragma unroll
    for (int j = 0; j < 8; ++j) { const u32x2 a1 = __builtin_nontemporal_load((const u32x2*)io + 64 * j + lane), a2 = __builtin_nontemporal_load((const u32x2*)acc2 + 64 * j + lane);
        v[j] = (__builtin_nontemporal_load((const f32x4*)xrow + 64 * j + lane) + (f32x4){bflo(a1.x), bfhi(a1.x), bflo(a1.y), bfhi(a1.y)}) + (f32x4){bflo(a2.x), bfhi(a2.x), bflo(a2.y), bfhi(a2.y)};
        s += (v[j].x * v[j].x + v[j].y * v[j].y) + (v[j].z * v[j].z + v[j].w * v[j].w); }
    const float r = rsqrtf(wave_sum(s) * (1.f / DM) + 1e-6f);
#pragma unroll
    for (int j = 0; j < 8; ++j) { const f32x4 gg = ((const f32x4*)g)[64 * j + lane]; __builtin_nontemporal_store(v[j] * r * gg, (f32x4*)io + 64 * j + lane); }
}

template <bool DRY> __device__ __forceinline__ void retpre_unit(LAS unsigned char* lds, bf16* Pb, const int* pos, bf16* SC, float* DEC, int u, int tid, int never) {
    const int h = u & 3, n = (u >> 2) & 127, b = u >> 9;
    const int r0 = b * SEQ + n * 64;
    LAS bf16* Qs = (LAS bf16*)lds; LAS bf16* Ks = Qs + 64 * 264;
    const float lg2 = __log2f(1.f - exp2f(-5.f - (float)h));
    const int wv = tid >> 6, lane = tid & 63, l15 = lane & 15, quad = lane >> 4;
    for (int it = tid; it < 1024; it += 512) {
        const int t = it >> 4, j8 = it & 15;
        const float p = (float)pos[r0 + t];
        const bf16* qr = Pb + (size_t)(r0 + t) * LD + Q0 + h * 256 + j8 * 8;
        const bf16* kr = Pb + (size_t)(r0 + t) * LD + K0 + h * 256 + j8 * 8;
        const u32x4 q1 = *(const u32x4*)qr, q2 = *(const u32x4*)(qr + 128), k1 = *(const u32x4*)kr, k2 = *(const u32x4*)(kr + 128);
        u32x4 oq1, oq2, ok1, ok2;
#pragma unroll
        for (int e2 = 0; e2 < 4; ++e2) {
            float cs[2], sn[2];
#pragma unroll
            for (int z = 0; z < 2; ++z) { const float j = (float)(j8 * 8 + e2 * 2 + z);
                const float cj = exp2f(j * -0.10381025296523008f) * 0.15915494309189535f;
                const float hi = p * cj, lo = fmaf(p, cj, -hi); const float fr = (hi - floorf(hi)) + lo;
                sn[z] = __builtin_amdgcn_sinf(fr); cs[z] = __builtin_amdgcn_cosf(fr); }
            const float a0 = bflo(q1[e2]), a1 = bfhi(q1[e2]), b0 = bflo(q2[e2]), b1 = bfhi(q2[e2]);
            oq1[e2] = pk2((a0 * cs[0] - b0 * sn[0]) * 0.0625f, (a1 * cs[1] - b1 * sn[1]) * 0.0625f);
            oq2[e2] = pk2((a0 * sn[0] + b0 * cs[0]) * 0.0625f, (a1 * sn[1] + b1 * cs[1]) * 0.0625f);
            const float c0 = bflo(k1[e2]), c1 = bfhi(k1[e2]), d0 = bflo(k2[e2]), d1 = bfhi(k2[e2]);
            ok1[e2] = pk2(c0 * cs[0] - d0 * sn[0], c1 * cs[1] - d1 * sn[1]);
            ok2[e2] = pk2(c0 * sn[0] + d0 * cs[0], c1 * sn[1] + d1 * cs[1]);
        }
        *(LAS u32x4*)(Qs + t * 264 + j8 * 8) = oq1; *(LAS u32x4*)(Qs + t * 264 + 128 + j8 * 8) = oq2;
        *(LAS u32x4*)(Ks + t * 264 + j8 * 8) = ok1; *(LAS u32x4*)(Ks + t * 264 + 128 + j8 * 8) = ok2;
    }
    __syncthreads();
#pragma unroll
    for (int tl = 0; tl < 2; ++tl) { const int tile = 2 * wv + tl, ti = tile >> 2, si = tile & 3; const int t = ti * 16 + l15;
        u32x2 w; w.x = 0u; w.y = 0u;
        if (si <= ti) { f32x4 acc = {0.f, 0.f, 0.f, 0.f};
#pragma unroll
            for (int kk = 0; kk < 8; ++kk) { const bf16x8 qf = *(const LAS bf16x8*)(Qs + t * 264 + kk * 32 + quad * 8); const bf16x8 kf = *(const LAS bf16x8*)(Ks + (si * 16 + l15) * 264 + kk * 32 + quad * 8); acc = mma16(kf, qf, acc); }
            float v[4];
#pragma unroll
            for (int e = 0; e < 4; ++e) { const int s_ = si * 16 + quad * 4 + e; v[e] = (s_ <= t) ? acc[e] * exp2f((float)(t - s_) * lg2) : 0.f; }
            w.x = pk2(v[0], v[1]); w.y = pk2(v[2], v[3]); }
        if (!DRY || never) *(u32x2*)(SC + (size_t)u * 4096 + ((ti * 2 + (si >> 1)) * 64 + ((si & 1) * 2 + (quad >> 1)) * 16 + l15) * 8 + (quad & 1) * 4) = w; }
    for (int it = tid; it < 2048; it += 512) {
        const int fb = it >> 6, L = it & 63, tt = fb >> 3, kk = fb & 7, fl = L & 15, fq = L >> 4; const int t = tt * 16 + fl;
        const u32x4 v = *(const LAS u32x4*)(Qs + t * 264 + kk * 32 + fq * 8); const float f = exp2f((float)(t + 1) * lg2);
        u32x4 o;
#pragma unroll
        for (int e = 0; e < 4; ++e) o[e] = pk2(bflo(v[e]) * f, bfhi(v[e]) * f);
        if (!DRY || never) *(u32x4*)(Pb + (size_t)(r0 + 2 * fb + (L >> 5)) * LD + Q0 + h * 256 + (L & 31) * 8) = o;
    }
    for (int it = tid; it < 2048; it += 512) {
        const int fb = it >> 6, L = it & 63, kt = fb >> 1, kk = fb & 1, fl = L & 15, fq = L >> 4; const int k = kt * 16 + fl;
        u32x4 o;
#pragma unroll
        for (int e2 = 0; e2 < 4; ++e2) { const int s_ = kk * 32 + fq * 8 + e2 * 2;
            o[e2] = pk2(bf2f(Ks[s_ * 264 + k]) * exp2f((float)(63 - s_) * lg2), bf2f(Ks[(s_ + 1) * 264 + k]) * exp2f((float)(62 - s_) * lg2)); }
        if (!DRY || never) *(u32x4*)(Pb + (size_t)(r0 + 2 * fb + (L >> 5)) * LD + K0 + h * 256 + (L & 31) * 8) = o;
    }
    if ((!DRY || never) && tid < 256) DEC[(size_t)u * 256 + tid] = exp2f(64.f * lg2);
    __syncthreads();
}

template <bool DRY> __device__ __forceinline__ void sgu_unit(LAS unsigned char* lds, bf16* Pb, const float* gain, const float* w_s, const float* b_s, int u, int tid, int never) {
    const int g = u & 7, n = (u >> 3) & 63, b = u >> 9;
    const int r0 = b * SEQ + n * 128;
    LAS bf16* VnT = (LAS bf16*)lds;
    LAS bf16* Ws = VnT + 256 * 136;
    const int wv = tid >> 6, lane = tid & 63, l15 = lane & 15, quad = lane >> 4;
    for (int it = tid; it < 4096; it += 512) {
        const int t = it >> 5, s4 = (it & 31) * 4;
        const f32x4 w = *(const f32x4*)(w_s + (size_t)g * 16384 + t * 128 + s4);
        u32x2 o; o.x = pk2(s4 <= t ? w.x : 0.f, s4 + 1 <= t ? w.y : 0.f); o.y = pk2(s4 + 2 <= t ? w.z : 0.f, s4 + 3 <= t ? w.w : 0.f);
        *(LAS u32x2*)(Ws + t * 136 + s4) = o;
    }
    {
        const int row = tid >> 2, part = tid & 3;
        const bf16* src = Pb + (size_t)(r0 + row) * LD + VS0 + g * 256 + part * 64;
        u32x4 x[8]; float s = 0.f, s2 = 0.f;
#pragma unroll
        for (int j = 0; j < 8; ++j) { x[j] = *(const u32x4*)(src + j * 8);
#pragma unroll
            for (int e = 0; e < 4; ++e) { const float a = bflo(x[j][e]), c = bfhi(x[j][e]); s += a + c; s2 += a * a + c * c; } }
        s += __shfl_xor(s, 1); s2 += __shfl_xor(s2, 1); s += __shfl_xor(s, 2); s2 += __shfl_xor(s2, 2);
        const float mean = s * (1.f / 256.f); const float var = fmaxf(s2 * (1.f / 256.f) - mean * mean, 0.f); const float rstd = rsqrtf(var + 1e-6f);
        const float* gp = gain + g * 256 + part * 64;
#pragma unroll
        for (int j = 0; j < 8; ++j)
#pragma unroll
            for (int e = 0; e < 4; ++e) { const int c = part * 64 + j * 8 + e * 2;
                VnT[c * 136 + row] = (bf16)f2bf((bflo(x[j][e]) - mean) * rstd * gp[j * 8 + e * 2]);
                VnT[(c + 1) * 136 + row] = (bf16)f2bf((bfhi(x[j][e]) - mean) * rstd * gp[j * 8 + e * 2 + 1]); }
    }
    __syncthreads();
    {
        const int t = wv * 16 + l15; const int nk = (wv >> 1) + 1;
        bf16x8 wf[4];
#pragma unroll
        for (int kk = 0; kk < 4; ++kk) wf[kk] = *(const LAS bf16x8*)(Ws + t * 136 + kk * 32 + quad * 8);
        const float bias = b_s[g * 128 + t];
        bf16* rowp = Pb + (size_t)(r0 + t) * LD + g * 256 + quad * 4;
        for (int ci = 0; ci < 16; ++ci) {
            f32x4 acc = {0.f, 0.f, 0.f, 0.f};
#pragma unroll
            for (int kk = 0; kk < 4; ++kk) if (kk < nk) { const bf16x8 vf = *(const LAS bf16x8*)(VnT + (ci * 16 + l15) * 136 + kk * 32 + quad * 8); acc = mma16(vf, wf[kk], acc); }
            const u32x2 uu = *(const u32x2*)(rowp + U0 + ci * 16), gs = *(const u32x2*)(rowp + GS0 + ci * 16);
            u32x2 o;
            o.x = pk2(bflo(uu.x) * (acc[0] + bias) * silu(bflo(gs.x)), bfhi(uu.x) * (acc[1] + bias) * silu(bfhi(gs.x)));
            o.y = pk2(bflo(uu.y) * (acc[2] + bias) * silu(bflo(gs.y)), bfhi(uu.y) * (acc[3] + bias) * silu(bfhi(gs.y)));
            if (!DRY || never) *(u32x2*)(rowp + GS0 + ci * 16) = o;
        }
    }
    __syncthreads();
}

#define LBAR() do { asm volatile("s_waitcnt lgkmcnt(0)" ::: "memory"); __builtin_amdgcn_s_barrier(); asm volatile("" ::: "memory"); } while (0)
template <int NH, int QOFF, int KOFF, int VOFF, int GOFF, bool DRY>
__device__ __forceinline__ void scan_worker(LAS unsigned char* lds, bf16* Pb, const bf16* SC, const float* DEC, float* SS, int wk, int tid, int never) {
    constexpr int C = 64, NC = SEQ / C, VTS = C + 8, STS = 264;
    constexpr int ST_ELEMS = 32 * STS, VT_ELEMS = 32 * VTS;
    const int w = __builtin_amdgcn_readfirstlane(tid >> 6), lane = tid & 63, l15 = lane & 15, quad = lane >> 4;
    const int bh = wk >> 4, sl = wk & 15, b = bh / NH, h = bh % NH;
    LAS bf16* ST = (LAS bf16*)lds;
    LAS bf16* VT = ST + 2 * ST_ELEMS;
    LAS float* DC = (LAS float*)(VT + 2 * VT_ELEMS);
    const int vcol = VOFF + h * 512 + sl * 32;
    const int wq = w & 3;
    for (int i = tid; i < ST_ELEMS / 2; i += 512) ((LAS unsigned*)ST)[i] = 0u;
    if (w < 4) {
        const int vs_s = tid >> 2, vs_p = tid & 3;
        const unsigned offQ = (unsigned)((wq * 16 + (lane >> 5)) * LD + QOFF + h * 256 + (lane & 31) * 8), offP = (unsigned)(wq * 1024 + lane * 8);
        const unsigned offV = (unsigned)(vs_s * LD + vcol + vs_p * 8);
        const unsigned offO = (unsigned)((wq * 16 + l15) * LD + (vcol - VOFF + GOFF) + quad * 8), offS = (unsigned)(((wq * 16 + l15) * NH + h) * 32 + sl * 2);
        bf16x8 frA[10], frB[10], frC[10]; u32x4 vrA, vrB, vrC, ggA, ggB, ggC;
#define O_LOAD(S, nn) do { const bf16* cb_ = Pb + (size_t)(b * SEQ + (nn) * C) * LD; const bf16* sb_ = SC + (size_t)((b * NC + (nn)) * NH + h) * (C * C); \
            _Pragma("unroll") for (int kk = 0; kk < 8; ++kk) { const bf16* ck_ = cb_ + kk * 2 * LD; fr##S[kk] = *(const bf16x8*)(ck_ + offQ); } \
            _Pragma("unroll") for (int kk = 0; kk < 2; ++kk) fr##S[8 + kk] = *(const bf16x8*)(sb_ + offP + kk * 512); \
            vr##S = *(const u32x4*)(cb_ + offV); gg##S = *(const u32x4*)(cb_ + offO); } while (0)
#define O_VT_WRITE(S, VTp) do { _Pragma("unroll") for (int e = 0; e < 4; ++e) { const int row_ = (e >> 1) * 16 + vs_p * 4 + (e & 1) * 2; (VTp)[row_ * VTS + vs_s] = (bf16)(vr##S[e] & 0xffffu); (VTp)[(row_ + 1) * VTS + vs_s] = (bf16)(vr##S[e] >> 16); } } while (0)
#define O_STEP(S, SN, SL, n_) do { const int n = (n_); const int buf = n & 1; const int r0 = b * SEQ + n * C; \
            LAS bf16* STb = ST + buf * ST_ELEMS; LAS bf16* VTb = VT + buf * VT_ELEMS; LAS bf16* VTn = VT + (buf ^ 1) * VT_ELEMS; \
            LBAR(); \
            { const int nn_ = (n + 2 < NC) ? n + 2 : NC - 1; O_LOAD(SL, nn_); } \
            f32x4 o0 = {0.f, 0.f, 0.f, 0.f}, o1 = {0.f, 0.f, 0.f, 0.f}; \
            _Pragma("unroll") for (int kk = 0; kk < 8; ++kk) { const bf16x8 s0 = *(const LAS bf16x8*)(STb + l15 * STS + kk * 32 + quad * 8); const bf16x8 s1 = *(const LAS bf16x8*)(STb + (16 + l15) * STS + kk * 32 + quad * 8); \
                o0 = mma16(s0, fr##S[kk], o0); o1 = mma16(s1, fr##S[kk], o1); } \
            _Pragma("unroll") for (int kk = 0; kk < 2; ++kk) { const bf16x8 v0 = *(const LAS bf16x8*)(VTb + l15 * VTS + kk * 32 + quad * 8); const bf16x8 v1 = *(const LAS bf16x8*)(VTb + (16 + l15) * VTS + kk * 32 + quad * 8); \
                o0 = mma16(v0, fr##S[8 + kk], o0); o1 = mma16(v1, fr##S[8 + kk], o1); } \
            u32x4 pp; pp.x = pk2(o0[0] * silu(bflo(gg##S.x)), o0[1] * silu(bfhi(gg##S.x))); pp.y = pk2(o0[2] * silu(bflo(gg##S.y)), o0[3] * silu(bfhi(gg##S.y))); \
            pp.z = pk2(o1[0] * silu(bflo(gg##S.z)), o1[1] * silu(bfhi(gg##S.z))); pp.w = pk2(o1[2] * silu(bflo(gg##S.w)), o1[3] * silu(bfhi(gg##S.w))); \
            bf16* op = Pb + (size_t)r0 * LD + offO; \
            if (!DRY || never) *(u32x4*)op = pp; \
            float ss0 = (o0[0] * o0[0] + o0[1] * o0[1]) + (o0[2] * o0[2] + o0[3] * o0[3]), ss1 = (o1[0] * o1[0] + o1[1] * o1[1]) + (o1[2] * o1[2] + o1[3] * o1[3]); \
            ss0 += __shfl_xor(ss0, 16); ss1 += __shfl_xor(ss1, 16); ss0 += __shfl_xor(ss0, 32); ss1 += __shfl_xor(ss1, 32); \
            if ((!DRY || never) && quad == 0) { float* sp = SS + (size_t)r0 * NH * 32 + offS; sp[0] = ss0; sp[1] = ss1; } \
            O_VT_WRITE(SN, VTn); } while (0)
        O_LOAD(A, 0); O_LOAD(B, 1);
        O_VT_WRITE(A, VT);
        for (int n0 = 0; n0 < NC; n0 += 3) {
            O_STEP(A, B, C, n0);
            if (n0 + 1 < NC) O_STEP(B, C, A, n0 + 1);
            if (n0 + 2 < NC) O_STEP(C, A, B, n0 + 2);
        }
#undef O_LOAD
#undef O_VT_WRITE
#undef O_STEP
    } else {
        const unsigned offK = (unsigned)((wq * 16 + (lane >> 5)) * LD + KOFF + h * 256 + (lane & 31) * 8);
        const unsigned offD = (unsigned)(lane * 4);
        const bool dw = (w == 4);
        f32x4 sacc[4][2];
#pragma unroll
        for (int a = 0; a < 4; ++a)
#pragma unroll
            for (int v = 0; v < 2; ++v) sacc[a][v] = (f32x4){0.f, 0.f, 0.f, 0.f};
        bf16x8 frA[8], frB[8], frC[8]; u32x4 vrA = {0u, 0u, 0u, 0u}, vrB = vrA, vrC = vrA;
#define S_LOAD(S, nn) do { const bf16* cb_ = Pb + (size_t)(b * SEQ + (nn) * C) * LD; \
            _Pragma("unroll") for (int a = 0; a < 4; ++a) _Pragma("unroll") for (int kk = 0; kk < 2; ++kk) { const bf16* ca_ = cb_ + (a * 4 + kk * 2) * LD; fr##S[a * 2 + kk] = *(const bf16x8*)(ca_ + offK); } \
            if (dw) vr##S = *(const u32x4*)(DEC + (size_t)((b * NC + (nn)) * NH + h) * 256 + offD); } while (0)
#define S_STEP(S, SN, SL, n_) do { const int n = (n_); const int buf = n & 1; \
            LAS bf16* VTb = VT + buf * VT_ELEMS; LAS bf16* STn = ST + (buf ^ 1) * ST_ELEMS; LAS float* DCb = DC + buf * 256; \
            LBAR(); \
            { const int nn_ = (n + 2 < NC) ? n + 2 : NC - 1; S_LOAD(SL, nn_); } \
            bf16x8 vf[2][2]; \
            _Pragma("unroll") for (int v = 0; v < 2; ++v) _Pragma("unroll") for (int kk = 0; kk < 2; ++kk) vf[v][kk] = *(const LAS bf16x8*)(VTb + (v * 16 + l15) * VTS + kk * 32 + quad * 8); \
            _Pragma("unroll") for (int a = 0; a < 4; ++a) { const f32x4 dc4 = *(const LAS f32x4*)(DCb + (wq * 4 + a) * 16 + quad * 4); \
                _Pragma("unroll") for (int v = 0; v < 2; ++v) { \
                    f32x4 s_ = sacc[a][v] * dc4; \
                    _Pragma("unroll") for (int kk = 0; kk < 2; ++kk) s_ = mma16(fr##S[a * 2 + kk], vf[v][kk], s_); \
                    sacc[a][v] = s_; u32x2 o_; o_.x = pk2(s_[0], s_[1]); o_.y = pk2(s_[2], s_[3]); \
                    *(LAS u32x2*)(STn + (v * 16 + l15) * STS + (wq * 4 + a) * 16 + quad * 4) = o_; } } \
            if (dw) *(LAS u32x4*)(DC + (buf ^ 1) * 256 + lane * 4) = vr##SN; } while (0)
        S_LOAD(A, 0); S_LOAD(B, 1);
        if (dw) *(LAS u32x4*)(DC + lane * 4) = vrA;
        for (int n0 = 0; n0 < NC; n0 += 3) {
            S_STEP(A, B, C, n0);
            if (n0 + 1 < NC) S_STEP(B, C, A, n0 + 1);
            if (n0 + 2 < NC) S_STEP(C, A, B, n0 + 2);
        }
#undef S_LOAD
#undef S_STEP
    }
    asm volatile("s_waitcnt vmcnt(0)" ::: "memory");
    __syncthreads();
}

template <int NH, int GOFF, bool DRY>
__device__ __forceinline__ void fin_phase(bf16* Pb, const float* SS, int gw, int ngw, int lane, int never) {
    for (int item = gw; item < T * NH; item += ngw) {
        const int tok = item / NH, h = item % NH;
        float s = (lane < 32) ? __builtin_nontemporal_load(SS + (size_t)item * 32 + lane) : 0.f; s = wave_sum(s);
        const float rstd = rsqrtf(s * (1.f / 512.f) + 1e-6f);
        bf16* rowp = Pb + (size_t)tok * LD + GOFF + h * 512 + lane * 8;
        const u32x4 o = *(const u32x4*)rowp;
        u32x4 r;
#pragma unroll
        for (int e = 0; e < 4; ++e) r[e] = pk2(bflo(o[e]) * rstd, bfhi(o[e]) * rstd);
        if (!DRY || never) *(u32x4*)rowp = r;
    }
}

__device__ __forceinline__ void lr_phase(const bf16* H, const bf16* WLRT, float* LR, int gw, int ngw, int lane) {
    const int l15 = lane & 15, quad = lane >> 4;
    for (int tile = gw; tile < T / 16; tile += ngw) {
        f32x4 acc = {0.f, 0.f, 0.f, 0.f};
        const bf16* ap = H + (size_t)(tile * 16 + l15) * DM + quad * 8; const bf16* bp = WLRT + (size_t)l15 * DM + quad * 8;
#pragma unroll 8
        for (int kk = 0; kk < 64; ++kk) acc = mma16(*(const bf16x8*)(ap + kk * 32), *(const bf16x8*)(bp + kk * 32), acc);
#pragma unroll
        for (int e = 0; e < 4; ++e) LR[(size_t)(tile * 16 + quad * 4 + e) * 16 + l15] = acc[e];
    }
}

template <bool DRY> __device__ __forceinline__ void glapre_unit(LAS unsigned char* lds, bf16* Pb, const float* LR, const float* w_lr, const float* b_lr, bf16* SC, float* DEC, int u, int tid, int never) {
    const int h = u & 7, n = (u >> 3) & 127, b = u >> 10;
    const int r0 = b * SEQ + n * 64;
    LAS bf16* Qs = (LAS bf16*)lds; LAS bf16* Ks = Qs + 64 * 264;
    LAS float* lrs = (LAS float*)(lds + 2 * 64 * 264 * 2); LAS float* tot = lrs + 1024;
    const int c = tid & 255, half = tid >> 8;
    const int wv = tid >> 6, lane = tid & 63, l15 = lane & 15, quad = lane >> 4;
    if (tid < 256) ((LAS f32x4*)lrs)[tid] = ((const f32x4*)(LR + (size_t)r0 * 16))[tid];
    float wl[16];
#pragma unroll
    for (int r = 0; r < 16; ++r) wl[r] = w_lr[r * 2048 + h * 256 + c];
    const float bb = b_lr[h * 256 + c];
    u32x4 qraw[4], kraw[4];
#pragma unroll
    for (int j = 0; j < 4; ++j) { const int it = tid + 512 * j, t_ = it >> 5, c8 = it & 31; const bf16* gp = Pb + (size_t)(r0 + t_) * LD + h * 256 + c8 * 8;
        qraw[j] = *(const u32x4*)(gp + Q1); kraw[j] = *(const u32x4*)(gp + K1); }
    __syncthreads();
    float bc[32]; float run = 0.f;
#pragma unroll
    for (int i = 0; i < 32; ++i) { const int t = half * 32 + i; float z = bb;
#pragma unroll
        for (int r4 = 0; r4 < 4; ++r4) { const f32x4 l = ((const LAS f32x4*)lrs)[t * 4 + r4]; z += (l.x * wl[4 * r4] + l.y * wl[4 * r4 + 1]) + (l.z * wl[4 * r4 + 2] + l.w * wl[4 * r4 + 3]); }
        const float a = -(fmaxf(-z, 0.f) + __logf(1.f + __expf(-fabsf(z)))) * 0.0625f;
        run += a; bc[i] = run; }
    tot[half * 256 + c] = run;
#pragma unroll
    for (int j = 0; j < 4; ++j) { const int it = tid + 512 * j, t_ = it >> 5, c8 = it & 31; *(LAS u32x4*)(Qs + t_ * 264 + c8 * 8) = qraw[j]; *(LAS u32x4*)(Ks + t_ * 264 + c8 * 8) = kraw[j]; }
    __syncthreads();
    const float t0 = tot[c], t1 = tot[256 + c]; const float blast = t0 + t1, off = half ? t0 : 0.f; const float eb = __expf(blast);
    LAS float* ebs = tot + 512;
#pragma unroll
    for (int i = 0; i < 32; ++i) { const int t = half * 32 + i; const float bcv = bc[i] + off;
        const float q = bf2f(Qs[t * 264 + c]), k = bf2f(Ks[t * 264 + c]);
        const float e = __expf(bcv), ei = __expf(-bcv);
        Qs[t * 264 + c] = (bf16)f2bf(q * 0.0625f * e); Ks[t * 264 + c] = (bf16)f2bf(k * ei); }
    if (half == 0) { ebs[c] = eb; if (!DRY || never) DEC[(size_t)u * 256 + c] = eb; }
    __syncthreads();
    for (int it = tid; it < 2048; it += 512) {
        const int fb = it >> 6, L = it & 63, tt = fb >> 3, kk = fb & 7, fl = L & 15, fq = L >> 4;
        const u32x4 v = *(const LAS u32x4*)(Qs + (tt * 16 + fl) * 264 + kk * 32 + fq * 8);
        if (!DRY || never) *(u32x4*)(Pb + (size_t)(r0 + 2 * fb + (L >> 5)) * LD + Q1 + h * 256 + (L & 31) * 8) = v;
    }
    for (int it = tid; it < 2048; it += 512) {
        const int fb = it >> 6, L = it & 63, kt = fb >> 1, kk = fb & 1, fl = L & 15, fq = L >> 4; const int k = kt * 16 + fl; const float ek = ebs[k];
        u32x4 o;
#pragma unroll
        for (int e2 = 0; e2 < 4; ++e2) { const int s_ = kk * 32 + fq * 8 + e2 * 2; o[e2] = pk2(bf2f(Ks[s_ * 264 + k]) * ek, bf2f(Ks[(s_ + 1) * 264 + k]) * ek); }
        if (!DRY || never) *(u32x4*)(Pb + (size_t)(r0 + 2 * fb + (L >> 5)) * LD + K1 + h * 256 + (L & 31) * 8) = o;
    }
#pragma unroll
    for (int tl = 0; tl < 2; ++tl) { const int tile = 2 * wv + tl, ti = tile >> 2, si = tile & 3; const int t = ti * 16 + l15;
        u32x2 w; w.x = 0u; w.y = 0u;
        if (si <= ti) { f32x4 acc = {0.f, 0.f, 0.f, 0.f};
#pragma unroll
            for (int kk = 0; kk < 8; ++kk) { const bf16x8 qf = *(const LAS bf16x8*)(Qs + t * 264 + kk * 32 + quad * 8); const bf16x8 kf = *(const LAS bf16x8*)(Ks + (si * 16 + l15) * 264 + kk * 32 + quad * 8); acc = mma16(kf, qf, acc); }
            float v[4];
#pragma unroll
            for (int e = 0; e < 4; ++e) { const int s = si * 16 + quad * 4 + e; v[e] = (s <= t) ? acc[e] : 0.f; }
            w.x = pk2(v[0], v[1]); w.y = pk2(v[2], v[3]); }
        if (!DRY || never) *(u32x2*)(SC + (size_t)u * 4096 + ((ti * 2 + (si >> 1)) * 64 + ((si & 1) * 2 + (quad >> 1)) * 16 + l15) * 8 + (quad & 1) * 4) = w; }
    __syncthreads();
}

#define RLX_AGENT __ATOMIC_RELAXED, __HIP_MEMORY_SCOPE_AGENT
#define XB_TMO      128
#define XB_XCNT(j)  (256  + 64 * (j))
#define XB_XSUB(j)  (1280 + 64 * (j))
#define XB_XGEN(j)  (2304 + 64 * (j))
#define XB_TOP      3328
#define XB_TOPGEN   3392
#define XCD_BAR_WORDS 3456
#define XB_SPIN_CAP (1u << 18)

__device__ __forceinline__ unsigned xb_ld(unsigned* p)              { return __hip_atomic_load(p, __ATOMIC_RELAXED, __HIP_MEMORY_SCOPE_AGENT); }
__device__ __forceinline__ unsigned xb_add(unsigned* p, unsigned v) { return __hip_atomic_fetch_add(p, v, __ATOMIC_RELAXED, __HIP_MEMORY_SCOPE_AGENT); }
__device__ __forceinline__ unsigned xb_xcc_id() { return (unsigned)__builtin_amdgcn_s_getreg((3 << 11) | 20) & 0xFu; }
#define XB_SPIN(cond, bar) do { unsigned _sp = 0; while (cond) { __builtin_amdgcn_s_sleep(1); \
    if ((++_sp & 255u) == 0u) { if (xb_ld(&(bar)[XB_TMO])) break; if (_sp > XB_SPIN_CAP) { atomicAdd(&(bar)[XB_TMO], 1u); break; } } } } while (0)

struct XcdBarrier {
    unsigned* bar; unsigned x;
    volatile LAS unsigned* st;
};

__device__ __forceinline__ XcdBarrier xcd_barrier_post(unsigned* bar, volatile LAS unsigned* st) {
    XcdBarrier b; b.bar = bar; b.x = xb_xcc_id(); b.st = st;
    if (threadIdx.x == 0) (void)xb_add(&bar[XB_XCNT(b.x)], 1u);
    return b;
}
__device__ __forceinline__ void xcd_barrier_complete(unsigned* bar, unsigned x, unsigned& nloc, unsigned& nx) {
    const unsigned G = gridDim.x * gridDim.y * gridDim.z;
    unsigned sum, cnt, mine, sp = 0u;
    for (;;) {
        sum = 0u; cnt = 0u; mine = 0u;
#pragma unroll
        for (unsigned j = 0; j < 16; ++j) { const unsigned c = xb_ld(&bar[XB_XCNT(j)]); sum += c; cnt += (c > 0u) ? 1u : 0u; mine = (j == x) ? c : mine; }
        if (sum == G) break;
        __builtin_amdgcn_s_sleep(1);
        if ((++sp & 255u) == 0u) { if (xb_ld(&bar[XB_TMO])) break; if (sp > XB_SPIN_CAP) { atomicAdd(&bar[XB_TMO], 1u); break; } }
    }
    nloc = mine > 0u ? mine : 1u; nx = cnt > 0u ? cnt : 1u;
}

__device__ __forceinline__ void xcd_barrier(const XcdBarrier& b) {
    asm volatile("s_waitcnt vmcnt(0)" ::: "memory");
    __syncthreads();
    if (threadIdx.x == 0) {
        unsigned* bar = b.bar;
        __builtin_amdgcn_s_waitcnt(0);
        unsigned nloc = b.st[0], nx = b.st[1];
        if (nloc == 0u) { xcd_barrier_complete(bar, b.x, nloc, nx); b.st[0] = nloc; b.st[1] = nx; }
        const unsigned old = xb_add(&bar[XB_XSUB(b.x)], 1u);
        const unsigned gen = old / nloc;
        if (old + 1u == (gen + 1u) * nloc) {
            __builtin_amdgcn_fence(__ATOMIC_RELEASE, "agent");
            asm volatile("s_waitcnt vmcnt(0)" ::: "memory");
            const unsigned og = xb_add(&bar[XB_TOP], 1u);
            const unsigned tg = og / nx;
            if (og + 1u == (tg + 1u) * nx) xb_add(&bar[XB_TOPGEN], 1u);
            else XB_SPIN(xb_ld(&bar[XB_TOPGEN]) == tg, bar);
            __builtin_amdgcn_fence(__ATOMIC_ACQUIRE, "agent");
            xb_add(&bar[XB_XGEN(b.x)], 1u);
            asm volatile("s_waitcnt vmcnt(0)" ::: "memory");
        } else {
            XB_SPIN(xb_ld(&bar[XB_XGEN(b.x)]) == gen, bar);
            __builtin_amdgcn_fence(__ATOMIC_ACQUIRE, "agent");
            asm volatile("s_waitcnt vmcnt(0)" ::: "memory");
        }
    }
    __syncthreads();
}

template <int NH>
__device__ __forceinline__ void build_hs_table(LAS float* tab, const float* SS, int pm, int tid) {
    for (int it = tid; it < 256 * NH; it += 512) { const int row = it / NH, h = it % NH;
        const f32x4* sp = (const f32x4*)(SS + ((size_t)(pm * 256 + row) * NH + h) * 32);
        float s = 0.f;
#pragma unroll
        for (int i = 0; i < 8; ++i) { const f32x4 v = sp[i]; s += (v.x + v.y) + (v.z + v.w); }
        tab[h * 256 + row] = rsqrtf(s * (1.f / 512.f) + 1e-6f); }
    __syncthreads();
    float f[NH / 2];
#pragma unroll
    for (int k = 0; k < NH / 2; ++k) { const int it = tid + 512 * k, j = it >> 8, row = it & 255; f[k] = (j < NH - 1) ? tab[j * 256 + row] / tab[(j + 1) * 256 + row] : tab[j * 256 + row]; }
    __syncthreads();
#pragma unroll
    for (int k = 0; k < NH / 2; ++k) tab[tid + 512 * k] = f[k];
    __syncthreads();
}

struct Args { const float* x; const int* pos; const float* ev_norm; const float* ev_w_in; const float* sgu_gain; const float* sgu_w_s; const float* sgu_b; const float* ev_w_out;
              const float* od_norm; const float* od_w_in; const float* gla_w_lr; const float* gla_b_lr; const float* od_w_out; const float* final_norm; float* out; unsigned char* ws; int never; int pad; };

__global__ void __launch_bounds__(512, 2) trunk_fwd(Args a) {
    extern __shared__ __attribute__((aligned(16))) unsigned char lds_raw[];
    LAS unsigned char* lds = (LAS unsigned char*)lds_raw;
    cg::grid_group grid = cg::this_grid();
    volatile LAS unsigned* xbst = (volatile LAS unsigned*)(lds + 131072 + 8 * 2304);
    if (threadIdx.x < 2) xbst[threadIdx.x] = 0u;
    __syncthreads();
    XcdBarrier xbar = xcd_barrier_post((unsigned*)a.ws, xbst);
    const int G = gridDim.x, bid = blockIdx.x, ngw = G * 8;
#define PH_BEGIN int t_ = threadIdx.x; asm volatile("" : "+v"(t_)); const int tid = t_, lane = tid & 63, wave = __builtin_amdgcn_readfirstlane(tid >> 6), gw = bid * 8 + wave; LAS float* scr = (LAS float*)(lds + wave * 16384); (void)lane; (void)gw; (void)scr;
    unsigned char* ws = a.ws;
    float* LR = (float*)(ws + WS_LR); bf16* WLRT = (bf16*)(ws + WS_WLRT); float* DEC = (float*)(ws + WS_DEC);
    bf16* WA = (bf16*)(ws + WS_WA); bf16* H = (bf16*)(ws + WS_H); bf16* Pb = (bf16*)(ws + WS_P);
    bf16* SC = (bf16*)(ws + WS_SC); float* SS = (float*)(ws + WS_SS); bf16* WO0 = (bf16*)(ws + WS_WO0);

    { PH_BEGIN
    for (int rep = 0; rep < 1 + ((PROBE >> 11) & 1); ++rep) {
    transpose_all<true>(a.ev_w_in, 12288, 2048, 12288, WA, scr, gw, ngw, lane);
    for (int m = gw; m < T; m += ngw) rms_row_bf16(a.x + (size_t)m * DM, a.ev_norm, H + (size_t)m * DM, lane);
    }
    }
    xcd_barrier(xbar);
    { PH_BEGIN
    if ((PROBE >> 15) & 1) { pg8::Gemm g{H, WA, T, 12288, 2048, 2048}; pg8::StaticOrder S; S.init(T, 12288, G, bid); pg8::EpiHot E{(bf16*)a.out};
      pg8::gemm_phase<pg8::EpiHot, pg8::StaticOrder, true, true>(lds, g, S, E); }
    for (int rep = 0; rep < 1 + ((PROBE >> 1) & 1); ++rep)
    { pg8::Gemm g{H, WA, T, 12288, 2048, 2048}; pg8::StaticOrder S; S.init(T, 12288, G, bid); pg8::EpiBf16W E{Pb, LD, lds + 131072};
      pg8::gemm_phase<pg8::EpiBf16W, pg8::StaticOrder, true, true>(lds, g, S, E); }
    }
    xcd_barrier(xbar);
    { PH_BEGIN
    if ((PROBE >> 2) & 1) for (int u = bid; u < 1024; u += G) retpre_unit<true>(lds, Pb, a.pos, SC, DEC, u, tid, a.never);
    for (int u = bid; u < 1024; u += G) retpre_unit<false>(lds, Pb, a.pos, SC, DEC, u, tid, a.never);
    }
    xcd_barrier(xbar);
    { PH_BEGIN
    for (int v = bid; v < 256; v += G) { const int xcd = v & 7, idx = v >> 3;
        if (idx < 16) { const int wk = xcd * 16 + idx;
            if ((PROBE >> 4) & 1) scan_worker<4, Q0, K0, V0, GR0, true>(lds, Pb, SC, DEC, SS, wk, tid, a.never);
            scan_worker<4, Q0, K0, V0, GR0, false>(lds, Pb, SC, DEC, SS, wk, tid, a.never);
        } else { const int hi = (idx - 16) * 8 + xcd;
            if ((PROBE >> 3) & 1) for (int u = hi; u < 1024; u += 128) sgu_unit<true>(lds, Pb, a.sgu_gain, a.sgu_w_s, a.sgu_b, u, tid, a.never);
            for (int u = hi; u < 1024; u += 128) sgu_unit<false>(lds, Pb, a.sgu_gain, a.sgu_w_s, a.sgu_b, u, tid, a.never);
            transpose_all<false>(a.ev_w_out, 2048, 4096, 2048, WO0, scr, hi * 8 + wave, 128 * 8, lane);
            transpose_all<false>(a.od_w_in, 12304, 2048, 12288, WA, scr, hi * 8 + wave, 128 * 8, lane);
        } }
    }
    grid.sync();
    if (G != 256) {
    { PH_BEGIN
    if ((PROBE >> 5) & 1) fin_phase<4, GR0, true>(Pb, SS, gw, ngw, lane, a.never);
    fin_phase<4, GR0, false>(Pb, SS, gw, ngw, lane, a.never);
    }
    xcd_barrier(xbar);
    }
    { PH_BEGIN
    { pg8::Gemm g{Pb + MIXC, WO0, T, 2048, 4096, LD}; pg8::StaticOrder S; S.init(T, 2048, G, bid); pg8::EpiBf16W E{(bf16*)a.out, 2 * DM, lds + 131072};
      if (G == 256) { pg8::Unit u0; S.next(0, u0); LAS float* tab = (LAS float*)(lds + HS_OFF); build_hs_table<4>(tab, SS, u0.pm, tid);
        pg8::gemm_phase<pg8::EpiBf16W, pg8::StaticOrder, true, true, 4>(lds, g, S, E, tab); }
      else pg8::gemm_phase<pg8::EpiBf16W, pg8::StaticOrder, true, true>(lds, g, S, E); }
    }
    xcd_barrier(xbar);
    { PH_BEGIN
    for (int m = gw; m < T; m += ngw) res_rms_row_bf16(a.x + (size_t)m * DM, (const bf16*)a.out + (size_t)m * 2 * DM, a.od_norm, H + (size_t)m * DM, lane);
    for (int i = bid * 512 + tid; i < 16 * 2048; i += G * 512) { const int r = i >> 11, k = i & 2047; WLRT[i] = (bf16)f2bf(a.od_w_in[(size_t)k * 12304 + 12288 + r]); }
    }
    xcd_barrier(xbar);
    { PH_BEGIN
    lr_phase(H, WLRT, LR, gw, ngw, lane);
    { pg8::Gemm g{H, WA, T, 12288, 2048, 2048}; pg8::StaticOrder S; S.init(T, 12288, G, bid); pg8::EpiBf16W E{Pb, LD, lds + 131072};
      pg8::gemm_phase<pg8::EpiBf16W, pg8::StaticOrder, true, true>(lds, g, S, E); }
    }
    xcd_barrier(xbar);
    { PH_BEGIN
    if ((PROBE >> 8) & 1) for (int u = bid; u < 2048; u += G) glapre_unit<true>(lds, Pb, LR, a.gla_w_lr, a.gla_b_lr, SC, DEC, u, tid, a.never);
    for (int u = bid; u < 2048; u += G) glapre_unit<false>(lds, Pb, LR, a.gla_w_lr, a.gla_b_lr, SC, DEC, u, tid, a.never);
    transpose_all<false>(a.od_w_out, 2048, 4096, 2048, WA, scr, gw, ngw, lane);
    }
    xcd_barrier(xbar);
    { PH_BEGIN
    for (int v = bid; v < 256; v += G) { const int xcd = v & 7, idx = v >> 3; const int wk = (xcd * 2 + (idx >> 4)) * 16 + (idx & 15);
        if ((PROBE >> 9) & 1) scan_worker<8, Q1, K1, V1, G1, true>(lds, Pb, SC, DEC, SS, wk, tid, a.never);
        scan_worker<8, Q1, K1, V1, G1, false>(lds, Pb, SC, DEC, SS, wk, tid, a.never); }
    }
    xcd_barrier(xbar);
    if (G != 256) {
    { PH_BEGIN
    if ((PROBE >> 10) & 1) fin_phase<8, G1, true>(Pb, SS, gw, ngw, lane, a.never);
    fin_phase<8, G1, false>(Pb, SS, gw, ngw, lane, a.never);
    }
    xcd_barrier(xbar);
    }
    { PH_BEGIN
    { pg8::Gemm g{Pb + MIXC, WA, T, 2048, 4096, LD}; pg8::StaticOrder S; S.init(T, 2048, G, bid); pg8::EpiBf16W E{Pb, LD, lds + 131072};
      if (G == 256) { pg8::Unit u0; S.next(0, u0); LAS float* tab = (LAS float*)(lds + HS_OFF); build_hs_table<8>(tab, SS, u0.pm, tid);
        pg8::gemm_phase<pg8::EpiBf16W, pg8::StaticOrder, true, true, 8>(lds, g, S, E, tab); }
      else pg8::gemm_phase<pg8::EpiBf16W, pg8::StaticOrder, true, true>(lds, g, S, E); }
    }
    xcd_barrier(xbar);
    if ((PROBE >> 12) & 1) { for (int rep = 0; rep < 12; ++rep) xcd_barrier(xbar); }
    { PH_BEGIN
    for (int m = gw; m < T; m += ngw) res_rms_row_f32(a.x + (size_t)m * DM, a.out + (size_t)m * DM, Pb + (size_t)m * LD, a.final_norm, lane);
    }
}

extern "C" void kernel_launch(void* const* d_in, const int* in_sizes, int n_in, void* d_out, int out_size, void* d_ws, size_t ws_size, hipStream_t stream) {
    static int grid = 0;
    if (grid == 0) {
        if (n_in != 14 || out_size != T * DM || ws_size < WS_END) { fprintf(stderr, "kernel_launch: unexpected shapes (n_in %d out %d ws %zu)\n", n_in, out_size, ws_size); grid = -1; return; }
        int dev = 0, cus = 0, per_cu = 0;
        (void)hipGetDevice(&dev);
        (void)hipDeviceGetAttribute(&cus, hipDeviceAttributeMultiprocessorCount, dev);
        (void)hipFuncSetAttribute((const void*)trunk_fwd, hipFuncAttributeMaxDynamicSharedMemorySize, LDS_BYTES);
        (void)hipOccupancyMaxActiveBlocksPerMultiprocessor(&per_cu, (const void*)trunk_fwd, 512, LDS_BYTES);
        if (per_cu < 1) per_cu = 1;
        grid = cus * per_cu;
    }
    if (grid < 0) return;
    (void)hipMemsetAsync(d_ws, 0, 16384, stream);
    Args a{};
    a.x = (const float*)d_in[0]; a.pos = (const int*)d_in[1]; a.ev_norm = (const float*)d_in[2]; a.ev_w_in = (const float*)d_in[3]; a.sgu_gain = (const float*)d_in[4];
    a.sgu_w_s = (const float*)d_in[5]; a.sgu_b = (const float*)d_in[6]; a.ev_w_out = (const float*)d_in[7]; a.od_norm = (const float*)d_in[8]; a.od_w_in = (const float*)d_in[9];
    a.gla_w_lr = (const float*)d_in[10]; a.gla_b_lr = (const float*)d_in[11]; a.od_w_out = (const float*)d_in[12]; a.final_norm = (const float*)d_in[13];
    a.out = (float*)d_out; a.ws = (unsigned char*)d_ws;
    void* args[] = {&a};
    hipError_t e = hipLaunchCooperativeKernel((void*)trunk_fwd, dim3(grid), dim3(512), args, LDS_BYTES, stream);
    if (e != hipSuccess) fprintf(stderr, "kernel_launch: cooperative launch failed: %s (grid %d)\n", hipGetErrorString(e), grid);
}
```

```cpp
#include <hip/hip_runtime.h>
#include <hip/hip_cooperative_groups.h>
#include <cstdio>
#include <cstdint>
namespace cg = cooperative_groups;

namespace pg8 {
#define PG8_LAS __attribute__((address_space(3)))
typedef unsigned short bf16_t;
typedef short bf16x8 __attribute__((ext_vector_type(8)));
typedef float f32x4 __attribute__((ext_vector_type(4)));
typedef unsigned u32x4 __attribute__((ext_vector_type(4)));
constexpr int BM = 256, BK = 64, HALF = 128, HTB = HALF * BK * 2, STAGE_BYTES = 8 * HTB, NXCD = 8, WGM = 8;
__host__ __device__ __forceinline__ int lds_byte(int r, int c) { const int st = (r >> 4) * 2 + (c >> 5), rr = r & 15, cc = c & 31, ob = rr * 64 + cc * 2; return st * 1024 + (ob ^ (((ob >> 9) & 1) << 5)); }
__host__ __device__ __forceinline__ void stage_rc(int b, int& R, int& C) { const int st = b / 1024, sb = b % 1024, swz = sb ^ (((sb >> 9) & 1) << 5); R = (st >> 1) * 16 + swz / 64; C = (st & 1) * 32 + (swz % 64) / 2; }
__host__ __device__ __forceinline__ int perm32(int rho) { const int n = rho >> 4, i = rho & 15; return 8 * (i >> 2) + 4 * n + (i & 3); }
struct Unit { int pm, pn; };
struct Gemm { const bf16_t* A; const bf16_t* Bt; int M, N, K, lda; };
struct StaticOrder {
    int nM, nN, nwg, G, c;
    __host__ __device__ void init(int M, int N, int G_, int c_) { nM = M / BM; nN = N / BM; nwg = nM * nN; G = G_; c = c_; }
    __host__ __device__ bool next(int i, Unit& u) const {
        const long L = (long)i * G + c; if (L >= nwg) return false;
        int wgid = (int)L; { const int q = nwg / NXCD, r = nwg % NXCD, xcd = wgid % NXCD, off = wgid / NXCD; wgid = (xcd < r ? xcd * (q + 1) : r * (q + 1) + (xcd - r) * q) + off; }
        const int nig = WGM * nN, gid = wgid / nig, fm = gid * WGM, gsz = (nM - fm) < WGM ? (nM - fm) : WGM;
        u.pm = fm + ((wgid % nig) % gsz); u.pn = (wgid % nig) / gsz; return true;
    }
    __device__ __forceinline__ void a_ready(const Unit&) const {}
    __device__ __forceinline__ void done(const Unit&) const {}
};
typedef float f32x2c __attribute__((ext_vector_type(2)));
typedef __bf16 bf16x2c __attribute__((ext_vector_type(2)));
__device__ __forceinline__ unsigned cvt_pk_bf16(float lo, float hi) { const f32x2c v = {lo, hi}; const bf16x2c b = __builtin_convertvector(v, bf16x2c); return __builtin_bit_cast(unsigned, b); }
struct EpiBf16P {
    static constexpr bool PERM = true, WIDE = false, AFTER_DRAIN = false;
    bf16_t* O; int ldc;
    __device__ __forceinline__ void operator()(const f32x4 (&acc)[2][2][4][2], const Unit& u, int wr, int wc, int fr, int fq) const {
        const int row0 = u.pm * BM + wr * 64 + fr, col0 = u.pn * BM + wc * 32 + 8 * fq;
#pragma unroll
        for (int ai = 0; ai < 2; ++ai)
#pragma unroll
            for (int m = 0; m < 4; ++m) { bf16_t* rowp = O + (size_t)(row0 + ai * HALF + m * 16) * ldc + col0;
#pragma unroll
                for (int bj = 0; bj < 2; ++bj) { const f32x4 v0 = acc[ai][bj][m][0], v1 = acc[ai][bj][m][1];
                    u32x4 w; w.x = cvt_pk_bf16(v0[0], v0[1]); w.y = cvt_pk_bf16(v0[2], v0[3]); w.z = cvt_pk_bf16(v1[0], v1[1]); w.w = cvt_pk_bf16(v1[2], v1[3]);
                    *(u32x4*)(rowp + bj * HALF) = w; } }
    }
};
struct EpiNull {
    static constexpr bool PERM = false, WIDE = false, AFTER_DRAIN = false;
    float* out; int never;
    __device__ __forceinline__ void operator()(const f32x4 (&acc)[2][2][4][2], const Unit& u, int wr, int wc, int fr, int fq) const {
        f32x4 s = {0.f, 0.f, 0.f, 0.f};
#pragma unroll
        for (int ai = 0; ai < 2; ++ai)
#pragma unroll
            for (int bj = 0; bj < 2; ++bj)
#pragma unroll
                for (int m = 0; m < 4; ++m)
#pragma unroll
                    for (int n = 0; n < 2; ++n) s += acc[ai][bj][m][n];
        if (never) *(f32x4*)(out + (size_t)(u.pm * BM + wr * 64 + fr) * 2048 + u.pn * BM + wc * 32 + 4 * fq) = s;
    }
};
struct EpiBf16W {
    static constexpr bool PERM = true, WIDE = true, AFTER_DRAIN = false;
    bf16_t* O; int ldc; PG8_LAS unsigned char* stg;
    __device__ __forceinline__ void operator()(const f32x4 (&acc)[2][2][4][2], const Unit& u, int wr, int wc, int fr, int fq) const {
        PG8_LAS unsigned char* my = stg + (wr * 4 + wc) * 2304;
        const int lane = fq * 16 + fr, rrow = lane >> 3, rc8 = lane & 7;
        bf16_t* obase = O + (size_t)(u.pm * BM + wr * 64 + rrow) * ldc + u.pn * BM + wc * 64 + rc8 * 8;
#pragma unroll
        for (int ai = 0; ai < 2; ++ai)
#pragma unroll
            for (int m = 0; m < 4; ++m) {
                u32x4 w0, w1;
                w0.x = cvt_pk_bf16(acc[ai][0][m][0][0], acc[ai][0][m][0][1]); w0.y = cvt_pk_bf16(acc[ai][0][m][0][2], acc[ai][0][m][0][3]);
                w0.z = cvt_pk_bf16(acc[ai][0][m][1][0], acc[ai][0][m][1][1]); w0.w = cvt_pk_bf16(acc[ai][0][m][1][2], acc[ai][0][m][1][3]);
                w1.x = cvt_pk_bf16(acc[ai][1][m][0][0], acc[ai][1][m][0][1]); w1.y = cvt_pk_bf16(acc[ai][1][m][0][2], acc[ai][1][m][0][3]);
                w1.z = cvt_pk_bf16(acc[ai][1][m][1][0], acc[ai][1][m][1][1]); w1.w = cvt_pk_bf16(acc[ai][1][m][1][2], acc[ai][1][m][1][3]);
                *(PG8_LAS u32x4*)(my + fr * 144 + fq * 32) = w0; *(PG8_LAS u32x4*)(my + fr * 144 + fq * 32 + 16) = w1;
                asm volatile("s_waitcnt lgkmcnt(0)" ::: "memory");
                const u32x4 r0 = *(const PG8_LAS u32x4*)(my + rrow * 144 + rc8 * 16), r1 = *(const PG8_LAS u32x4*)(my + (8 + rrow) * 144 + rc8 * 16);
                asm volatile("s_waitcnt lgkmcnt(0)" ::: "memory");
                bf16_t* op = obase + (size_t)(ai * HALF + m * 16) * ldc;
                __builtin_nontemporal_store(r0, (u32x4*)op); __builtin_nontemporal_store(r1, (u32x4*)(op + (size_t)8 * ldc));
            }
    }
};
struct EpiHot {
    static constexpr bool PERM = true, WIDE = false, AFTER_DRAIN = false;
    bf16_t* O;
    __device__ __forceinline__ void operator()(const f32x4 (&acc)[2][2][4][2], const Unit& u, int wr, int wc, int fr, int fq) const {
        const int row0 = wr * 64 + fr, col0 = wc * 32 + 8 * fq;
#pragma unroll
        for (int ai = 0; ai < 2; ++ai)
#pragma unroll
            for (int m = 0; m < 4; ++m) { bf16_t* rowp = O + (size_t)blockIdx.x * 65536 + (size_t)(row0 + ai * HALF + m * 16) * 256 + col0;
#pragma unroll
                for (int bj = 0; bj < 2; ++bj) { const f32x4 v0 = acc[ai][bj][m][0], v1 = acc[ai][bj][m][1];
                    u32x4 w; w.x = cvt_pk_bf16(v0[0], v0[1]); w.y = cvt_pk_bf16(v0[2], v0[3]); w.z = cvt_pk_bf16(v1[0], v1[1]); w.w = cvt_pk_bf16(v1[2], v1[3]);
                    *(u32x4*)(rowp + bj * HALF) = w; } }
    }
};
struct EpiF32P {
    static constexpr bool PERM = true, WIDE = false, AFTER_DRAIN = false;
    float* out; int ldc;
    __device__ __forceinline__ void operator()(const f32x4 (&acc)[2][2][4][2], const Unit& u, int wr, int wc, int fr, int fq) const {
        const int row0 = u.pm * BM + wr * 64 + fr, col0 = u.pn * BM + wc * 32 + 8 * fq;
#pragma unroll
        for (int ai = 0; ai < 2; ++ai)
#pragma unroll
            for (int m = 0; m < 4; ++m) { float* rowp = out + (size_t)(row0 + ai * HALF + m * 16) * ldc + col0;
#pragma unroll
                for (int bj = 0; bj < 2; ++bj) { *(f32x4*)(rowp + bj * HALF) = acc[ai][bj][m][0]; *(f32x4*)(rowp + bj * HALF + 4) = acc[ai][bj][m][1]; } }
    }
};
template <class Epi, class Sched, bool ALIGN_EPI = false, bool SP2 = false, int NHS = 0>
__device__ __forceinline__ void gemm_phase(PG8_LAS unsigned char* lds, const Gemm g, const Sched& S, const Epi& E, const PG8_LAS float* hs = nullptr) {
    int tid_ = threadIdx.x; asm volatile("" : "+v"(tid_));
    const int tid = tid_, wid = __builtin_amdgcn_readfirstlane(tid >> 6), lane = tid & 63, wr = wid >> 2, wc = wid & 3, fr = lane & 15, fq = lane >> 4;
    const int K = g.K, nt = K / BK;
    unsigned voffA[2], voffB[2];
#pragma unroll
    for (int i = 0; i < 2; ++i) { int R, C; stage_rc(tid * 16 + i * 8192, R, C); const int Rb = Epi::WIDE ? (64 * (R >> 5) + 16 * ((R & 15) >> 2) + 4 * ((R >> 4) & 1) + (R & 3)) : (Epi::PERM ? ((R & ~31) + perm32(R & 31)) : R);
        voffA[i] = (unsigned)(R * g.lda + C) * 2u; voffB[i] = (unsigned)(Rb * K + C) * 2u; }
    const size_t kstep = (size_t)(BK * 2);
    const size_t hstepA = (size_t)HALF * g.lda * 2, hstepB = Epi::WIDE ? (size_t)8 * K * 2 : (size_t)HALF * K * 2;
    const size_t tstepA = 2 * hstepA, tstepB = (size_t)BM * K * 2;
    const unsigned ldsw = (unsigned)wid * 1024u;
    const int aoff = lds_byte(wr * 64 + fr, fq * 8), boff = lds_byte(wc * 32 + fr, fq * 8);
#define PG8_SA(b, h) (((b) * 2 + (h)) * HTB)
#define PG8_SB(b, h) ((4 + (b) * 2 + (h)) * HTB)
#define PG8_STAGE(bufoff, gbase, voff) do { _Pragma("unroll") for (int _i = 0; _i < 2; ++_i) \
        __builtin_amdgcn_global_load_lds((const unsigned*)((const char*)(gbase) + (voff)[_i]), (PG8_LAS unsigned*)(lds + (bufoff) + ldsw + _i * 8192), 16, 0, 0); } while (0)
#define PG8_LDA(dst, b, h) do { _Pragma("unroll") for (int m = 0; m < 4; ++m) _Pragma("unroll") for (int k = 0; k < 2; ++k) dst[m][k] = *(const PG8_LAS bf16x8*)(lds + PG8_SA(b, h) + aoff + m * 2048 + k * 1024); } while (0)
#define PG8_LDB(dst, b, h) do { _Pragma("unroll") for (int n = 0; n < 2; ++n) _Pragma("unroll") for (int k = 0; k < 2; ++k) dst[n][k] = *(const PG8_LAS bf16x8*)(lds + PG8_SB(b, h) + boff + n * 2048 + k * 1024); } while (0)
#define PG8_MMA(ai, bj, At, Bt) do { __builtin_amdgcn_s_setprio(1); _Pragma("unroll") for (int m = 0; m < 4; ++m) _Pragma("unroll") for (int n = 0; n < 2; ++n) _Pragma("unroll") for (int k = 0; k < 2; ++k) \
        acc[ai][bj][m][n] = __builtin_amdgcn_mfma_f32_16x16x32_bf16(Bt[n][k], At[m][k], acc[ai][bj][m][n], 0, 0, 0); __builtin_amdgcn_s_setprio(0); } while (0)
#define PG8_WAIT_V(n) asm volatile("s_waitcnt vmcnt(" #n ")" ::: "memory")
#define PG8_WAIT_L(n) asm volatile("s_waitcnt lgkmcnt(" #n ")" ::: "memory")
#define PG8_BAR __builtin_amdgcn_s_barrier()
#define PG8_SCHED __builtin_amdgcn_sched_barrier(0)
    Unit cur, nxt; int ui = 0;
    if (!S.next(0, cur)) return;
    f32x4 acc[2][2][4][2];
#pragma unroll
    for (int a = 0; a < 2; ++a)
#pragma unroll
        for (int b = 0; b < 2; ++b)
#pragma unroll
            for (int m = 0; m < 4; ++m)
#pragma unroll
                for (int n = 0; n < 2; ++n) acc[a][b][m][n] = (f32x4){0.f, 0.f, 0.f, 0.f};
    bf16x8 At[4][2], B0[2][2], B1[2][2];
    const char* cA = (const char*)g.A + (size_t)cur.pm * tstepA; const char* cB = (const char*)g.Bt + (size_t)cur.pn * tstepB;
    S.a_ready(cur);
    if constexpr (SP2) {
        PG8_STAGE(PG8_SB(0, 0), cB, voffB); PG8_STAGE(PG8_SB(0, 1), cB + hstepB, voffB); PG8_STAGE(PG8_SA(0, 0), cA, voffA); PG8_STAGE(PG8_SA(0, 1), cA + hstepA, voffA);
        if (wr == 1) PG8_BAR;
        PG8_WAIT_V(2); PG8_BAR;
        PG8_STAGE(PG8_SB(1, 0), cB + kstep, voffB); PG8_STAGE(PG8_SA(1, 0), cA + kstep, voffA); PG8_STAGE(PG8_SB(1, 1), cB + hstepB + kstep, voffB);
        PG8_WAIT_V(6); PG8_BAR;
    } else {
        PG8_STAGE(PG8_SB(0, 0), cB, voffB); PG8_STAGE(PG8_SA(0, 0), cA, voffA); PG8_STAGE(PG8_SB(0, 1), cB + hstepB, voffB); PG8_STAGE(PG8_SA(0, 1), cA + hstepA, voffA);
        if (wr == 1) PG8_BAR;
        PG8_WAIT_V(4); PG8_BAR;
        PG8_STAGE(PG8_SB(1, 0), cB + kstep, voffB); PG8_STAGE(PG8_SA(1, 0), cA + kstep, voffA); PG8_STAGE(PG8_SB(1, 1), cB + hstepB + kstep, voffB);
        PG8_WAIT_V(6); PG8_BAR;
    }
    for (;;) {
        const bool has_next = S.next(ui + 1, nxt);
        const char* nA = has_next ? (const char*)g.A + (size_t)nxt.pm * tstepA : cA; const char* nB = has_next ? (const char*)g.Bt + (size_t)nxt.pn * tstepB : cB;
        for (int t = 0; t < nt; t += 2) {
            const bool last = (t == nt - 2);
            const char* a1 = cA + (size_t)(t + 1) * kstep;
            const char* a2 = last ? nA : cA + (size_t)(t + 2) * kstep; const char* b2 = last ? nB : cB + (size_t)(t + 2) * kstep;
            const char* a3 = a2 + kstep; const char* b3 = b2 + kstep;
            if (last && has_next) S.a_ready(nxt);
            if constexpr (SP2) {
            PG8_LDB(B0, 0, 0); PG8_LDB(B1, 0, 1); PG8_SCHED; PG8_LDA(At, 0, 0); PG8_STAGE(PG8_SA(1, 1), a1 + hstepA, voffA);
            PG8_WAIT_V(8); PG8_WAIT_L(0); PG8_BAR; PG8_MMA(0, 0, At, B0); PG8_MMA(0, 1, At, B1); PG8_BAR; PG8_SCHED;
            PG8_LDA(At, 0, 1); PG8_STAGE(PG8_SB(0, 0), b2, voffB); PG8_STAGE(PG8_SB(0, 1), b2 + hstepB, voffB); PG8_STAGE(PG8_SA(0, 0), a2, voffA);
            PG8_WAIT_V(8); PG8_WAIT_L(0); PG8_BAR; PG8_MMA(1, 0, At, B0); PG8_MMA(1, 1, At, B1); PG8_BAR; PG8_SCHED;
            PG8_LDB(B0, 1, 0); PG8_LDB(B1, 1, 1); PG8_SCHED; PG8_LDA(At, 1, 0); PG8_STAGE(PG8_SA(0, 1), a2 + hstepA, voffA);
            PG8_WAIT_V(8); PG8_WAIT_L(0); PG8_BAR; PG8_MMA(0, 0, At, B0); PG8_MMA(0, 1, At, B1); PG8_BAR; PG8_SCHED;
            PG8_LDA(At, 1, 1); PG8_STAGE(PG8_SB(1, 0), b3, voffB); PG8_STAGE(PG8_SB(1, 1), b3 + hstepB, voffB); PG8_STAGE(PG8_SA(1, 0), a3, voffA);
            PG8_WAIT_V(8); PG8_WAIT_L(0); PG8_BAR; PG8_MMA(1, 0, At, B0); PG8_MMA(1, 1, At, B1); PG8_BAR; PG8_SCHED;
            if constexpr (NHS > 0) {
                if (((t + 2) & 7) == 0 && ((t + 2) >> 3) <= NHS) { const PG8_LAS float* tp = hs + (((t + 2) >> 3) - 1) * 256 + wr * 64 + fr;
#pragma unroll
                    for (int ai = 0; ai < 2; ++ai)
#pragma unroll
                        for (int m = 0; m < 4; ++m) { const float f = tp[ai * HALF + m * 16];
#pragma unroll
                            for (int bj = 0; bj < 2; ++bj)
#pragma unroll
                                for (int n = 0; n < 2; ++n) acc[ai][bj][m][n] *= f; }
                    PG8_SCHED; }
            }
            } else {
            PG8_LDB(B0, 0, 0); PG8_SCHED; PG8_LDA(At, 0, 0); PG8_STAGE(PG8_SA(1, 1), a1 + hstepA, voffA);
            PG8_WAIT_L(8); PG8_BAR; PG8_WAIT_L(0); PG8_MMA(0, 0, At, B0); PG8_BAR; PG8_SCHED;
            PG8_LDB(B1, 0, 1); PG8_STAGE(PG8_SB(0, 0), b2, voffB);
            PG8_BAR; PG8_WAIT_L(0); PG8_MMA(0, 1, At, B1); PG8_BAR;
            PG8_LDA(At, 0, 1); PG8_STAGE(PG8_SA(0, 0), a2, voffA);
            PG8_BAR; PG8_WAIT_L(0); PG8_MMA(1, 0, At, B0); PG8_BAR; PG8_SCHED;
            PG8_STAGE(PG8_SB(0, 1), b2 + hstepB, voffB);
            PG8_WAIT_V(6); PG8_BAR; PG8_MMA(1, 1, At, B1); PG8_BAR;
            PG8_LDB(B0, 1, 0); PG8_SCHED; PG8_LDA(At, 1, 0); PG8_STAGE(PG8_SA(0, 1), a2 + hstepA, voffA);
            PG8_WAIT_L(8); PG8_BAR; PG8_WAIT_L(0); PG8_MMA(0, 0, At, B0); PG8_BAR; PG8_SCHED;
            PG8_LDB(B1, 1, 1); PG8_STAGE(PG8_SB(1, 0), b3, voffB);
            PG8_BAR; PG8_WAIT_L(0); PG8_MMA(0, 1, At, B1); PG8_BAR;
            PG8_LDA(At, 1, 1); PG8_STAGE(PG8_SA(1, 0), a3, voffA);
            PG8_BAR; PG8_WAIT_L(0); PG8_MMA(1, 0, At, B0); PG8_BAR; PG8_SCHED;
            PG8_STAGE(PG8_SB(1, 1), b3 + hstepB, voffB);
            PG8_WAIT_V(6); PG8_BAR; PG8_MMA(1, 1, At, B1); PG8_BAR;
            }
        }
        if constexpr (ALIGN_EPI) { if (wr == 0) PG8_BAR; }
        if constexpr (!Epi::AFTER_DRAIN) { E(acc, cur, wr, wc, fr, fq); S.done(cur); }
        if (!has_next) break;
#pragma unroll
        for (int a = 0; a < 2; ++a)
#pragma unroll
            for (int b = 0; b < 2; ++b)
#pragma unroll
                for (int m = 0; m < 4; ++m)
#pragma unroll
                    for (int n = 0; n < 2; ++n) acc[a][b][m][n] = (f32x4){0.f, 0.f, 0.f, 0.f};
        cur = nxt; cA = nA; cB = nB; ++ui;
        if constexpr (ALIGN_EPI) { if (wr == 1) PG8_BAR; }
    }
    PG8_WAIT_V(0);
    if constexpr (!ALIGN_EPI) { if (wr == 0) PG8_BAR; }
    PG8_BAR;
    if constexpr (Epi::AFTER_DRAIN) { E.fused(acc, cur, wr, wc, fr, fq, lds, wid, lane); S.done(cur); }
#undef PG8_SA
#undef PG8_SB
#undef PG8_STAGE
#undef PG8_LDA
#undef PG8_LDB
#undef PG8_MMA
#undef PG8_WAIT_V
#undef PG8_WAIT_L
#undef PG8_BAR
#undef PG8_SCHED
}
}

constexpr int T = 16384, SEQ = 8192, DM = 2048, LD = 12288 + 64;
constexpr int Q0 = 0, K0 = 1024, V0 = 2048, U0 = 4096, VS0 = 6144, GR0 = 8192, GS0 = 10240;
constexpr int Q1 = 0, K1 = 2048, V1 = 4096, G1 = 8192;
constexpr int MIXC = 8192;
constexpr size_t MiB = 1u << 20;
constexpr size_t WS_LR = 1 * MiB, WS_WLRT = 2 * MiB, WS_DEC = 3 * MiB, WS_WA = 8 * MiB, WS_H = 56 * MiB, WS_P = 120 * MiB, WS_END = 512 * MiB;
static_assert(WS_P + (size_t)T * LD * 2 <= WS_END, "d_ws map");
constexpr size_t WS_SC = WS_H, WS_SS = WS_H + 16 * MiB, WS_WO0 = WS_H + 32 * MiB;
constexpr int HS_OFF = 131072 + 8 * 2304 + 256;
constexpr int LDS_BYTES = HS_OFF + 8192;
#ifndef PROBE
#define PROBE 0
#endif

#define LAS __attribute__((address_space(3)))
typedef unsigned short bf16;
typedef short bf16x8 __attribute__((ext_vector_type(8)));
typedef float f32x4 __attribute__((ext_vector_type(4)));
typedef unsigned u32x4 __attribute__((ext_vector_type(4)));
typedef unsigned u32x2 __attribute__((ext_vector_type(2)));
#define LDS_WAIT() asm volatile("s_waitcnt lgkmcnt(0)" ::: "memory")
typedef float f32x2_t __attribute__((ext_vector_type(2)));
typedef __bf16 bf16x2_t __attribute__((ext_vector_type(2)));
__device__ __forceinline__ unsigned pk2(float lo, float hi) { const f32x2_t v = {lo, hi}; const bf16x2_t b = __builtin_convertvector(v, bf16x2_t); return __builtin_bit_cast(unsigned, b); }
__device__ __forceinline__ unsigned f2bf(float f) { return pk2(f, 0.f) & 0xffffu; }
__device__ __forceinline__ float bflo(unsigned w) { return __builtin_bit_cast(float, w << 16); }
__device__ __forceinline__ float bfhi(unsigned w) { return __builtin_bit_cast(float, w & 0xffff0000u); }
__device__ __forceinline__ float bf2f(bf16 b) { return __builtin_bit_cast(float, ((unsigned)b) << 16); }
__device__ __forceinline__ f32x4 mma16(bf16x8 a, bf16x8 b, f32x4 c) { return __builtin_amdgcn_mfma_f32_16x16x32_bf16(a, b, c, 0, 0, 0); }
__device__ __forceinline__ float wave_sum(float v) {
#pragma unroll
    for (int o = 1; o < 64; o <<= 1) v += __shfl_xor(v, o);
    return v;
}
__device__ __forceinline__ float silu(float g) { return g / (1.f + __expf(-g)); }

__device__ __forceinline__ void transpose_item(const float* W, int ldw, int K, bf16* WT, int k0, int n0, int drow0, LAS float* scr, int lane) {
#pragma unroll 8
    for (int i = 0; i < 32; ++i) { const int kk = 2 * i + (lane >> 5); scr[kk * 33 + (lane & 31)] = __builtin_nontemporal_load(W + (size_t)(k0 + kk) * ldw + n0 + (lane & 31)); }
    LDS_WAIT(); asm volatile("" ::: "memory");
    const int c = lane & 7;
#pragma unroll
    for (int j = 0; j < 4; ++j) { const int n = (lane >> 3) + 8 * j; const LAS float* s = scr + (8 * c) * 33 + n;
        u32x4 o; o.x = pk2(s[0 * 33], s[1 * 33]); o.y = pk2(s[2 * 33], s[3 * 33]); o.z = pk2(s[4 * 33], s[5 * 33]); o.w = pk2(s[6 * 33], s[7 * 33]);
        *(u32x4*)(WT + (size_t)(drow0 + n) * K + k0 + 8 * c) = o; }
    LDS_WAIT(); asm volatile("" ::: "memory");
}
__device__ __forceinline__ int perm0(int n) { return n < 4096 ? n : (n < 6144 ? n + 4096 : (n < 10240 ? n - 2048 : n)); }
template <bool PERM> __device__ __forceinline__ void transpose_all(const float* W, int ldw, int K, int N, bf16* WT, LAS float* scr, int gw, int ngw, int lane) {
    const int nblk = N / 32, nitems = (K / 64) * nblk;
    for (int it = gw; it < nitems; it += ngw) { const int kb = it / nblk, nb = it % nblk; const int n0 = nb * 32;
        transpose_item(W, ldw, K, WT, kb * 64, n0, PERM ? perm0(n0) : n0, scr, lane); }
}
__device__ __forceinline__ void rms_row_bf16(const float* xrow, const float* g, bf16* orow, int lane) {
    f32x4 v[8]; float s = 0.f;
#pragma unroll
    for (int j = 0; j < 8; ++j) { v[j] = __builtin_nontemporal_load((const f32x4*)xrow + 64 * j + lane); s += (v[j].x * v[j].x + v[j].y * v[j].y) + (v[j].z * v[j].z + v[j].w * v[j].w); }
    const float r = rsqrtf(wave_sum(s) * (1.f / DM) + 1e-6f);
#pragma unroll
    for (int j = 0; j < 8; ++j) { const f32x4 gg = ((const f32x4*)g)[64 * j + lane]; const f32x4 o = v[j] * r * gg;
        u32x2 w; w.x = pk2(o.x, o.y); w.y = pk2(o.z, o.w); ((u32x2*)orow)[64 * j + lane] = w; }
}
__device__ __forceinline__ void res_rms_row_bf16(const float* xrow, const bf16* acc, const float* g, bf16* orow, int lane) {
    f32x4 v[8]; float s = 0.f;
#pragma unroll
    for (int j = 0; j < 8; ++j) { const u32x2 a = ((const u32x2*)acc)[64 * j + lane]; v[j] = __builtin_nontemporal_load((const f32x4*)xrow + 64 * j + lane) + (f32x4){bflo(a.x), bfhi(a.x), bflo(a.y), bfhi(a.y)};
        s += (v[j].x * v[j].x + v[j].y * v[j].y) + (v[j].z * v[j].z + v[j].w * v[j].w); }
    const float r = rsqrtf(wave_sum(s) * (1.f / DM) + 1e-6f);
#pragma unroll
    for (int j = 0; j < 8; ++j) { const f32x4 gg = ((const f32x4*)g)[64 * j + lane]; const f32x4 o = v[j] * r * gg;
        u32x2 w; w.x = pk2(o.x, o.y); w.y = pk2(o.z, o.w); ((u32x2*)orow)[64 * j + lane] = w; }
}
__device__ __forceinline__ void res_rms_row_f32(const float* xrow, float* io, const bf16* acc2, const float* g, int lane) {
    f32x4 v[8]; float s = 0.f;
#pragma unroll
    for (int j = 0; j < 8; ++j) { const u32x2 a1 = __builtin_nontemporal_load((const u32x2*)io + 64 * j + lane), a2 = __builtin_nontemporal_load((const u32x2*)acc2 + 64 * j + lane);
        v[j] = (__builtin_nontemporal_load((const f32x4*)xrow + 64 * j + lane) + (f32x4){bflo(a1.x), bfhi(a1.x), bflo(a1.y), bfhi(a1.y)}) + (f32x4){bflo(a2.x), bfhi(a2.x), bflo(a2.y), bfhi(a2.y)};
        s += (v[j].x * v[j].x + v[j].y * v[j].y) + (v[j].z * v[j].z + v[j].w * v[j].w); }
    const float r = rsqrtf(wave_sum(s) * (1.f / DM) + 1e-6f);
#pragma unroll
    for (int j = 0; j < 8; ++j) { const f32x4 gg = ((const f32x4*)g)[64 * j + lane]; __builtin_nontemporal_store(v[j] * r * gg, (f32x4*)io + 64 * j + lane); }
}

template <bool DRY> __device__ __forceinline__ void retpre_unit(LAS unsigned char* lds, bf16* Pb, const int* pos, bf16* SC, float* DEC, int u, int tid, int never) {
    const int h = u & 3, n = (u >> 2) & 127, b = u >> 9;
    const int r0 = b * SEQ + n * 64;
    LAS bf16* Qs = (LAS bf16*)lds; LAS bf16* Ks = Qs + 64 * 264;
    const float lg2 = __log2f(1.f - exp2f(-5.f - (float)h));
    const int wv = tid >> 6, lane = tid & 63, l15 = lane & 15, quad = lane >> 4;
    for (int it = tid; it < 1024; it += 512) {
        const int t = it >> 4, j8 = it & 15;
        const float p = (float)pos[r0 + t];
        const bf16* qr = Pb + (size_t)(r0 + t) * LD + Q0 + h * 256 + j8 * 8;
        const bf16* kr = Pb + (size_t)(r0 + t) * LD + K0 + h * 256 + j8 * 8;
        const u32x4 q1 = *(const u32x4*)qr, q2 = *(const u32x4*)(qr + 128), k1 = *(const u32x4*)kr, k2 = *(const u32x4*)(kr + 128);
        u32x4 oq1, oq2, ok1, ok2;
#pragma unroll
        for (int e2 = 0; e2 < 4; ++e2) {
            float cs[2], sn[2];
#pragma unroll
            for (int z = 0; z < 2; ++z) { const float j = (float)(j8 * 8 + e2 * 2 + z);
                const float cj = exp2f(j * -0.10381025296523008f) * 0.15915494309189535f;
                const float hi = p * cj, lo = fmaf(p, cj, -hi); const float fr = (hi - floorf(hi)) + lo;
                sn[z] = __builtin_amdgcn_sinf(fr); cs[z] = __builtin_amdgcn_cosf(fr); }
            const float a0 = bflo(q1[e2]), a1 = bfhi(q1[e2]), b0 = bflo(q2[e2]), b1 = bfhi(q2[e2]);
            oq1[e2] = pk2((a0 * cs[0] - b0 * sn[0]) * 0.0625f, (a1 * cs[1] - b1 * sn[1]) * 0.0625f);
            oq2[e2] = pk2((a0 * sn[0] + b0 * cs[0]) * 0.0625f, (a1 * sn[1] + b1 * cs[1]) * 0.0625f);
            const float c0 = bflo(k1[e2]), c1 = bfhi(k1[e2]), d0 = bflo(k2[e2]), d1 = bfhi(k2[e2]);
            ok1[e2] = pk2(c0 * cs[0] - d0 * sn[0], c1 * cs[1] - d1 * sn[1]);
            ok2[e2] = pk2(c0 * sn[0] + d0 * cs[0], c1 * sn[1] + d1 * cs[1]);
        }
        *(LAS u32x4*)(Qs + t * 264 + j8 * 8) = oq1; *(LAS u32x4*)(Qs + t * 264 + 128 + j8 * 8) = oq2;
        *(LAS u32x4*)(Ks + t * 264 + j8 * 8) = ok1; *(LAS u32x4*)(Ks + t * 264 + 128 + j8 * 8) = ok2;
    }
    __syncthreads();
#pragma unroll
    for (int tl = 0; tl < 2; ++tl) { const int tile = 2 * wv + tl, ti = tile >> 2, si = tile & 3; const int t = ti * 16 + l15;
        u32x2 w; w.x = 0u; w.y = 0u;
        if (si <= ti) { f32x4 acc = {0.f, 0.f, 0.f, 0.f};
#pragma unroll
            for (int kk = 0; kk < 8; ++kk) { const bf16x8 qf = *(const LAS bf16x8*)(Qs + t * 264 + kk * 32 + quad * 8); const bf16x8 kf = *(const LAS bf16x8*)(Ks + (si * 16 + l15) * 264 + kk * 32 + quad * 8); acc = mma16(kf, qf, acc); }
            float v[4];
#pragma unroll
            for (int e = 0; e < 4; ++e) { const int s_ = si * 16 + quad * 4 + e; v[e] = (s_ <= t) ? acc[e] * exp2f((float)(t - s_) * lg2) : 0.f; }
            w.x = pk2(v[0], v[1]); w.y = pk2(v[2], v[3]); }
        if (!DRY || never) *(u32x2*)(SC + (size_t)u * 4096 + ((ti * 2 + (si >> 1)) * 64 + ((si & 1) * 2 + (quad >> 1)) * 16 + l15) * 8 + (quad & 1) * 4) = w; }
    for (int it = tid; it < 2048; it += 512) {
        const int fb = it >> 6, L = it & 63, tt = fb >> 3, kk = fb & 7, fl = L & 15, fq = L >> 4; const int t = tt * 16 + fl;
        const u32x4 v = *(const LAS u32x4*)(Qs + t * 264 + kk * 32 + fq * 8); const float f = exp2f((float)(t + 1) * lg2);
        u32x4 o;
#pragma unroll
        for (int e = 0; e < 4; ++e) o[e] = pk2(bflo(v[e]) * f, bfhi(v[e]) * f);
        if (!DRY || never) *(u32x4*)(Pb + (size_t)(r0 + 2 * fb + (L >> 5)) * LD + Q0 + h * 256 + (L & 31) * 8) = o;
    }
    for (int it = tid; it < 2048; it += 512) {
        const int fb = it >> 6, L = it & 63, kt = fb >> 1, kk = fb & 1, fl = L & 15, fq = L >> 4; const int k = kt * 16 + fl;
        u32x4 o;
#pragma unroll
        for (int e2 = 0; e2 < 4; ++e2) { const int s_ = kk * 32 + fq * 8 + e2 * 2;
            o[e2] = pk2(bf2f(Ks[s_ * 264 + k]) * exp2f((float)(63 - s_) * lg2), bf2f(Ks[(s_ + 1) * 264 + k]) * exp2f((float)(62 - s_) * lg2)); }
        if (!DRY || never) *(u32x4*)(Pb + (size_t)(r0 + 2 * fb + (L >> 5)) * LD + K0 + h * 256 + (L & 31) * 8) = o;
    }
    if ((!DRY || never) && tid < 256) DEC[(size_t)u * 256 + tid] = exp2f(64.f * lg2);
    __syncthreads();
}

template <bool DRY> __device__ __forceinline__ void sgu_unit(LAS unsigned char* lds, bf16* Pb, const float* gain, const float* w_s, const float* b_s, int u, int tid, int never) {
    const int g = u & 7, n = (u >> 3) & 63, b = u >> 9;
    const int r0 = b * SEQ + n * 128;
    LAS bf16* VnT = (LAS bf16*)lds;
    LAS bf16* Ws = VnT + 256 * 136;
    const int wv = tid >> 6, lane = tid & 63, l15 = lane & 15, quad = lane >> 4;
    for (int it = tid; it < 4096; it += 512) {
        const int t = it >> 5, s4 = (it & 31) * 4;
        const f32x4 w = *(const f32x4*)(w_s + (size_t)g * 16384 + t * 128 + s4);
        u32x2 o; o.x = pk2(s4 <= t ? w.x : 0.f, s4 + 1 <= t ? w.y : 0.f); o.y = pk2(s4 + 2 <= t ? w.z : 0.f, s4 + 3 <= t ? w.w : 0.f);
        *(LAS u32x2*)(Ws + t * 136 + s4) = o;
    }
    {
        const int row = tid >> 2, part = tid & 3;
        const bf16* src = Pb + (size_t)(r0 + row) * LD + VS0 + g * 256 + part * 64;
        u32x4 x[8]; float s = 0.f, s2 = 0.f;
#pragma unroll
        for (int j = 0; j < 8; ++j) { x[j] = *(const u32x4*)(src + j * 8);
#pragma unroll
            for (int e = 0; e < 4; ++e) { const float a = bflo(x[j][e]), c = bfhi(x[j][e]); s += a + c; s2 += a * a + c * c; } }
        s += __shfl_xor(s, 1); s2 += __shfl_xor(s2, 1); s += __shfl_xor(s, 2); s2 += __shfl_xor(s2, 2);
        const float mean = s * (1.f / 256.f); const float var = fmaxf(s2 * (1.f / 256.f) - mean * mean, 0.f); const float rstd = rsqrtf(var + 1e-6f);
        const float* gp = gain + g * 256 + part * 64;
#pragma unroll
        for (int j = 0; j < 8; ++j)
#pragma unroll
            for (int e = 0; e < 4; ++e) { const int nr = ((part * 2 + (j >> 2)) * 2 + (e >> 1)) * 16 + (j & 3) * 4 + (e & 1) * 2;
                VnT[nr * 136 + row] = (bf16)f2bf((bflo(x[j][e]) - mean) * rstd * gp[j * 8 + e * 2]);
                VnT[(nr + 1) * 136 + row] = (bf16)f2bf((bfhi(x[j][e]) - mean) * rstd * gp[j * 8 + e * 2 + 1]); }
    }
    __syncthreads();
    {
        const int t = wv * 16 + l15; const int nk = (wv >> 1) + 1;
        bf16x8 wf[4];
#pragma unroll
        for (int kk = 0; kk < 4; ++kk) wf[kk] = *(const LAS bf16x8*)(Ws + t * 136 + kk * 32 + quad * 8);
        const float bias = b_s[g * 128 + t];
        bf16* rowp = Pb + (size_t)(r0 + t) * LD + g * 256 + quad * 8;
        for (int P = 0; P < 8; ++P) {
            const u32x4 uu = *(const u32x4*)(rowp + U0 + P * 32), gs = *(const u32x4*)(rowp + GS0 + P * 32);
            f32x4 a0 = {0.f, 0.f, 0.f, 0.f}, a1 = {0.f, 0.f, 0.f, 0.f};
#pragma unroll
            for (int kk = 0; kk < 4; ++kk) if (kk < nk) { const bf16x8 v0 = *(const LAS bf16x8*)(VnT + ((2 * P) * 16 + l15) * 136 + kk * 32 + quad * 8), v1 = *(const LAS bf16x8*)(VnT + ((2 * P + 1) * 16 + l15) * 136 + kk * 32 + quad * 8);
                a0 = mma16(v0, wf[kk], a0); a1 = mma16(v1, wf[kk], a1); }
            u32x4 o;
            o.x = pk2(bflo(uu.x) * (a0[0] + bias) * silu(bflo(gs.x)), bfhi(uu.x) * (a0[1] + bias) * silu(bfhi(gs.x)));
            o.y = pk2(bflo(uu.y) * (a0[2] + bias) * silu(bflo(gs.y)), bfhi(uu.y) * (a0[3] + bias) * silu(bfhi(gs.y)));
            o.z = pk2(bflo(uu.z) * (a1[0] + bias) * silu(bflo(gs.z)), bfhi(uu.z) * (a1[1] + bias) * silu(bfhi(gs.z)));
            o.w = pk2(bflo(uu.w) * (a1[2] + bias) * silu(bflo(gs.w)), bfhi(uu.w) * (a1[3] + bias) * silu(bfhi(gs.w)));
            if (!DRY || never) *(u32x4*)(rowp + GS0 + P * 32) = o;
        }
    }
    __syncthreads();
}

#define LBAR() do { asm volatile("s_waitcnt lgkmcnt(0)" ::: "memory"); __builtin_amdgcn_s_barrier(); asm volatile("" ::: "memory"); } while (0)
template <int NH, int QOFF, int KOFF, int VOFF, int GOFF, bool DRY>
__device__ __forceinline__ void scan_worker(LAS unsigned char* lds, bf16* Pb, const bf16* SC, const float* DEC, float* SS, int wk, int tid, int never) {
    constexpr int C = 64, NC = SEQ / C, VTS = C + 8, STS = 264;
    constexpr int ST_ELEMS = 32 * STS, VT_ELEMS = 32 * VTS;
    const int w = __builtin_amdgcn_readfirstlane(tid >> 6), lane = tid & 63, l15 = lane & 15, quad = lane >> 4;
    const int bh = wk >> 4, sl = wk & 15, b = bh / NH, h = bh % NH;
    LAS bf16* ST = (LAS bf16*)lds;
    LAS bf16* VT = ST + 2 * ST_ELEMS;
    LAS float* DC = (LAS float*)(VT + 2 * VT_ELEMS);
    const int vcol = VOFF + h * 512 + sl * 32;
    const int wq = w & 3;
    for (int i = tid; i < ST_ELEMS / 2; i += 512) ((LAS unsigned*)ST)[i] = 0u;
    if (w < 4) {
        const int vs_s = tid >> 2, vs_p = tid & 3;
        const unsigned offQ = (unsigned)((wq * 16 + (lane >> 5)) * LD + QOFF + h * 256 + (lane & 31) * 8), offP = (unsigned)(wq * 1024 + lane * 8);
        const unsigned offV = (unsigned)(vs_s * LD + vcol + vs_p * 8);
        const unsigned offO = (unsigned)((wq * 16 + l15) * LD + (vcol - VOFF + GOFF) + quad * 8), offS = (unsigned)(((wq * 16 + l15) * NH + h) * 32 + sl * 2);
        bf16x8 frA[10], frB[10], frC[10]; u32x4 vrA, vrB, vrC, ggA, ggB, ggC;
#define O_LOAD(S, nn) do { const bf16* cb_ = Pb + (size_t)(b * SEQ + (nn) * C) * LD; const bf16* sb_ = SC + (size_t)((b * NC + (nn)) * NH + h) * (C * C); \
            _Pragma("unroll") for (int kk = 0; kk < 8; ++kk) { const bf16* ck_ = cb_ + kk * 2 * LD; fr##S[kk] = *(const bf16x8*)(ck_ + offQ); } \
            _Pragma("unroll") for (int kk = 0; kk < 2; ++kk) fr##S[8 + kk] = *(const bf16x8*)(sb_ + offP + kk * 512); \
            vr##S = *(const u32x4*)(cb_ + offV); gg##S = *(const u32x4*)(cb_ + offO); } while (0)
#define O_VT_WRITE(S, VTp) do { _Pragma("unroll") for (int e = 0; e < 4; ++e) { const int row_ = (e >> 1) * 16 + vs_p * 4 + (e & 1) * 2; (VTp)[row_ * VTS + vs_s] = (bf16)(vr##S[e] & 0xffffu); (VTp)[(row_ + 1) * VTS + vs_s] = (bf16)(vr##S[e] >> 16); } } while (0)
#define O_STEP(S, SN, SL, n_) do { const int n = (n_); const int buf = n & 1; const int r0 = b * SEQ + n * C; \
            LAS bf16* STb = ST + buf * ST_ELEMS; LAS bf16* VTb = VT + buf * VT_ELEMS; LAS bf16* VTn = VT + (buf ^ 1) * VT_ELEMS; \
            LBAR(); \
            { const int nn_ = (n + 2 < NC) ? n + 2 : NC - 1; O_LOAD(SL, nn_); } \
            f32x4 o0 = {0.f, 0.f, 0.f, 0.f}, o1 = {0.f, 0.f, 0.f, 0.f}; \
            _Pragma("unroll") for (int kk = 0; kk < 8; ++kk) { const bf16x8 s0 = *(const LAS bf16x8*)(STb + l15 * STS + kk * 32 + quad * 8); const bf16x8 s1 = *(const LAS bf16x8*)(STb + (16 + l15) * STS + kk * 32 + quad * 8); \
                o0 = mma16(s0, fr##S[kk], o0); o1 = mma16(s1, fr##S[kk], o1); } \
            _Pragma("unroll") for (int kk = 0; kk < 2; ++kk) { const bf16x8 v0 = *(const LAS bf16x8*)(VTb + l15 * VTS + kk * 32 + quad * 8); const bf16x8 v1 = *(const LAS bf16x8*)(VTb + (16 + l15) * VTS + kk * 32 + quad * 8); \
                o0 = mma16(v0, fr##S[8 + kk], o0); o1 = mma16(v1, fr##S[8 + kk], o1); } \
            u32x4 pp; pp.x = pk2(o0[0] * silu(bflo(gg##S.x)), o0[1] * silu(bfhi(gg##S.x))); pp.y = pk2(o0[2] * silu(bflo(gg##S.y)), o0[3] * silu(bfhi(gg##S.y))); \
            pp.z = pk2(o1[0] * silu(bflo(gg##S.z)), o1[1] * silu(bfhi(gg##S.z))); pp.w = pk2(o1[2] * silu(bflo(gg##S.w)), o1[3] * silu(bfhi(gg##S.w))); \
            bf16* op = Pb + (size_t)r0 * LD + offO; \
            if (!DRY || never) *(u32x4*)op = pp; \
            float ss0 = (o0[0] * o0[0] + o0[1] * o0[1]) + (o0[2] * o0[2] + o0[3] * o0[3]), ss1 = (o1[0] * o1[0] + o1[1] * o1[1]) + (o1[2] * o1[2] + o1[3] * o1[3]); \
            ss0 += __shfl_xor(ss0, 16); ss1 += __shfl_xor(ss1, 16); ss0 += __shfl_xor(ss0, 32); ss1 += __shfl_xor(ss1, 32); \
            if ((!DRY || never) && quad == 0) { float* sp = SS + (size_t)r0 * NH * 32 + offS; sp[0] = ss0; sp[1] = ss1; } \
            O_VT_WRITE(SN, VTn); } while (0)
        O_LOAD(A, 0); O_LOAD(B, 1);
        O_VT_WRITE(A, VT);
        for (int n0 = 0; n0 < NC; n0 += 3) {
            O_STEP(A, B, C, n0);
            if (n0 + 1 < NC) O_STEP(B, C, A, n0 + 1);
            if (n0 + 2 < NC) O_STEP(C, A, B, n0 + 2);
        }
#undef O_LOAD
#undef O_VT_WRITE
#undef O_STEP
    } else {
        const unsigned offK = (unsigned)((wq * 16 + (lane >> 5)) * LD + KOFF + h * 256 + (lane & 31) * 8);
        const unsigned offD = (unsigned)(lane * 4);
        const bool dw = (w == 4);
        f32x4 sacc[4][2];
#pragma unroll
        for (int a = 0; a < 4; ++a)
#pragma unroll
            for (int v = 0; v < 2; ++v) sacc[a][v] = (f32x4){0.f, 0.f, 0.f, 0.f};
        bf16x8 frA[8], frB[8], frC[8]; u32x4 vrA = {0u, 0u, 0u, 0u}, vrB = vrA, vrC = vrA;
#define S_LOAD(S, nn) do { const bf16* cb_ = Pb + (size_t)(b * SEQ + (nn) * C) * LD; \
            _Pragma("unroll") for (int a = 0; a < 4; ++a) _Pragma("unroll") for (int kk = 0; kk < 2; ++kk) { const bf16* ca_ = cb_ + (a * 4 + kk * 2) * LD; fr##S[a * 2 + kk] = *(const bf16x8*)(ca_ + offK); } \
            if (dw) vr##S = *(const u32x4*)(DEC + (size_t)((b * NC + (nn)) * NH + h) * 256 + offD); } while (0)
#define S_STEP(S, SN, SL, n_) do { const int n = (n_); const int buf = n & 1; \
            LAS bf16* VTb = VT + buf * VT_ELEMS; LAS bf16* STn = ST + (buf ^ 1) * ST_ELEMS; LAS float* DCb = DC + buf * 256; \
            LBAR(); \
            { const int nn_ = (n + 2 < NC) ? n + 2 : NC - 1; S_LOAD(SL, nn_); } \
            bf16x8 vf[2][2]; \
            _Pragma("unroll") for (int v = 0; v < 2; ++v) _Pragma("unroll") for (int kk = 0; kk < 2; ++kk) vf[v][kk] = *(const LAS bf16x8*)(VTb + (v * 16 + l15) * VTS + kk * 32 + quad * 8); \
            _Pragma("unroll") for (int a = 0; a < 4; ++a) { const f32x4 dc4 = *(const LAS f32x4*)(DCb + (wq * 4 + a) * 16 + quad * 4); \
                _Pragma("unroll") for (int v = 0; v < 2; ++v) { \
                    f32x4 s_ = sacc[a][v] * dc4; \
                    _Pragma("unroll") for (int kk = 0; kk < 2; ++kk) s_ = mma16(fr##S[a * 2 + kk], vf[v][kk], s_); \
                    sacc[a][v] = s_; u32x2 o_; o_.x = pk2(s_[0], s_[1]); o_.y = pk2(s_[2], s_[3]); \
                    *(LAS u32x2*)(STn + (v * 16 + l15) * STS + (wq * 4 + a) * 16 + quad * 4) = o_; } } \
            if (dw) *(LAS u32x4*)(DC + (buf ^ 1) * 256 + lane * 4) = vr##SN; } while (0)
        S_LOAD(A, 0); S_LOAD(B, 1);
        if (dw) *(LAS u32x4*)(DC + lane * 4) = vrA;
        for (int n0 = 0; n0 < NC; n0 += 3) {
            S_STEP(A, B, C, n0);
            if (n0 + 1 < NC) S_STEP(B, C, A, n0 + 1);
            if (n0 + 2 < NC) S_STEP(C, A, B, n0 + 2);
        }
#undef S_LOAD
#undef S_STEP
    }
    asm volatile("s_waitcnt vmcnt(0)" ::: "memory");
    __syncthreads();
}

template <int NH, int GOFF, bool DRY>
__device__ __forceinline__ void fin_phase(bf16* Pb, const float* SS, int gw, int ngw, int lane, int never) {
    for (int item = gw; item < T * NH; item += ngw) {
        const int tok = item / NH, h = item % NH;
        float s = (lane < 32) ? __builtin_nontemporal_load(SS + (size_t)item * 32 + lane) : 0.f; s = wave_sum(s);
        const float rstd = rsqrtf(s * (1.f / 512.f) + 1e-6f);
        bf16* rowp = Pb + (size_t)tok * LD + GOFF + h * 512 + lane * 8;
        const u32x4 o = *(const u32x4*)rowp;
        u32x4 r;
#pragma unroll
        for (int e = 0; e < 4; ++e) r[e] = pk2(bflo(o[e]) * rstd, bfhi(o[e]) * rstd);
        if (!DRY || never) *(u32x4*)rowp = r;
    }
}

__device__ __forceinline__ void lr_phase(const bf16* H, const bf16* WLRT, float* LR, int gw, int ngw, int lane) {
    const int l15 = lane & 15, quad = lane >> 4;
    for (int tile = gw; tile < T / 16; tile += ngw) {
        f32x4 acc = {0.f, 0.f, 0.f, 0.f};
        const bf16* ap = H + (size_t)(tile * 16 + l15) * DM + quad * 8; const bf16* bp = WLRT + (size_t)l15 * DM + quad * 8;
#pragma unroll 8
        for (int kk = 0; kk < 64; ++kk) acc = mma16(*(const bf16x8*)(ap + kk * 32), *(const bf16x8*)(bp + kk * 32), acc);
#pragma unroll
        for (int e = 0; e < 4; ++e) LR[(size_t)(tile * 16 + quad * 4 + e) * 16 + l15] = acc[e];
    }
}

template <bool DRY> __device__ __forceinline__ void glapre_unit(LAS unsigned char* lds, bf16* Pb, const float* LR, const float (&wl)[16], const float bb, bf16* SC, float* DEC, int u, int tid, int never) {
    const int h = u & 7, n = (u >> 3) & 127, b = u >> 10;
    const int r0 = b * SEQ + n * 64;
    LAS bf16* Qs = (LAS bf16*)lds; LAS bf16* Ks = Qs + 64 * 264;
    LAS float* lrs = (LAS float*)(lds + 2 * 64 * 264 * 2); LAS float* tot = lrs + 1024;
    const int c = tid & 255, half = tid >> 8;
    const int wv = tid >> 6, lane = tid & 63, l15 = lane & 15, quad = lane >> 4;
    if (tid < 256) ((LAS f32x4*)lrs)[tid] = ((const f32x4*)(LR + (size_t)r0 * 16))[tid];
    u32x4 qraw[4], kraw[4];
#pragma unroll
    for (int j = 0; j < 4; ++j) { const int it = tid + 512 * j, t_ = it >> 5, c8 = it & 31; const bf16* gp = Pb + (size_t)(r0 + t_) * LD + h * 256 + c8 * 8;
        qraw[j] = *(const u32x4*)(gp + Q1); kraw[j] = *(const u32x4*)(gp + K1); }
    __syncthreads();
    float bc[32]; float run = 0.f;
#pragma unroll
    for (int i = 0; i < 32; ++i) { const int t = half * 32 + i; float z = bb;
#pragma unroll
        for (int r4 = 0; r4 < 4; ++r4) { const f32x4 l = ((const LAS f32x4*)lrs)[t * 4 + r4]; z += (l.x * wl[4 * r4] + l.y * wl[4 * r4 + 1]) + (l.z * wl[4 * r4 + 2] + l.w * wl[4 * r4 + 3]); }
        const float a = -(fmaxf(-z, 0.f) + __logf(1.f + __expf(-fabsf(z)))) * 0.0625f;
        run += a; bc[i] = run; }
    tot[half * 256 + c] = run;
#pragma unroll
    for (int j = 0; j < 4; ++j) { const int it = tid + 512 * j, t_ = it >> 5, c8 = it & 31; *(LAS u32x4*)(Qs + t_ * 264 + c8 * 8) = qraw[j]; *(LAS u32x4*)(Ks + t_ * 264 + c8 * 8) = kraw[j]; }
    __syncthreads();
    const float t0 = tot[c], t1 = tot[256 + c]; const float blast = t0 + t1, off = half ? t0 : 0.f; const float eb = __expf(blast);
    LAS float* ebs = tot + 512;
#pragma unroll
    for (int i = 0; i < 32; ++i) { const int t = half * 32 + i; const float bcv = bc[i] + off;
        const float q = bf2f(Qs[t * 264 + c]), k = bf2f(Ks[t * 264 + c]);
        const float e = __expf(bcv), ei = __expf(-bcv);
        Qs[t * 264 + c] = (bf16)f2bf(q * 0.0625f * e); Ks[t * 264 + c] = (bf16)f2bf(k * ei); }
    if (half == 0) { ebs[c] = eb; if (!DRY || never) DEC[(size_t)u * 256 + c] = eb; }
    __syncthreads();
    for (int it = tid; it < 2048; it += 512) {
        const int fb = it >> 6, L = it & 63, tt = fb >> 3, kk = fb & 7, fl = L & 15, fq = L >> 4;
        const u32x4 v = *(const LAS u32x4*)(Qs + (tt * 16 + fl) * 264 + kk * 32 + fq * 8);
        if (!DRY || never) *(u32x4*)(Pb + (size_t)(r0 + 2 * fb + (L >> 5)) * LD + Q1 + h * 256 + (L & 31) * 8) = v;
    }
    for (int it = tid; it < 2048; it += 512) {
        const int fb = it >> 6, L = it & 63, kt = fb >> 1, kk = fb & 1, fl = L & 15, fq = L >> 4; const int k = kt * 16 + fl; const float ek = ebs[k];
        u32x4 o;
#pragma unroll
        for (int e2 = 0; e2 < 4; ++e2) { const int s_ = kk * 32 + fq * 8 + e2 * 2; o[e2] = pk2(bf2f(Ks[s_ * 264 + k]) * ek, bf2f(Ks[(s_ + 1) * 264 + k]) * ek); }
        if (!DRY || never) *(u32x4*)(Pb + (size_t)(r0 + 2 * fb + (L >> 5)) * LD + K1 + h * 256 + (L & 31) * 8) = o;
    }
#pragma unroll
    for (int tl = 0; tl < 2; ++tl) { const int tile = 2 * wv + tl, ti = tile >> 2, si = tile & 3; const int t = ti * 16 + l15;
        u32x2 w; w.x = 0u; w.y = 0u;
        if (si <= ti) { f32x4 acc = {0.f, 0.f, 0.f, 0.f};
#pragma unroll
            for (int kk = 0; kk < 8; ++kk) { const bf16x8 qf = *(const LAS bf16x8*)(Qs + t * 264 + kk * 32 + quad * 8); const bf16x8 kf = *(const LAS bf16x8*)(Ks + (si * 16 + l15) * 264 + kk * 32 + quad * 8); acc = mma16(kf, qf, acc); }
            float v[4];
#pragma unroll
            for (int e = 0; e < 4; ++e) { const int s = si * 16 + quad * 4 + e; v[e] = (s <= t) ? acc[e] : 0.f; }
            w.x = pk2(v[0], v[1]); w.y = pk2(v[2], v[3]); }
        if (!DRY || never) *(u32x2*)(SC + (size_t)u * 4096 + ((ti * 2 + (si >> 1)) * 64 + ((si & 1) * 2 + (quad >> 1)) * 16 + l15) * 8 + (quad & 1) * 4) = w; }
    __syncthreads();
}

#define RLX_AGENT __ATOMIC_RELAXED, __HIP_MEMORY_SCOPE_AGENT
#define XB_TMO      128
#define XB_XCNT(j)  (256  + 64 * (j))
#define XB_XSUB(j)  (1280 + 64 * (j))
#define XB_XGEN(j)  (2304 + 64 * (j))
#define XB_TOP      3328
#define XB_TOPGEN   3392
#define XCD_BAR_WORDS 3456
#define XB_SPIN_CAP (1u << 18)

__device__ __forceinline__ unsigned xb_ld(unsigned* p)              { return __hip_atomic_load(p, __ATOMIC_RELAXED, __HIP_MEMORY_SCOPE_AGENT); }
__device__ __forceinline__ unsigned xb_add(unsigned* p, unsigned v) { return __hip_atomic_fetch_add(p, v, __ATOMIC_RELAXED, __HIP_MEMORY_SCOPE_AGENT); }
__device__ __forceinline__ unsigned xb_xcc_id() { return (unsigned)__builtin_amdgcn_s_getreg((3 << 11) | 20) & 0xFu; }
#define XB_SPIN(cond, bar) do { unsigned _sp = 0; while (cond) { __builtin_amdgcn_s_sleep(1); \
    if ((++_sp & 255u) == 0u) { if (xb_ld(&(bar)[XB_TMO])) break; if (_sp > XB_SPIN_CAP) { atomicAdd(&(bar)[XB_TMO], 1u); break; } } } } while (0)

struct XcdBarrier {
    unsigned* bar; unsigned x;
    volatile LAS unsigned* st;
};

__device__ __forceinline__ XcdBarrier xcd_barrier_post(unsigned* bar, volatile LAS unsigned* st) {
    XcdBarrier b; b.bar = bar; b.x = xb_xcc_id(); b.st = st;
    if (threadIdx.x == 0) (void)xb_add(&bar[XB_XCNT(b.x)], 1u);
    return b;
}
__device__ __forceinline__ void xcd_barrier_complete(unsigned* bar, unsigned x, unsigned& nloc, unsigned& nx) {
    const unsigned G = gridDim.x * gridDim.y * gridDim.z;
    unsigned sum, cnt, mine, sp = 0u;
    for (;;) {
        sum = 0u; cnt = 0u; mine = 0u;
#pragma unroll
        for (unsigned j = 0; j < 16; ++j) { const unsigned c = xb_ld(&bar[XB_XCNT(j)]); sum += c; cnt += (c > 0u) ? 1u : 0u; mine = (j == x) ? c : mine; }
        if (sum == G) break;
        __builtin_amdgcn_s_sleep(1);
        if ((++sp & 255u) == 0u) { if (xb_ld(&bar[XB_TMO])) break; if (sp > XB_SPIN_CAP) { atomicAdd(&bar[XB_TMO], 1u); break; } }
    }
    nloc = mine > 0u ? mine : 1u; nx = cnt > 0u ? cnt : 1u;
}

__device__ __forceinline__ void xcd_barrier(const XcdBarrier& b) {
    asm volatile("s_waitcnt vmcnt(0)" ::: "memory");
    __syncthreads();
    if (threadIdx.x == 0) {
        unsigned* bar = b.bar;
        __builtin_amdgcn_s_waitcnt(0);
        unsigned nloc = b.st[0], nx = b.st[1];
        if (nloc == 0u) { xcd_barrier_complete(bar, b.x, nloc, nx); b.st[0] = nloc; b.st[1] = nx; }
        const unsigned old = xb_add(&bar[XB_XSUB(b.x)], 1u);
        const unsigned gen = old / nloc;
        if (old + 1u == (gen + 1u) * nloc) {
            __builtin_amdgcn_fence(__ATOMIC_RELEASE, "agent");
            asm volatile("s_waitcnt vmcnt(0)" ::: "memory");
            const unsigned og = xb_add(&bar[XB_TOP], 1u);
            const unsigned tg = og / nx;
            if (og + 1u == (tg + 1u) * nx) xb_add(&bar[XB_TOPGEN], 1u);
            else XB_SPIN(xb_ld(&bar[XB_TOPGEN]) == tg, bar);
            __builtin_amdgcn_fence(__ATOMIC_ACQUIRE, "agent");
            xb_add(&bar[XB_XGEN(b.x)], 1u);
            asm volatile("s_waitcnt vmcnt(0)" ::: "memory");
        } else {
            XB_SPIN(xb_ld(&bar[XB_XGEN(b.x)]) == gen, bar);
            __builtin_amdgcn_fence(__ATOMIC_ACQUIRE, "agent");
            asm volatile("s_waitcnt vmcnt(0)" ::: "memory");
        }
    }
    __syncthreads();
}

template <int NH>
__device__ __forceinline__ void build_hs_table(LAS float* tab, const float* SS, int pm, int tid) {
    for (int it = tid; it < 256 * NH; it += 512) { const int row = it / NH, h = it % NH;
        const f32x4* sp = (const f32x4*)(SS + ((size_t)(pm * 256 + row) * NH + h) * 32);
        float s = 0.f;
#pragma unroll
        for (int i = 0; i < 8; ++i) { const f32x4 v = sp[i]; s += (v.x + v.y) + (v.z + v.w); }
        tab[h * 256 + row] = rsqrtf(s * (1.f / 512.f) + 1e-6f); }
    __syncthreads();
    float f[NH / 2];
#pragma unroll
    for (int k = 0; k < NH / 2; ++k) { const int it = tid + 512 * k, j = it >> 8, row = it & 255; f[k] = (j < NH - 1) ? tab[j * 256 + row] / tab[(j + 1) * 256 + row] : tab[j * 256 + row]; }
    __syncthreads();
#pragma unroll
    for (int k = 0; k < NH / 2; ++k) tab[tid + 512 * k] = f[k];
    __syncthreads();
}

struct Args { const float* x; const int* pos; const float* ev_norm; const float* ev_w_in; const float* sgu_gain; const float* sgu_w_s; const float* sgu_b; const float* ev_w_out;
              const float* od_norm; const float* od_w_in; const float* gla_w_lr; const float* gla_b_lr; const float* od_w_out; const float* final_norm; float* out; unsigned char* ws; int never; int pad; };

__global__ void __launch_bounds__(512, 2) trunk_fwd(Args a) {
    extern __shared__ __attribute__((aligned(16))) unsigned char lds_raw[];
    LAS unsigned char* lds = (LAS unsigned char*)lds_raw;
    cg::grid_group grid = cg::this_grid();
    volatile LAS unsigned* xbst = (volatile LAS unsigned*)(lds + 131072 + 8 * 2304);
    if (threadIdx.x < 2) xbst[threadIdx.x] = 0u;
    __syncthreads();
    XcdBarrier xbar = xcd_barrier_post((unsigned*)a.ws, xbst);
    const int G = gridDim.x, bid = blockIdx.x, ngw = G * 8;
#define PH_BEGIN int t_ = threadIdx.x; asm volatile("" : "+v"(t_)); const int tid = t_, lane = tid & 63, wave = __builtin_amdgcn_readfirstlane(tid >> 6), gw = bid * 8 + wave; LAS float* scr = (LAS float*)(lds + wave * 16384); (void)lane; (void)gw; (void)scr;
    unsigned char* ws = a.ws;
    float* LR = (float*)(ws + WS_LR); bf16* WLRT = (bf16*)(ws + WS_WLRT); float* DEC = (float*)(ws + WS_DEC);
    bf16* WA = (bf16*)(ws + WS_WA); bf16* H = (bf16*)(ws + WS_H); bf16* Pb = (bf16*)(ws + WS_P);
    bf16* SC = (bf16*)(ws + WS_SC); float* SS = (float*)(ws + WS_SS); bf16* WO0 = (bf16*)(ws + WS_WO0);

    { PH_BEGIN
    for (int rep = 0; rep < 1 + ((PROBE >> 11) & 1); ++rep) {
    transpose_all<true>(a.ev_w_in, 12288, 2048, 12288, WA, scr, gw, ngw, lane);
    for (int m = gw; m < T; m += ngw) rms_row_bf16(a.x + (size_t)m * DM, a.ev_norm, H + (size_t)m * DM, lane);
    }
    }
    xcd_barrier(xbar);
    { PH_BEGIN
    if ((PROBE >> 15) & 1) { pg8::Gemm g{H, WA, T, 12288, 2048, 2048}; pg8::StaticOrder S; S.init(T, 12288, G, bid); pg8::EpiHot E{(bf16*)a.out};
      pg8::gemm_phase<pg8::EpiHot, pg8::StaticOrder, true, true>(lds, g, S, E); }
    for (int rep = 0; rep < 1 + ((PROBE >> 1) & 1); ++rep)
    { pg8::Gemm g{H, WA, T, 12288, 2048, 2048}; pg8::StaticOrder S; S.init(T, 12288, G, bid); pg8::EpiBf16W E{Pb, LD, lds + 131072};
      pg8::gemm_phase<pg8::EpiBf16W, pg8::StaticOrder, true, true>(lds, g, S, E); }
    }
    xcd_barrier(xbar);
    { PH_BEGIN
    if ((PROBE >> 2) & 1) for (int u = bid; u < 1024; u += G) retpre_unit<true>(lds, Pb, a.pos, SC, DEC, u, tid, a.never);
    for (int u = bid; u < 1024; u += G) retpre_unit<false>(lds, Pb, a.pos, SC, DEC, u, tid, a.never);
    }
    xcd_barrier(xbar);
    { PH_BEGIN
    for (int v = bid; v < 256; v += G) { const int xcd = v & 7, idx = v >> 3;
        if (idx < 16) { const int wk = xcd * 16 + idx;
            if ((PROBE >> 4) & 1) scan_worker<4, Q0, K0, V0, GR0, true>(lds, Pb, SC, DEC, SS, wk, tid, a.never);
            scan_worker<4, Q0, K0, V0, GR0, false>(lds, Pb, SC, DEC, SS, wk, tid, a.never);
        } else { const int hi = (idx - 16) * 8 + xcd;
            if ((PROBE >> 3) & 1) for (int u = hi; u < 1024; u += 128) sgu_unit<true>(lds, Pb, a.sgu_gain, a.sgu_w_s, a.sgu_b, u, tid, a.never);
            for (int u = hi; u < 1024; u += 128) sgu_unit<false>(lds, Pb, a.sgu_gain, a.sgu_w_s, a.sgu_b, u, tid, a.never);
            transpose_all<false>(a.ev_w_out, 2048, 4096, 2048, WO0, scr, hi * 8 + wave, 128 * 8, lane);
            transpose_all<false>(a.od_w_in, 12304, 2048, 12288, WA, scr, hi * 8 + wave, 128 * 8, lane);
        } }
    }
    grid.sync();
    if (G != 256) {
    { PH_BEGIN
    if ((PROBE >> 5) & 1) fin_phase<4, GR0, true>(Pb, SS, gw, ngw, lane, a.never);
    fin_phase<4, GR0, false>(Pb, SS, gw, ngw, lane, a.never);
    }
    xcd_barrier(xbar);
    }
    { PH_BEGIN
    { pg8::Gemm g{Pb + MIXC, WO0, T, 2048, 4096, LD}; pg8::StaticOrder S; S.init(T, 2048, G, bid); pg8::EpiBf16W E{(bf16*)a.out, 2 * DM, lds + 131072};
      if (G == 256) { pg8::Unit u0; S.next(0, u0); LAS float* tab = (LAS float*)(lds + HS_OFF); build_hs_table<4>(tab, SS, u0.pm, tid);
        pg8::gemm_phase<pg8::EpiBf16W, pg8::StaticOrder, true, true, 4>(lds, g, S, E, tab); }
      else pg8::gemm_phase<pg8::EpiBf16W, pg8::StaticOrder, true, true>(lds, g, S, E); }
    }
    xcd_barrier(xbar);
    { PH_BEGIN
    for (int m = gw; m < T; m += ngw) res_rms_row_bf16(a.x + (size_t)m * DM, (const bf16*)a.out + (size_t)m * 2 * DM, a.od_norm, H + (size_t)m * DM, lane);
    for (int i = bid * 512 + tid; i < 16 * 2048; i += G * 512) { const int r = i >> 11, k = i & 2047; WLRT[i] = (bf16)f2bf(a.od_w_in[(size_t)k * 12304 + 12288 + r]); }
    }
    xcd_barrier(xbar);
    { PH_BEGIN
    lr_phase(H, WLRT, LR, gw, ngw, lane);
    { pg8::Gemm g{H, WA, T, 12288, 2048, 2048}; pg8::StaticOrder S; S.init(T, 12288, G, bid); pg8::EpiBf16W E{Pb, LD, lds + 131072};
      pg8::gemm_phase<pg8::EpiBf16W, pg8::StaticOrder, true, true>(lds, g, S, E); }
    }
    xcd_barrier(xbar);
    { PH_BEGIN
    { float wl[16]; float bb = 0.f; int hcur = -1;
#pragma unroll
      for (int r = 0; r < 16; ++r) wl[r] = 0.f;
      for (int u = bid; u < 2048; u += G) { const int h_ = u & 7;
        if (h_ != hcur) { hcur = h_; const int c_ = tid & 255;
#pragma unroll
            for (int r = 0; r < 16; ++r) wl[r] = a.gla_w_lr[r * 2048 + h_ * 256 + c_];
            bb = a.gla_b_lr[h_ * 256 + c_]; }
        if ((PROBE >> 8) & 1) glapre_unit<true>(lds, Pb, LR, wl, bb, SC, DEC, u, tid, a.never);
        glapre_unit<false>(lds, Pb, LR, wl, bb, SC, DEC, u, tid, a.never); } }
    transpose_all<false>(a.od_w_out, 2048, 4096, 2048, WA, scr, gw, ngw, lane);
    }
    xcd_barrier(xbar);
    { PH_BEGIN
    for (int v = bid; v < 256; v += G) { const int xcd = v & 7, idx = v >> 3; const int wk = (xcd * 2 + (idx >> 4)) * 16 + (idx & 15);
        if ((PROBE >> 9) & 1) scan_worker<8, Q1, K1, V1, G1, true>(lds, Pb, SC, DEC, SS, wk, tid, a.never);
        scan_worker<8, Q1, K1, V1, G1, false>(lds, Pb, SC, DEC, SS, wk, tid, a.never); }
    }
    xcd_barrier(xbar);
    if (G != 256) {
    { PH_BEGIN
    if ((PROBE >> 10) & 1) fin_phase<8, G1, true>(Pb, SS, gw, ngw, lane, a.never);
    fin_phase<8, G1, false>(Pb, SS, gw, ngw, lane, a.never);
    }
    xcd_barrier(xbar);
    }
    { PH_BEGIN
    { pg8::Gemm g{Pb + MIXC, WA, T, 2048, 4096, LD}; pg8::StaticOrder S; S.init(T, 2048, G, bid); pg8::EpiBf16W E{Pb, LD, lds + 131072};
      if (G == 256) { pg8::Unit u0; S.next(0, u0); LAS float* tab = (LAS float*)(lds + HS_OFF); build_hs_table<8>(tab, SS, u0.pm, tid);
        pg8::gemm_phase<pg8::EpiBf16W, pg8::StaticOrder, true, true, 8>(lds, g, S, E, tab); }
      else pg8::gemm_phase<pg8::EpiBf16W, pg8::StaticOrder, true, true>(lds, g, S, E); }
    }
    xcd_barrier(xbar);
    if ((PROBE >> 12) & 1) { for (int rep = 0; rep < 12; ++rep) xcd_barrier(xbar); }
    { PH_BEGIN
    for (int m = gw; m < T; m += ngw) res_rms_row_f32(a.x + (size_t)m * DM, a.out + (size_t)m * DM, Pb + (size_t)m * LD, a.final_norm, lane);
    }
}

extern "C" void kernel_launch(void* const* d_in, const int* in_sizes, int n_in, void* d_out, int out_size, void* d_ws, size_t ws_size, hipStream_t stream) {
    static int grid = 0;
    if (grid == 0) {
        if (n_in != 14 || out_size != T * DM || ws_size < WS_END) { fprintf(stderr, "kernel_launch: unexpected shapes (n_in %d out %d ws %zu)\n", n_in, out_size, ws_size); grid = -1; return; }
        int dev = 0, cus = 0, per_cu = 0;
        (void)hipGetDevice(&dev);
        (void)hipDeviceGetAttribute(&cus, hipDeviceAttributeMultiprocessorCount, dev);
        (void)hipFuncSetAttribute((const void*)trunk_fwd, hipFuncAttributeMaxDynamicSharedMemorySize, LDS_BYTES);
        (void)hipOccupancyMaxActiveBlocksPerMultiprocessor(&per_cu, (const void*)trunk_fwd, 512, LDS_BYTES);
        if (per_cu < 1) per_cu = 1;
        grid = cus * per_cu;
    }
    if (grid < 0) return;
    (void)hipMemsetAsync(d_ws, 0, 16384, stream);
    Args a{};
    a.x = (const float*)d_in[0]; a.pos = (const int*)d_in[1]; a.ev_norm = (const float*)d_in[2]; a.ev_w_in = (const float*)d_in[3]; a.sgu_gain = (const float*)d_in[4];
    a.sgu_w_s = (const float*)d_in[5]; a.sgu_b = (const float*)d_in[6]; a.ev_w_out = (const float*)d_in[7]; a.od_norm = (const float*)d_in[8]; a.od_w_in = (const float*)d_in[9];
    a.gla_w_lr = (const float*)d_in[10]; a.gla_b_lr = (const float*)d_in[11]; a.od_w_out = (const float*)d_in[12]; a.final_norm = (const float*)d_in[13];
    a.out = (float*)d_out; a.ws = (unsigned char*)d_ws;
    void* args[] = {&a};
    hipError_t e = hipLaunchCooperativeKernel((void*)trunk_fwd, dim3(grid), dim3(512), args, LDS_BYTES, stream);
    if (e != hipSuccess) fprintf(stderr, "kernel_launch: cooperative launch failed: %s (grid %d)\n", hipGetErrorString(e), grid);
}
```

```cpp
#include <hip/hip_runtime.h>
#include <hip/hip_cooperative_groups.h>
#include <cstdio>
#include <cstdint>
namespace cg = cooperative_groups;

namespace pg8 {
#define PG8_LAS __attribute__((address_space(3)))
typedef unsigned short bf16_t;
typedef short bf16x8 __attribute__((ext_vector_type(8)));
typedef float f32x4 __attribute__((ext_vector_type(4)));
typedef unsigned u32x4 __attribute__((ext_vector_type(4)));
constexpr int BM = 256, BK = 64, HALF = 128, HTB = HALF * BK * 2, STAGE_BYTES = 8 * HTB, NXCD = 8, WGM = 8;
__host__ __device__ __forceinline__ int lds_byte(int r, int c) { const int st = (r >> 4) * 2 + (c >> 5), rr = r & 15, cc = c & 31, ob = rr * 64 + cc * 2; return st * 1024 + (ob ^ (((ob >> 9) & 1) << 5)); }
__host__ __device__ __forceinline__ void stage_rc(int b, int& R, int& C) { const int st = b / 1024, sb = b % 1024, swz = sb ^ (((sb >> 9) & 1) << 5); R = (st >> 1) * 16 + swz / 64; C = (st & 1) * 32 + (swz % 64) / 2; }
__host__ __device__ __forceinline__ int perm32(int rho) { const int n = rho >> 4, i = rho & 15; return 8 * (i >> 2) + 4 * n + (i & 3); }
struct Unit { int pm, pn; };
struct Gemm { const bf16_t* A; const bf16_t* Bt; int M, N, K, lda; };
struct StaticOrder {
    int nM, nN, nwg, G, c;
    __host__ __device__ void init(int M, int N, int G_, int c_) { nM = M / BM; nN = N / BM; nwg = nM * nN; G = G_; c = c_; }
    __host__ __device__ bool next(int i, Unit& u) const {
        const long L = (long)i * G + c; if (L >= nwg) return false;
        int wgid = (int)L; { const int q = nwg / NXCD, r = nwg % NXCD, xcd = wgid % NXCD, off = wgid / NXCD; wgid = (xcd < r ? xcd * (q + 1) : r * (q + 1) + (xcd - r) * q) + off; }
        const int nig = WGM * nN, gid = wgid / nig, fm = gid * WGM, gsz = (nM - fm) < WGM ? (nM - fm) : WGM;
        u.pm = fm + ((wgid % nig) % gsz); u.pn = (wgid % nig) / gsz; return true;
    }
    __device__ __forceinline__ void a_ready(const Unit&) const {}
    __device__ __forceinline__ void done(const Unit&) const {}
};
typedef float f32x2c __attribute__((ext_vector_type(2)));
typedef __bf16 bf16x2c __attribute__((ext_vector_type(2)));
__device__ __forceinline__ unsigned cvt_pk_bf16(float lo, float hi) { const f32x2c v = {lo, hi}; const bf16x2c b = __builtin_convertvector(v, bf16x2c); return __builtin_bit_cast(unsigned, b); }
struct EpiBf16P {
    static constexpr bool PERM = true, WIDE = false, AFTER_DRAIN = false;
    bf16_t* O; int ldc;
    __device__ __forceinline__ void operator()(const f32x4 (&acc)[2][2][4][2], const Unit& u, int wr, int wc, int fr, int fq) const {
        const int row0 = u.pm * BM + wr * 64 + fr, col0 = u.pn * BM + wc * 32 + 8 * fq;
#pragma unroll
        for (int ai = 0; ai < 2; ++ai)
#pragma unroll
            for (int m = 0; m < 4; ++m) { bf16_t* rowp = O + (size_t)(row0 + ai * HALF + m * 16) * ldc + col0;
#pragma unroll
                for (int bj = 0; bj < 2; ++bj) { const f32x4 v0 = acc[ai][bj][m][0], v1 = acc[ai][bj][m][1];
                    u32x4 w; w.x = cvt_pk_bf16(v0[0], v0[1]); w.y = cvt_pk_bf16(v0[2], v0[3]); w.z = cvt_pk_bf16(v1[0], v1[1]); w.w = cvt_pk_bf16(v1[2], v1[3]);
                    *(u32x4*)(rowp + bj * HALF) = w; } }
    }
};
struct EpiNull {
    static constexpr bool PERM = false, WIDE = false, AFTER_DRAIN = false;
    float* out; int never;
    __device__ __forceinline__ void operator()(const f32x4 (&acc)[2][2][4][2], const Unit& u, int wr, int wc, int fr, int fq) const {
        f32x4 s = {0.f, 0.f, 0.f, 0.f};
#pragma unroll
        for (int ai = 0; ai < 2; ++ai)
#pragma unroll
            for (int bj = 0; bj < 2; ++bj)
#pragma unroll
                for (int m = 0; m < 4; ++m)
#pragma unroll
                    for (int n = 0; n < 2; ++n) s += acc[ai][bj][m][n];
        if (never) *(f32x4*)(out + (size_t)(u.pm * BM + wr * 64 + fr) * 2048 + u.pn * BM + wc * 32 + 4 * fq) = s;
    }
};
struct EpiBf16W {
    static constexpr bool PERM = true, WIDE = true, AFTER_DRAIN = false;
    bf16_t* O; int ldc; PG8_LAS unsigned char* stg;
    __device__ __forceinline__ void operator()(const f32x4 (&acc)[2][2][4][2], const Unit& u, int wr, int wc, int fr, int fq) const {
        PG8_LAS unsigned char* my = stg + (wr * 4 + wc) * 2304;
        const int lane = fq * 16 + fr, rrow = lane >> 3, rc8 = lane & 7;
        bf16_t* obase = O + (size_t)(u.pm * BM + wr * 64 + rrow) * ldc + u.pn * BM + wc * 64 + rc8 * 8;
#pragma unroll
        for (int ai = 0; ai < 2; ++ai)
#pragma unroll
            for (int m = 0; m < 4; ++m) {
                u32x4 w0, w1;
                w0.x = cvt_pk_bf16(acc[ai][0][m][0][0], acc[ai][0][m][0][1]); w0.y = cvt_pk_bf16(acc[ai][0][m][0][2], acc[ai][0][m][0][3]);
                w0.z = cvt_pk_bf16(acc[ai][0][m][1][0], acc[ai][0][m][1][1]); w0.w = cvt_pk_bf16(acc[ai][0][m][1][2], acc[ai][0][m][1][3]);
                w1.x = cvt_pk_bf16(acc[ai][1][m][0][0], acc[ai][1][m][0][1]); w1.y = cvt_pk_bf16(acc[ai][1][m][0][2], acc[ai][1][m][0][3]);
                w1.z = cvt_pk_bf16(acc[ai][1][m][1][0], acc[ai][1][m][1][1]); w1.w = cvt_pk_bf16(acc[ai][1][m][1][2], acc[ai][1][m][1][3]);
                *(PG8_LAS u32x4*)(my + fr * 144 + fq * 32) = w0; *(PG8_LAS u32x4*)(my + fr * 144 + fq * 32 + 16) = w1;
                asm volatile("s_waitcnt lgkmcnt(0)" ::: "memory");
                const u32x4 r0 = *(const PG8_LAS u32x4*)(my + rrow * 144 + rc8 * 16), r1 = *(const PG8_LAS u32x4*)(my + (8 + rrow) * 144 + rc8 * 16);
                asm volatile("s_waitcnt lgkmcnt(0)" ::: "memory");
                bf16_t* op = obase + (size_t)(ai * HALF + m * 16) * ldc;
                __builtin_nontemporal_store(r0, (u32x4*)op); __builtin_nontemporal_store(r1, (u32x4*)(op + (size_t)8 * ldc));
            }
    }
};
struct EpiHot {
    static constexpr bool PERM = true, WIDE = false, AFTER_DRAIN = false;
    bf16_t* O;
    __device__ __forceinline__ void operator()(const f32x4 (&acc)[2][2][4][2], const Unit& u, int wr, int wc, int fr, int fq) const {
        const int row0 = wr * 64 + fr, col0 = wc * 32 + 8 * fq;
#pragma unroll
        for (int ai = 0; ai < 2; ++ai)
#pragma unroll
            for (int m = 0; m < 4; ++m) { bf16_t* rowp = O + (size_t)blockIdx.x * 65536 + (size_t)(row0 + ai * HALF + m * 16) * 256 + col0;
#pragma unroll
                for (int bj = 0; bj < 2; ++bj) { const f32x4 v0 = acc[ai][bj][m][0], v1 = acc[ai][bj][m][1];
                    u32x4 w; w.x = cvt_pk_bf16(v0[0], v0[1]); w.y = cvt_pk_bf16(v0[2], v0[3]); w.z = cvt_pk_bf16(v1[0], v1[1]); w.w = cvt_pk_bf16(v1[2], v1[3]);
                    *(u32x4*)(rowp + bj * HALF) = w; } }
    }
};
struct EpiF32P {
    static constexpr bool PERM = true, WIDE = false, AFTER_DRAIN = false;
    float* out; int ldc;
    __device__ __forceinline__ void operator()(const f32x4 (&acc)[2][2][4][2], const Unit& u, int wr, int wc, int fr, int fq) const {
        const int row0 = u.pm * BM + wr * 64 + fr, col0 = u.pn * BM + wc * 32 + 8 * fq;
#pragma unroll
        for (int ai = 0; ai < 2; ++ai)
#pragma unroll
            for (int m = 0; m < 4; ++m) { float* rowp = out + (size_t)(row0 + ai * HALF + m * 16) * ldc + col0;
#pragma unroll
                for (int bj = 0; bj < 2; ++bj) { *(f32x4*)(rowp + bj * HALF) = acc[ai][bj][m][0]; *(f32x4*)(rowp + bj * HALF + 4) = acc[ai][bj][m][1]; } }
    }
};
template <class Epi, class Sched, bool ALIGN_EPI = false, bool SP2 = false, int NHS = 0>
__device__ __forceinline__ void gemm_phase(PG8_LAS unsigned char* lds, const Gemm g, const Sched& S, const Epi& E, const PG8_LAS float* hs = nullptr) {
    int tid_ = threadIdx.x; asm volatile("" : "+v"(tid_));
    const int tid = tid_, wid = __builtin_amdgcn_readfirstlane(tid >> 6), lane = tid & 63, wr = wid >> 2, wc = wid & 3, fr = lane & 15, fq = lane >> 4;
    const int K = g.K, nt = K / BK;
    unsigned voffA[2], voffB[2];
#pragma unroll
    for (int i = 0; i < 2; ++i) { int R, C; stage_rc(tid * 16 + i * 8192, R, C); const int Rb = Epi::WIDE ? (64 * (R >> 5) + 16 * ((R & 15) >> 2) + 4 * ((R >> 4) & 1) + (R & 3)) : (Epi::PERM ? ((R & ~31) + perm32(R & 31)) : R);
        voffA[i] = (unsigned)(R * g.lda + C) * 2u; voffB[i] = (unsigned)(Rb * K + C) * 2u; }
    const size_t kstep = (size_t)(BK * 2);
    const size_t hstepA = (size_t)HALF * g.lda * 2, hstepB = Epi::WIDE ? (size_t)8 * K * 2 : (size_t)HALF * K * 2;
    const size_t tstepA = 2 * hstepA, tstepB = (size_t)BM * K * 2;
    const unsigned ldsw = (unsigned)wid * 1024u;
    const int aoff = lds_byte(wr * 64 + fr, fq * 8), boff = lds_byte(wc * 32 + fr, fq * 8);
#define PG8_SA(b, h) (((b) * 2 + (h)) * HTB)
#define PG8_SB(b, h) ((4 + (b) * 2 + (h)) * HTB)
#define PG8_STAGE(bufoff, gbase, voff) do { _Pragma("unroll") for (int _i = 0; _i < 2; ++_i) \
        __builtin_amdgcn_global_load_lds((const unsigned*)((const char*)(gbase) + (voff)[_i]), (PG8_LAS unsigned*)(lds + (bufoff) + ldsw + _i * 8192), 16, 0, 0); } while (0)
#define PG8_LDA(dst, b, h) do { _Pragma("unroll") for (int m = 0; m < 4; ++m) _Pragma("unroll") for (int k = 0; k < 2; ++k) dst[m][k] = *(const PG8_LAS bf16x8*)(lds + PG8_SA(b, h) + aoff + m * 2048 + k * 1024); } while (0)
#define PG8_LDB(dst, b, h) do { _Pragma("unroll") for (int n = 0; n < 2; ++n) _Pragma("unroll") for (int k = 0; k < 2; ++k) dst[n][k] = *(const PG8_LAS bf16x8*)(lds + PG8_SB(b, h) + boff + n * 2048 + k * 1024); } while (0)
#define PG8_MMA(ai, bj, At, Bt) do { __builtin_amdgcn_s_setprio(1); _Pragma("unroll") for (int m = 0; m < 4; ++m) _Pragma("unroll") for (int n = 0; n < 2; ++n) _Pragma("unroll") for (int k = 0; k < 2; ++k) \
        acc[ai][bj][m][n] = __builtin_amdgcn_mfma_f32_16x16x32_bf16(Bt[n][k], At[m][k], acc[ai][bj][m][n], 0, 0, 0); __builtin_amdgcn_s_setprio(0); } while (0)
#define PG8_WAIT_V(n) asm volatile("s_waitcnt vmcnt(" #n ")" ::: "memory")
#define PG8_WAIT_L(n) asm volatile("s_waitcnt lgkmcnt(" #n ")" ::: "memory")
#define PG8_BAR __builtin_amdgcn_s_barrier()
#define PG8_SCHED __builtin_amdgcn_sched_barrier(0)
    Unit cur, nxt; int ui = 0;
    if (!S.next(0, cur)) return;
    f32x4 acc[2][2][4][2];
#pragma unroll
    for (int a = 0; a < 2; ++a)
#pragma unroll
        for (int b = 0; b < 2; ++b)
#pragma unroll
            for (int m = 0; m < 4; ++m)
#pragma unroll
                for (int n = 0; n < 2; ++n) acc[a][b][m][n] = (f32x4){0.f, 0.f, 0.f, 0.f};
    bf16x8 At[4][2], B0[2][2], B1[2][2];
    const char* cA = (const char*)g.A + (size_t)cur.pm * tstepA; const char* cB = (const char*)g.Bt + (size_t)cur.pn * tstepB;
    S.a_ready(cur);
    if constexpr (SP2) {
        PG8_STAGE(PG8_SB(0, 0), cB, voffB); PG8_STAGE(PG8_SB(0, 1), cB + hstepB, voffB); PG8_STAGE(PG8_SA(0, 0), cA, voffA); PG8_STAGE(PG8_SA(0, 1), cA + hstepA, voffA);
        if (wr == 1) PG8_BAR;
        PG8_WAIT_V(2); PG8_BAR;
        PG8_STAGE(PG8_SB(1, 0), cB + kstep, voffB); PG8_STAGE(PG8_SA(1, 0), cA + kstep, voffA); PG8_STAGE(PG8_SB(1, 1), cB + hstepB + kstep, voffB);
        PG8_WAIT_V(6); PG8_BAR;
    } else {
        PG8_STAGE(PG8_SB(0, 0), cB, voffB); PG8_STAGE(PG8_SA(0, 0), cA, voffA); PG8_STAGE(PG8_SB(0, 1), cB + hstepB, voffB); PG8_STAGE(PG8_SA(0, 1), cA + hstepA, voffA);
        if (wr == 1) PG8_BAR;
        PG8_WAIT_V(4); PG8_BAR;
        PG8_STAGE(PG8_SB(1, 0), cB + kstep, voffB); PG8_STAGE(PG8_SA(1, 0), cA + kstep, voffA); PG8_STAGE(PG8_SB(1, 1), cB + hstepB + kstep, voffB);
        PG8_WAIT_V(6); PG8_BAR;
    }
    for (;;) {
        const bool has_next = S.next(ui + 1, nxt);
        const char* nA = has_next ? (const char*)g.A + (size_t)nxt.pm * tstepA : cA; const char* nB = has_next ? (const char*)g.Bt + (size_t)nxt.pn * tstepB : cB;
        for (int t = 0; t < nt; t += 2) {
            const bool last = (t == nt - 2);
            const char* a1 = cA + (size_t)(t + 1) * kstep;
            const char* a2 = last ? nA : cA + (size_t)(t + 2) * kstep; const char* b2 = last ? nB : cB + (size_t)(t + 2) * kstep;
            const char* a3 = a2 + kstep; const char* b3 = b2 + kstep;
            if (last && has_next) S.a_ready(nxt);
            if constexpr (SP2) {
            PG8_LDB(B0, 0, 0); PG8_LDB(B1, 0, 1); PG8_SCHED; PG8_LDA(At, 0, 0); PG8_STAGE(PG8_SA(1, 1), a1 + hstepA, voffA);
            PG8_WAIT_V(8); PG8_WAIT_L(0); PG8_BAR; PG8_MMA(0, 0, At, B0); PG8_MMA(0, 1, At, B1); PG8_BAR; PG8_SCHED;
            PG8_LDA(At, 0, 1); PG8_STAGE(PG8_SB(0, 0), b2, voffB); PG8_STAGE(PG8_SB(0, 1), b2 + hstepB, voffB); PG8_STAGE(PG8_SA(0, 0), a2, voffA);
            PG8_WAIT_V(8); PG8_WAIT_L(0); PG8_BAR; PG8_MMA(1, 0, At, B0); PG8_MMA(1, 1, At, B1); PG8_BAR; PG8_SCHED;
            PG8_LDB(B0, 1, 0); PG8_LDB(B1, 1, 1); PG8_SCHED; PG8_LDA(At, 1, 0); PG8_STAGE(PG8_SA(0, 1), a2 + hstepA, voffA);
            PG8_WAIT_V(8); PG8_WAIT_L(0); PG8_BAR; PG8_MMA(0, 0, At, B0); PG8_MMA(0, 1, At, B1); PG8_BAR; PG8_SCHED;
            PG8_LDA(At, 1, 1); PG8_STAGE(PG8_SB(1, 0), b3, voffB); PG8_STAGE(PG8_SB(1, 1), b3 + hstepB, voffB); PG8_STAGE(PG8_SA(1, 0), a3, voffA);
            PG8_WAIT_V(8); PG8_WAIT_L(0); PG8_BAR; PG8_MMA(1, 0, At, B0); PG8_MMA(1, 1, At, B1); PG8_BAR; PG8_SCHED;
            if constexpr (NHS > 0) {
                if (((t + 2) & 7) == 0 && ((t + 2) >> 3) <= NHS) { const PG8_LAS float* tp = hs + (((t + 2) >> 3) - 1) * 256 + wr * 64 + fr;
#pragma unroll
                    for (int ai = 0; ai < 2; ++ai)
#pragma unroll
                        for (int m = 0; m < 4; ++m) { const float f = tp[ai * HALF + m * 16];
#pragma unroll
                            for (int bj = 0; bj < 2; ++bj)
#pragma unroll
                                for (int n = 0; n < 2; ++n) acc[ai][bj][m][n] *= f; }
                    PG8_SCHED; }
            }
            } else {
            PG8_LDB(B0, 0, 0); PG8_SCHED; PG8_LDA(At, 0, 0); PG8_STAGE(PG8_SA(1, 1), a1 + hstepA, voffA);
            PG8_WAIT_L(8); PG8_BAR; PG8_WAIT_L(0); PG8_MMA(0, 0, At, B0); PG8_BAR; PG8_SCHED;
            PG8_LDB(B1, 0, 1); PG8_STAGE(PG8_SB(0, 0), b2, voffB);
            PG8_BAR; PG8_WAIT_L(0); PG8_MMA(0, 1, At, B1); PG8_BAR;
            PG8_LDA(At, 0, 1); PG8_STAGE(PG8_SA(0, 0), a2, voffA);
            PG8_BAR; PG8_WAIT_L(0); PG8_MMA(1, 0, At, B0); PG8_BAR; PG8_SCHED;
            PG8_STAGE(PG8_SB(0, 1), b2 + hstepB, voffB);
            PG8_WAIT_V(6); PG8_BAR; PG8_MMA(1, 1, At, B1); PG8_BAR;
            PG8_LDB(B0, 1, 0); PG8_SCHED; PG8_LDA(At, 1, 0); PG8_STAGE(PG8_SA(0, 1), a2 + hstepA, voffA);
            PG8_WAIT_L(8); PG8_BAR; PG8_WAIT_L(0); PG8_MMA(0, 0, At, B0); PG8_BAR; PG8_SCHED;
            PG8_LDB(B1, 1, 1); PG8_STAGE(PG8_SB(1, 0), b3, voffB);
            PG8_BAR; PG8_WAIT_L(0); PG8_MMA(0, 1, At, B1); PG8_BAR;
            PG8_LDA(At, 1, 1); PG8_STAGE(PG8_SA(1, 0), a3, voffA);
            PG8_BAR; PG8_WAIT_L(0); PG8_MMA(1, 0, At, B0); PG8_BAR; PG8_SCHED;
            PG8_STAGE(PG8_SB(1, 1), b3 + hstepB, voffB);
            PG8_WAIT_V(6); PG8_BAR; PG8_MMA(1, 1, At, B1); PG8_BAR;
            }
        }
        if constexpr (ALIGN_EPI) { if (wr == 0) PG8_BAR; }
        if constexpr (!Epi::AFTER_DRAIN) { E(acc, cur, wr, wc, fr, fq); S.done(cur); }
        if (!has_next) break;
#pragma unroll
        for (int a = 0; a < 2; ++a)
#pragma unroll
            for (int b = 0; b < 2; ++b)
#pragma unroll
                for (int m = 0; m < 4; ++m)
#pragma unroll
                    for (int n = 0; n < 2; ++n) acc[a][b][m][n] = (f32x4){0.f, 0.f, 0.f, 0.f};
        cur = nxt; cA = nA; cB = nB; ++ui;
        if constexpr (ALIGN_EPI) { if (wr == 1) PG8_BAR; }
    }
    PG8_WAIT_V(0);
    if constexpr (!ALIGN_EPI) { if (wr == 0) PG8_BAR; }
    PG8_BAR;
    if constexpr (Epi::AFTER_DRAIN) { E.fused(acc, cur, wr, wc, fr, fq, lds, wid, lane); S.done(cur); }
#undef PG8_SA
#undef PG8_SB
#undef PG8_STAGE
#undef PG8_LDA
#undef PG8_LDB
#undef PG8_MMA
#undef PG8_WAIT_V
#undef PG8_WAIT_L
#undef PG8_BAR
#undef PG8_SCHED
}
}

constexpr int T = 16384, SEQ = 8192, DM = 2048, LD = 12288 + 64;
constexpr int Q0 = 0, K0 = 1024, V0 = 2048, U0 = 4096, VS0 = 6144, GR0 = 8192, GS0 = 10240;
constexpr int Q1 = 0, K1 = 2048, V1 = 4096, G1 = 8192;
constexpr int MIXC = 8192;
constexpr size_t MiB = 1u << 20;
constexpr size_t WS_LR = 1 * MiB, WS_WLRT = 2 * MiB, WS_DEC = 3 * MiB, WS_WA = 8 * MiB, WS_H = 56 * MiB, WS_P = 120 * MiB, WS_END = 512 * MiB;
static_assert(WS_P + (size_t)T * LD * 2 <= WS_END, "d_ws map");
constexpr size_t WS_SC = WS_H, WS_SS = WS_H + 16 * MiB, WS_WO0 = WS_H + 32 * MiB;
constexpr int HS_OFF = 131072 + 8 * 2304 + 256;
constexpr int LDS_BYTES = HS_OFF + 8192;
#ifndef PROBE
#define PROBE 0
#endif

#define LAS __attribute__((address_space(3)))
typedef unsigned short bf16;
typedef short bf16x8 __attribute__((ext_vector_type(8)));
typedef float f32x4 __attribute__((ext_vector_type(4)));
typedef unsigned u32x4 __attribute__((ext_vector_type(4)));
typedef unsigned u32x2 __attribute__((ext_vector_type(2)));
#define LDS_WAIT() asm volatile("s_waitcnt lgkmcnt(0)" ::: "memory")
typedef float f32x2_t __attribute__((ext_vector_type(2)));
typedef __bf16 bf16x2_t __attribute__((ext_vector_type(2)));
__device__ __forceinline__ unsigned pk2(float lo, float hi) { const f32x2_t v = {lo, hi}; const bf16x2_t b = __builtin_convertvector(v, bf16x2_t); return __builtin_bit_cast(unsigned, b); }
__device__ __forceinline__ unsigned f2bf(float f) { return pk2(f, 0.f) & 0xffffu; }
__device__ __forceinline__ float bflo(unsigned w) { return __builtin_bit_cast(float, w << 16); }
__device__ __forceinline__ float bfhi(unsigned w) { return __builtin_bit_cast(float, w & 0xffff0000u); }
__device__ __forceinline__ float bf2f(bf16 b) { return __builtin_bit_cast(float, ((unsigned)b) << 16); }
__device__ __forceinline__ f32x4 mma16(bf16x8 a, bf16x8 b, f32x4 c) { return __builtin_amdgcn_mfma_f32_16x16x32_bf16(a, b, c, 0, 0, 0); }
__device__ __forceinline__ float wave_sum(float v) {
#pragma unroll
    for (int o = 1; o < 64; o <<= 1) v += __shfl_xor(v, o);
    return v;
}
__device__ __forceinline__ float silu(float g) { return g / (1.f + __expf(-g)); }
__device__ __forceinline__ float fexp2(float x) { return __builtin_amdgcn_exp2f(x); }
__device__ __forceinline__ float flog2(float x) { return __builtin_amdgcn_logf(x); }

__device__ __forceinline__ void transpose_item(const float* W, int ldw, int K, bf16* WT, int k0, int n0, int drow0, LAS float* scr, int lane) {
#pragma unroll 8
    for (int i = 0; i < 32; ++i) { const int kk = 2 * i + (lane >> 5); scr[kk * 33 + (lane & 31)] = __builtin_nontemporal_load(W + (size_t)(k0 + kk) * ldw + n0 + (lane & 31)); }
    LDS_WAIT(); asm volatile("" ::: "memory");
    const int c = lane & 7;
#pragma unroll
    for (int j = 0; j < 4; ++j) { const int n = (lane >> 3) + 8 * j; const LAS float* s = scr + (8 * c) * 33 + n;
        u32x4 o; o.x = pk2(s[0 * 33], s[1 * 33]); o.y = pk2(s[2 * 33], s[3 * 33]); o.z = pk2(s[4 * 33], s[5 * 33]); o.w = pk2(s[6 * 33], s[7 * 33]);
        *(u32x4*)(WT + (size_t)(drow0 + n) * K + k0 + 8 * c) = o; }
    LDS_WAIT(); asm volatile("" ::: "memory");
}
__device__ __forceinline__ int perm0(int n) { return n < 4096 ? n : (n < 6144 ? n + 4096 : (n < 10240 ? n - 2048 : n)); }
template <bool PERM> __device__ __forceinline__ void transpose_all(const float* W, int ldw, int K, int N, bf16* WT, LAS float* scr, int gw, int ngw, int lane) {
    const int nblk = N / 32, nitems = (K / 64) * nblk;
    for (int it = gw; it < nitems; it += ngw) { const int kb = it / nblk, nb = it % nblk; const int n0 = nb * 32;
        transpose_item(W, ldw, K, WT, kb * 64, n0, PERM ? perm0(n0) : n0, scr, lane); }
}
__device__ __forceinline__ void rms_row_bf16(const float* xrow, const float* g, bf16* orow, int lane) {
    f32x4 v[8]; float s = 0.f;
#pragma unroll
    for (int j = 0; j < 8; ++j) { v[j] = __builtin_nontemporal_load((const f32x4*)xrow + 64 * j + lane); s += (v[j].x * v[j].x + v[j].y * v[j].y) + (v[j].z * v[j].z + v[j].w * v[j].w); }
    const float r = rsqrtf(wave_sum(s) * (1.f / DM) + 1e-6f);
#pragma unroll
    for (int j = 0; j < 8; ++j) { const f32x4 gg = ((const f32x4*)g)[64 * j + lane]; const f32x4 o = v[j] * r * gg;
        u32x2 w; w.x = pk2(o.x, o.y); w.y = pk2(o.z, o.w); ((u32x2*)orow)[64 * j + lane] = w; }
}
__device__ __forceinline__ void res_rms_row_bf16(const float* xrow, const bf16* acc, const float* g, bf16* orow, int lane) {
    f32x4 v[8]; float s = 0.f;
#pragma unroll
    for (int j = 0; j < 8; ++j) { const u32x2 a = ((const u32x2*)acc)[64 * j + lane]; v[j] = __builtin_nontemporal_load((const f32x4*)xrow + 64 * j + lane) + (f32x4){bflo(a.x), bfhi(a.x), bflo(a.y), bfhi(a.y)};
        s += (v[j].x * v[j].x + v[j].y * v[j].y) + (v[j].z * v[j].z + v[j].w * v[j].w); }
    const float r = rsqrtf(wave_sum(s) * (1.f / DM) + 1e-6f);
#pragma unroll
    for (int j = 0; j < 8; ++j) { const f32x4 gg = ((const f32x4*)g)[64 * j + lane]; const f32x4 o = v[j] * r * gg;
        u32x2 w; w.x = pk2(o.x, o.y); w.y = pk2(o.z, o.w); ((u32x2*)orow)[64 * j + lane] = w; }
}
__device__ __forceinline__ void res_rms_row_f32(const float* xrow, float* io, const bf16* acc2, const float* g, int lane) {
    f32x4 v[8]; float s = 0.f;
#pragma unroll
    for (int j = 0; j < 8; ++j) { const u32x2 a1 = __builtin_nontemporal_load((const u32x2*)io + 64 * j + lane), a2 = __builtin_nontemporal_load((const u32x2*)acc2 + 64 * j + lane);
        v[j] = (__builtin_nontemporal_load((const f32x4*)xrow + 64 * j + lane) + (f32x4){bflo(a1.x), bfhi(a1.x), bflo(a1.y), bfhi(a1.y)}) + (f32x4){bflo(a2.x), bfhi(a2.x), bflo(a2.y), bfhi(a2.y)};
        s += (v[j].x * v[j].x + v[j].y * v[j].y) + (v[j].z * v[j].z + v[j].w * v[j].w); }
    const float r = rsqrtf(wave_sum(s) * (1.f / DM) + 1e-6f);
#pragma unroll
    for (int j = 0; j < 8; ++j) { const f32x4 gg = ((const f32x4*)g)[64 * j + lane]; __builtin_nontemporal_store(v[j] * r * gg, (f32x4*)io + 64 * j + lane); }
}

template <bool DRY> __device__ __forceinline__ void retpre_unit(LAS unsigned char* lds, bf16* Pb, const int* pos, bf16* SC, float* DEC, int u, int tid, int never) {
    const int h = u & 3, n = (u >> 2) & 127, b = u >> 9;
    const int r0 = b * SEQ + n * 64;
    LAS bf16* Qs = (LAS bf16*)lds; LAS bf16* Ks = Qs + 64 * 264;
    const float lg2 = __log2f(1.f - exp2f(-5.f - (float)h));
    const int wv = tid >> 6, lane = tid & 63, l15 = lane & 15, quad = lane >> 4;
    for (int it = tid; it < 1024; it += 512) {
        const int t = it >> 4, j8 = it & 15;
        const float p = (float)pos[r0 + t];
        const bf16* qr = Pb + (size_t)(r0 + t) * LD + Q0 + h * 256 + j8 * 8;
        const bf16* kr = Pb + (size_t)(r0 + t) * LD + K0 + h * 256 + j8 * 8;
        const u32x4 q1 = *(const u32x4*)qr, q2 = *(const u32x4*)(qr + 128), k1 = *(const u32x4*)kr, k2 = *(const u32x4*)(kr + 128);
        u32x4 oq1, oq2, ok1, ok2;
#pragma unroll
        for (int e2 = 0; e2 < 4; ++e2) {
            float cs[2], sn[2];
#pragma unroll
            for (int z = 0; z < 2; ++z) { const float j = (float)(j8 * 8 + e2 * 2 + z);
                const float cj = fexp2(j * -0.10381025296523008f) * 0.15915494309189535f;
                const float hi = p * cj, lo = fmaf(p, cj, -hi); const float fr = (hi - floorf(hi)) + lo;
                sn[z] = __builtin_amdgcn_sinf(fr); cs[z] = __builtin_amdgcn_cosf(fr); }
            const float a0 = bflo(q1[e2]), a1 = bfhi(q1[e2]), b0 = bflo(q2[e2]), b1 = bfhi(q2[e2]);
            oq1[e2] = pk2((a0 * cs[0] - b0 * sn[0]) * 0.0625f, (a1 * cs[1] - b1 * sn[1]) * 0.0625f);
            oq2[e2] = pk2((a0 * sn[0] + b0 * cs[0]) * 0.0625f, (a1 * sn[1] + b1 * cs[1]) * 0.0625f);
            const float c0 = bflo(k1[e2]), c1 = bfhi(k1[e2]), d0 = bflo(k2[e2]), d1 = bfhi(k2[e2]);
            ok1[e2] = pk2(c0 * cs[0] - d0 * sn[0], c1 * cs[1] - d1 * sn[1]);
            ok2[e2] = pk2(c0 * sn[0] + d0 * cs[0], c1 * sn[1] + d1 * cs[1]);
        }
        *(LAS u32x4*)(Qs + t * 264 + j8 * 8) = oq1; *(LAS u32x4*)(Qs + t * 264 + 128 + j8 * 8) = oq2;
        *(LAS u32x4*)(Ks + t * 264 + j8 * 8) = ok1; *(LAS u32x4*)(Ks + t * 264 + 128 + j8 * 8) = ok2;
    }
    __syncthreads();
#pragma unroll
    for (int tl = 0; tl < 2; ++tl) { const int tile = 2 * wv + tl, ti = tile >> 2, si = tile & 3; const int t = ti * 16 + l15;
        u32x2 w; w.x = 0u; w.y = 0u;
        if (si <= ti) { f32x4 acc = {0.f, 0.f, 0.f, 0.f};
#pragma unroll
            for (int kk = 0; kk < 8; ++kk) { const bf16x8 qf = *(const LAS bf16x8*)(Qs + t * 264 + kk * 32 + quad * 8); const bf16x8 kf = *(const LAS bf16x8*)(Ks + (si * 16 + l15) * 264 + kk * 32 + quad * 8); acc = mma16(kf, qf, acc); }
            float v[4];
#pragma unroll
            for (int e = 0; e < 4; ++e) { const int s_ = si * 16 + quad * 4 + e; v[e] = (s_ <= t) ? acc[e] * fexp2((float)(t - s_) * lg2) : 0.f; }
            w.x = pk2(v[0], v[1]); w.y = pk2(v[2], v[3]); }
        if (!DRY || never) *(u32x2*)(SC + (size_t)u * 4096 + ((ti * 2 + (si >> 1)) * 64 + ((si & 1) * 2 + (quad >> 1)) * 16 + l15) * 8 + (quad & 1) * 4) = w; }
    for (int it = tid; it < 2048; it += 512) {
        const int fb = it >> 6, L = it & 63, tt = fb >> 3, kk = fb & 7, fl = L & 15, fq = L >> 4; const int t = tt * 16 + fl;
        const u32x4 v = *(const LAS u32x4*)(Qs + t * 264 + kk * 32 + fq * 8); const float f = fexp2((float)(t + 1) * lg2);
        u32x4 o;
#pragma unroll
        for (int e = 0; e < 4; ++e) o[e] = pk2(bflo(v[e]) * f, bfhi(v[e]) * f);
        if (!DRY || never) *(u32x4*)(Pb + (size_t)(r0 + 2 * fb + (L >> 5)) * LD + Q0 + h * 256 + (L & 31) * 8) = o;
    }
    for (int it = tid; it < 2048; it += 512) {
        const int fb = it >> 6, L = it & 63, kt = fb >> 1, kk = fb & 1, fl = L & 15, fq = L >> 4; const int k = kt * 16 + fl;
        u32x4 o;
#pragma unroll
        for (int e2 = 0; e2 < 4; ++e2) { const int s_ = kk * 32 + fq * 8 + e2 * 2;
            o[e2] = pk2(bf2f(Ks[s_ * 264 + k]) * fexp2((float)(63 - s_) * lg2), bf2f(Ks[(s_ + 1) * 264 + k]) * fexp2((float)(62 - s_) * lg2)); }
        if (!DRY || never) *(u32x4*)(Pb + (size_t)(r0 + 2 * fb + (L >> 5)) * LD + K0 + h * 256 + (L & 31) * 8) = o;
    }
    if ((!DRY || never) && tid < 256) DEC[(size_t)u * 256 + tid] = exp2f(64.f * lg2);
    __syncthreads();
}

template <bool DRY> __device__ __forceinline__ void sgu_unit(LAS unsigned char* lds, bf16* Pb, const float* gain, const float* w_s, const float* b_s, int u, int tid, int never) {
    const int g = u & 7, n = (u >> 3) & 63, b = u >> 9;
    const int r0 = b * SEQ + n * 128;
    LAS bf16* VnT = (LAS bf16*)lds;
    LAS bf16* Ws = VnT + 256 * 136;
    const int wv = tid >> 6, lane = tid & 63, l15 = lane & 15, quad = lane >> 4;
    for (int it = tid; it < 4096; it += 512) {
        const int t = it >> 5, s4 = (it & 31) * 4;
        const f32x4 w = *(const f32x4*)(w_s + (size_t)g * 16384 + t * 128 + s4);
        u32x2 o; o.x = pk2(s4 <= t ? w.x : 0.f, s4 + 1 <= t ? w.y : 0.f); o.y = pk2(s4 + 2 <= t ? w.z : 0.f, s4 + 3 <= t ? w.w : 0.f);
        *(LAS u32x2*)(Ws + t * 136 + s4) = o;
    }
    {
        const int row = tid >> 2, part = tid & 3;
        const bf16* src = Pb + (size_t)(r0 + row) * LD + VS0 + g * 256 + part * 64;
        u32x4 x[8]; float s = 0.f, s2 = 0.f;
#pragma unroll
        for (int j = 0; j < 8; ++j) { x[j] = *(const u32x4*)(src + j * 8);
#pragma unroll
            for (int e = 0; e < 4; ++e) { const float a = bflo(x[j][e]), c = bfhi(x[j][e]); s += a + c; s2 += a * a + c * c; } }
        s += __shfl_xor(s, 1); s2 += __shfl_xor(s2, 1); s += __shfl_xor(s, 2); s2 += __shfl_xor(s2, 2);
        const float mean = s * (1.f / 256.f); const float var = fmaxf(s2 * (1.f / 256.f) - mean * mean, 0.f); const float rstd = rsqrtf(var + 1e-6f);
        const float* gp = gain + g * 256 + part * 64;
#pragma unroll
        for (int j = 0; j < 8; ++j)
#pragma unroll
            for (int e = 0; e < 4; ++e) { const int nr = ((part * 2 + (j >> 2)) * 2 + (e >> 1)) * 16 + (j & 3) * 4 + (e & 1) * 2;
                VnT[nr * 136 + row] = (bf16)f2bf((bflo(x[j][e]) - mean) * rstd * gp[j * 8 + e * 2]);
                VnT[(nr + 1) * 136 + row] = (bf16)f2bf((bfhi(x[j][e]) - mean) * rstd * gp[j * 8 + e * 2 + 1]); }
    }
    __syncthreads();
    {
        const int t = wv * 16 + l15; const int nk = (wv >> 1) + 1;
        bf16x8 wf[4];
#pragma unroll
        for (int kk = 0; kk < 4; ++kk) wf[kk] = *(const LAS bf16x8*)(Ws + t * 136 + kk * 32 + quad * 8);
        const float bias = b_s[g * 128 + t];
        bf16* rowp = Pb + (size_t)(r0 + t) * LD + g * 256 + quad * 8;
        for (int P = 0; P < 8; ++P) {
            const u32x4 uu = *(const u32x4*)(rowp + U0 + P * 32), gs = *(const u32x4*)(rowp + GS0 + P * 32);
            f32x4 a0 = {0.f, 0.f, 0.f, 0.f}, a1 = {0.f, 0.f, 0.f, 0.f};
#pragma unroll
            for (int kk = 0; kk < 4; ++kk) if (kk < nk) { const bf16x8 v0 = *(const LAS bf16x8*)(VnT + ((2 * P) * 16 + l15) * 136 + kk * 32 + quad * 8), v1 = *(const LAS bf16x8*)(VnT + ((2 * P + 1) * 16 + l15) * 136 + kk * 32 + quad * 8);
                a0 = mma16(v0, wf[kk], a0); a1 = mma16(v1, wf[kk], a1); }
            u32x4 o;
            o.x = pk2(bflo(uu.x) * (a0[0] + bias) * silu(bflo(gs.x)), bfhi(uu.x) * (a0[1] + bias) * silu(bfhi(gs.x)));
            o.y = pk2(bflo(uu.y) * (a0[2] + bias) * silu(bflo(gs.y)), bfhi(uu.y) * (a0[3] + bias) * silu(bfhi(gs.y)));
            o.z = pk2(bflo(uu.z) * (a1[0] + bias) * silu(bflo(gs.z)), bfhi(uu.z) * (a1[1] + bias) * silu(bfhi(gs.z)));
            o.w = pk2(bflo(uu.w) * (a1[2] + bias) * silu(bflo(gs.w)), bfhi(uu.w) * (a1[3] + bias) * silu(bfhi(gs.w)));
            if (!DRY || never) *(u32x4*)(rowp + GS0 + P * 32) = o;
        }
    }
    __syncthreads();
}

#define LBAR() do { asm volatile("s_waitcnt lgkmcnt(0)" ::: "memory"); __builtin_amdgcn_s_barrier(); asm volatile("" ::: "memory"); } while (0)
template <int NH, int QOFF, int KOFF, int VOFF, int GOFF, bool DRY>
__device__ __forceinline__ void scan_worker(LAS unsigned char* lds, bf16* Pb, const bf16* SC, const float* DEC, float* SS, int wk, int tid, int never) {
    constexpr int C = 64, NC = SEQ / C, VTS = C + 8, STS = 264;
    constexpr int ST_ELEMS = 32 * STS, VT_ELEMS = 32 * VTS;
    const int w = __builtin_amdgcn_readfirstlane(tid >> 6), lane = tid & 63, l15 = lane & 15, quad = lane >> 4;
    const int bh = wk >> 4, sl = wk & 15, b = bh / NH, h = bh % NH;
    LAS bf16* ST = (LAS bf16*)lds;
    LAS bf16* VT = ST + 2 * ST_ELEMS;
    LAS float* DC = (LAS float*)(VT + 2 * VT_ELEMS);
    const int vcol = VOFF + h * 512 + sl * 32;
    const int wq = w & 3;
    for (int i = tid; i < ST_ELEMS / 2; i += 512) ((LAS unsigned*)ST)[i] = 0u;
    if (w < 4) {
        const int vs_s = tid >> 2, vs_p = tid & 3;
        const unsigned offQ = (unsigned)((wq * 16 + (lane >> 5)) * LD + QOFF + h * 256 + (lane & 31) * 8), offP = (unsigned)(wq * 1024 + lane * 8);
        const unsigned offV = (unsigned)(vs_s * LD + vcol + vs_p * 8);
        const unsigned offO = (unsigned)((wq * 16 + l15) * LD + (vcol - VOFF + GOFF) + quad * 8), offS = (unsigned)(((wq * 16 + l15) * NH + h) * 32 + sl * 2);
        bf16x8 frA[10], frB[10], frC[10]; u32x4 vrA, vrB, vrC, ggA, ggB, ggC;
#define O_LOAD(S, nn) do { const bf16* cb_ = Pb + (size_t)(b * SEQ + (nn) * C) * LD; const bf16* sb_ = SC + (size_t)((b * NC + (nn)) * NH + h) * (C * C); \
            _Pragma("unroll") for (int kk = 0; kk < 8; ++kk) { const bf16* ck_ = cb_ + kk * 2 * LD; fr##S[kk] = *(const bf16x8*)(ck_ + offQ); } \
            _Pragma("unroll") for (int kk = 0; kk < 2; ++kk) fr##S[8 + kk] = *(const bf16x8*)(sb_ + offP + kk * 512); \
            vr##S = *(const u32x4*)(cb_ + offV); gg##S = *(const u32x4*)(cb_ + offO); } while (0)
#define O_VT_WRITE(S, VTp) do { _Pragma("unroll") for (int e = 0; e < 4; ++e) { const int row_ = (e >> 1) * 16 + vs_p * 4 + (e & 1) * 2; (VTp)[row_ * VTS + vs_s] = (bf16)(vr##S[e] & 0xffffu); (VTp)[(row_ + 1) * VTS + vs_s] = (bf16)(vr##S[e] >> 16); } } while (0)
#define O_STEP(S, SN, SL, n_) do { const int n = (n_); const int buf = n & 1; const int r0 = b * SEQ + n * C; \
            LAS bf16* STb = ST + buf * ST_ELEMS; LAS bf16* VTb = VT + buf * VT_ELEMS; LAS bf16* VTn = VT + (buf ^ 1) * VT_ELEMS; \
            LBAR(); \
            { const int nn_ = (n + 2 < NC) ? n + 2 : NC - 1; O_LOAD(SL, nn_); } \
            f32x4 o0 = {0.f, 0.f, 0.f, 0.f}, o1 = {0.f, 0.f, 0.f, 0.f}; \
            _Pragma("unroll") for (int kk = 0; kk < 8; ++kk) { const bf16x8 s0 = *(const LAS bf16x8*)(STb + l15 * STS + kk * 32 + quad * 8); const bf16x8 s1 = *(const LAS bf16x8*)(STb + (16 + l15) * STS + kk * 32 + quad * 8); \
                o0 = mma16(s0, fr##S[kk], o0); o1 = mma16(s1, fr##S[kk], o1); } \
            _Pragma("unroll") for (int kk = 0; kk < 2; ++kk) { const bf16x8 v0 = *(const LAS bf16x8*)(VTb + l15 * VTS + kk * 32 + quad * 8); const bf16x8 v1 = *(const LAS bf16x8*)(VTb + (16 + l15) * VTS + kk * 32 + quad * 8); \
                o0 = mma16(v0, fr##S[8 + kk], o0); o1 = mma16(v1, fr##S[8 + kk], o1); } \
            u32x4 pp; pp.x = pk2(o0[0] * silu(bflo(gg##S.x)), o0[1] * silu(bfhi(gg##S.x))); pp.y = pk2(o0[2] * silu(bflo(gg##S.y)), o0[3] * silu(bfhi(gg##S.y))); \
            pp.z = pk2(o1[0] * silu(bflo(gg##S.z)), o1[1] * silu(bfhi(gg##S.z))); pp.w = pk2(o1[2] * silu(bflo(gg##S.w)), o1[3] * silu(bfhi(gg##S.w))); \
            bf16* op = Pb + (size_t)r0 * LD + offO; \
            if (!DRY || never) *(u32x4*)op = pp; \
            float ss0 = (o0[0] * o0[0] + o0[1] * o0[1]) + (o0[2] * o0[2] + o0[3] * o0[3]), ss1 = (o1[0] * o1[0] + o1[1] * o1[1]) + (o1[2] * o1[2] + o1[3] * o1[3]); \
            ss0 += __shfl_xor(ss0, 16); ss1 += __shfl_xor(ss1, 16); ss0 += __shfl_xor(ss0, 32); ss1 += __shfl_xor(ss1, 32); \
            if ((!DRY || never) && quad == 0) { float* sp = SS + (size_t)r0 * NH * 32 + offS; sp[0] = ss0; sp[1] = ss1; } \
            O_VT_WRITE(SN, VTn); } while (0)
        O_LOAD(A, 0); O_LOAD(B, 1);
        O_VT_WRITE(A, VT);
        for (int n0 = 0; n0 < NC; n0 += 3) {
            O_STEP(A, B, C, n0);
            if (n0 + 1 < NC) O_STEP(B, C, A, n0 + 1);
            if (n0 + 2 < NC) O_STEP(C, A, B, n0 + 2);
        }
#undef O_LOAD
#undef O_VT_WRITE
#undef O_STEP
    } else {
        const unsigned offK = (unsigned)((wq * 16 + (lane >> 5)) * LD + KOFF + h * 256 + (lane & 31) * 8);
        const unsigned offD = (unsigned)(lane * 4);
        const bool dw = (w == 4);
        f32x4 sacc[4][2];
#pragma unroll
        for (int a = 0; a < 4; ++a)
#pragma unroll
            for (int v = 0; v < 2; ++v) sacc[a][v] = (f32x4){0.f, 0.f, 0.f, 0.f};
        bf16x8 frA[8], frB[8], frC[8]; u32x4 vrA = {0u, 0u, 0u, 0u}, vrB = vrA, vrC = vrA;
#define S_LOAD(S, nn) do { const bf16* cb_ = Pb + (size_t)(b * SEQ + (nn) * C) * LD; \
            _Pragma("unroll") for (int a = 0; a < 4; ++a) _Pragma("unroll") for (int kk = 0; kk < 2; ++kk) { const bf16* ca_ = cb_ + (a * 4 + kk * 2) * LD; fr##S[a * 2 + kk] = *(const bf16x8*)(ca_ + offK); } \
            if (dw) vr##S = *(const u32x4*)(DEC + (size_t)((b * NC + (nn)) * NH + h) * 256 + offD); } while (0)
#define S_STEP(S, SN, SL, n_) do { const int n = (n_); const int buf = n & 1; \
            LAS bf16* VTb = VT + buf * VT_ELEMS; LAS bf16* STn = ST + (buf ^ 1) * ST_ELEMS; LAS float* DCb = DC + buf * 256; \
            LBAR(); \
            { const int nn_ = (n + 2 < NC) ? n + 2 : NC - 1; S_LOAD(SL, nn_); } \
            bf16x8 vf[2][2]; \
            _Pragma("unroll") for (int v = 0; v < 2; ++v) _Pragma("unroll") for (int kk = 0; kk < 2; ++kk) vf[v][kk] = *(const LAS bf16x8*)(VTb + (v * 16 + l15) * VTS + kk * 32 + quad * 8); \
            _Pragma("unroll") for (int a = 0; a < 4; ++a) { const f32x4 dc4 = *(const LAS f32x4*)(DCb + (wq * 4 + a) * 16 + quad * 4); \
                _Pragma("unroll") for (int v = 0; v < 2; ++v) { \
                    f32x4 s_ = sacc[a][v] * dc4; \
                    _Pragma("unroll") for (int kk = 0; kk < 2; ++kk) s_ = mma16(fr##S[a * 2 + kk], vf[v][kk], s_); \
                    sacc[a][v] = s_; u32x2 o_; o_.x = pk2(s_[0], s_[1]); o_.y = pk2(s_[2], s_[3]); \
                    *(LAS u32x2*)(STn + (v * 16 + l15) * STS + (wq * 4 + a) * 16 + quad * 4) = o_; } } \
            if (dw) *(LAS u32x4*)(DC + (buf ^ 1) * 256 + lane * 4) = vr##SN; } while (0)
        S_LOAD(A, 0); S_LOAD(B, 1);
        if (dw) *(LAS u32x4*)(DC + lane * 4) = vrA;
        for (int n0 = 0; n0 < NC; n0 += 3) {
            S_STEP(A, B, C, n0);
            if (n0 + 1 < NC) S_STEP(B, C, A, n0 + 1);
            if (n0 + 2 < NC) S_STEP(C, A, B, n0 + 2);
        }
#undef S_LOAD
#undef S_STEP
    }
    asm volatile("s_waitcnt vmcnt(0)" ::: "memory");
    __syncthreads();
}

template <int NH, int GOFF, bool DRY>
__device__ __forceinline__ void fin_phase(bf16* Pb, const float* SS, int gw, int ngw, int lane, int never) {
    for (int item = gw; item < T * NH; item += ngw) {
        const int tok = item / NH, h = item % NH;
        float s = (lane < 32) ? __builtin_nontemporal_load(SS + (size_t)item * 32 + lane) : 0.f; s = wave_sum(s);
        const float rstd = rsqrtf(s * (1.f / 512.f) + 1e-6f);
        bf16* rowp = Pb + (size_t)tok * LD + GOFF + h * 512 + lane * 8;
        const u32x4 o = *(const u32x4*)rowp;
        u32x4 r;
#pragma unroll
        for (int e = 0; e < 4; ++e) r[e] = pk2(bflo(o[e]) * rstd, bfhi(o[e]) * rstd);
        if (!DRY || never) *(u32x4*)rowp = r;
    }
}

__device__ __forceinline__ void lr_phase(const bf16* H, const bf16* WLRT, float* LR, int gw, int ngw, int lane) {
    const int l15 = lane & 15, quad = lane >> 4;
    for (int tile = gw; tile < T / 16; tile += ngw) {
        f32x4 acc = {0.f, 0.f, 0.f, 0.f};
        const bf16* ap = H + (size_t)(tile * 16 + l15) * DM + quad * 8; const bf16* bp = WLRT + (size_t)l15 * DM + quad * 8;
#pragma unroll 8
        for (int kk = 0; kk < 64; ++kk) acc = mma16(*(const bf16x8*)(ap + kk * 32), *(const bf16x8*)(bp + kk * 32), acc);
#pragma unroll
        for (int e = 0; e < 4; ++e) LR[(size_t)(tile * 16 + quad * 4 + e) * 16 + l15] = acc[e];
    }
}

template <bool DRY> __device__ __forceinline__ void glapre_unit(LAS unsigned char* lds, bf16* Pb, const float* LR, const float (&wl)[16], const float bb, bf16* SC, float* DEC, int u, int tid, int never) {
    const int h = u & 7, n = (u >> 3) & 127, b = u >> 10;
    const int r0 = b * SEQ + n * 64;
    LAS bf16* Qs = (LAS bf16*)lds; LAS bf16* Ks = Qs + 64 * 264;
    LAS float* lrs = (LAS float*)(lds + 2 * 64 * 264 * 2); LAS float* tot = lrs + 1024;
    const int c = tid & 255, half = tid >> 8;
    const int wv = tid >> 6, lane = tid & 63, l15 = lane & 15, quad = lane >> 4;
    if (tid < 256) ((LAS f32x4*)lrs)[tid] = ((const f32x4*)(LR + (size_t)r0 * 16))[tid];
    u32x4 qraw[4], kraw[4];
#pragma unroll
    for (int j = 0; j < 4; ++j) { const int it = tid + 512 * j, t_ = it >> 5, c8 = it & 31; const bf16* gp = Pb + (size_t)(r0 + t_) * LD + h * 256 + c8 * 8;
        qraw[j] = *(const u32x4*)(gp + Q1); kraw[j] = *(const u32x4*)(gp + K1); }
    __syncthreads();
    float bc[32]; float run = 0.f;
#pragma unroll
    for (int i = 0; i < 32; ++i) { const int t = half * 32 + i; float z = bb;
#pragma unroll
        for (int r4 = 0; r4 < 4; ++r4) { const f32x4 l = ((const LAS f32x4*)lrs)[t * 4 + r4]; z += (l.x * wl[4 * r4] + l.y * wl[4 * r4 + 1]) + (l.z * wl[4 * r4 + 2] + l.w * wl[4 * r4 + 3]); }
        const float a = -(fmaxf(-z, 0.f) + flog2(1.f + __expf(-fabsf(z))) * 0.69314718056f) * 0.0625f;
        run += a; bc[i] = run; }
    tot[half * 256 + c] = run;
#pragma unroll
    for (int j = 0; j < 4; ++j) { const int it = tid + 512 * j, t_ = it >> 5, c8 = it & 31; *(LAS u32x4*)(Qs + t_ * 264 + c8 * 8) = qraw[j]; *(LAS u32x4*)(Ks + t_ * 264 + c8 * 8) = kraw[j]; }
    __syncthreads();
    const float t0 = tot[c], t1 = tot[256 + c]; const float blast = t0 + t1, off = half ? t0 : 0.f; const float eb = __expf(blast);
    LAS float* ebs = tot + 512;
#pragma unroll
    for (int i = 0; i < 32; ++i) { const int t = half * 32 + i; const float bcv = bc[i] + off;
        const float q = bf2f(Qs[t * 264 + c]), k = bf2f(Ks[t * 264 + c]);
        const float e = __expf(bcv), ei = __expf(-bcv);
        Qs[t * 264 + c] = (bf16)f2bf(q * 0.0625f * e); Ks[t * 264 + c] = (bf16)f2bf(k * ei); }
    if (half == 0) { ebs[c] = eb; if (!DRY || never) DEC[(size_t)u * 256 + c] = eb; }
    __syncthreads();
    for (int it = tid; it < 2048; it += 512) {
        const int fb = it >> 6, L = it & 63, tt = fb >> 3, kk = fb & 7, fl = L & 15, fq = L >> 4;
        const u32x4 v = *(const LAS u32x4*)(Qs + (tt * 16 + fl) * 264 + kk * 32 + fq * 8);
        if (!DRY || never) *(u32x4*)(Pb + (size_t)(r0 + 2 * fb + (L >> 5)) * LD + Q1 + h * 256 + (L & 31) * 8) = v;
    }
    for (int it = tid; it < 2048; it += 512) {
        const int fb = it >> 6, L = it & 63, kt = fb >> 1, kk = fb & 1, fl = L & 15, fq = L >> 4; const int k = kt * 16 + fl; const float ek = ebs[k];
        u32x4 o;
#pragma unroll
        for (int e2 = 0; e2 < 4; ++e2) { const int s_ = kk * 32 + fq * 8 + e2 * 2; o[e2] = pk2(bf2f(Ks[s_ * 264 + k]) * ek, bf2f(Ks[(s_ + 1) * 264 + k]) * ek); }
        if (!DRY || never) *(u32x4*)(Pb + (size_t)(r0 + 2 * fb + (L >> 5)) * LD + K1 + h * 256 + (L & 31) * 8) = o;
    }
#pragma unroll
    for (int tl = 0; tl < 2; ++tl) { const int tile = 2 * wv + tl, ti = tile >> 2, si = tile & 3; const int t = ti * 16 + l15;
        u32x2 w; w.x = 0u; w.y = 0u;
        if (si <= ti) { f32x4 acc = {0.f, 0.f, 0.f, 0.f};
#pragma unroll
            for (int kk = 0; kk < 8; ++kk) { const bf16x8 qf = *(const LAS bf16x8*)(Qs + t * 264 + kk * 32 + quad * 8); const bf16x8 kf = *(const LAS bf16x8*)(Ks + (si * 16 + l15) * 264 + kk * 32 + quad * 8); acc = mma16(kf, qf, acc); }
            float v[4];
#pragma unroll
            for (int e = 0; e < 4; ++e) { const int s = si * 16 + quad * 4 + e; v[e] = (s <= t) ? acc[e] : 0.f; }
            w.x = pk2(v[0], v[1]); w.y = pk2(v[2], v[3]); }
        if (!DRY || never) *(u32x2*)(SC + (size_t)u * 4096 + ((ti * 2 + (si >> 1)) * 64 + ((si & 1) * 2 + (quad >> 1)) * 16 + l15) * 8 + (quad & 1) * 4) = w; }
    __syncthreads();
}

#define RLX_AGENT __ATOMIC_RELAXED, __HIP_MEMORY_SCOPE_AGENT
#define XB_TMO      128
#define XB_XCNT(j)  (256  + 64 * (j))
#define XB_XSUB(j)  (1280 + 64 * (j))
#define XB_XGEN(j)  (2304 + 64 * (j))
#define XB_TOP      3328
#define XB_TOPGEN   3392
#define XCD_BAR_WORDS 3456
#define XB_SPIN_CAP (1u << 18)

__device__ __forceinline__ unsigned xb_ld(unsigned* p)              { return __hip_atomic_load(p, __ATOMIC_RELAXED, __HIP_MEMORY_SCOPE_AGENT); }
__device__ __forceinline__ unsigned xb_add(unsigned* p, unsigned v) { return __hip_atomic_fetch_add(p, v, __ATOMIC_RELAXED, __HIP_MEMORY_SCOPE_AGENT); }
__device__ __forceinline__ unsigned xb_xcc_id() { return (unsigned)__builtin_amdgcn_s_getreg((3 << 11) | 20) & 0xFu; }
#define XB_SPIN(cond, bar) do { unsigned _sp = 0; while (cond) { __builtin_amdgcn_s_sleep(1); \
    if ((++_sp & 255u) == 0u) { if (xb_ld(&(bar)[XB_TMO])) break; if (_sp > XB_SPIN_CAP) { atomicAdd(&(bar)[XB_TMO], 1u); break; } } } } while (0)

struct XcdBarrier {
    unsigned* bar; unsigned x;
    volatile LAS unsigned* st;
};

__device__ __forceinline__ XcdBarrier xcd_barrier_post(unsigned* bar, volatile LAS unsigned* st) {
    XcdBarrier b; b.bar = bar; b.x = xb_xcc_id(); b.st = st;
    if (threadIdx.x == 0) (void)xb_add(&bar[XB_XCNT(b.x)], 1u);
    return b;
}
__device__ __forceinline__ void xcd_barrier_complete(unsigned* bar, unsigned x, unsigned& nloc, unsigned& nx) {
    const unsigned G = gridDim.x * gridDim.y * gridDim.z;
    unsigned sum, cnt, mine, sp = 0u;
    for (;;) {
        sum = 0u; cnt = 0u; mine = 0u;
#pragma unroll
        for (unsigned j = 0; j < 16; ++j) { const unsigned c = xb_ld(&bar[XB_XCNT(j)]); sum += c; cnt += (c > 0u) ? 1u : 0u; mine = (j == x) ? c : mine; }
        if (sum == G) break;
        __builtin_amdgcn_s_sleep(1);
        if ((++sp & 255u) == 0u) { if (xb_ld(&bar[XB_TMO])) break; if (sp > XB_SPIN_CAP) { atomicAdd(&bar[XB_TMO], 1u); break; } }
    }
    nloc = mine > 0u ? mine : 1u; nx = cnt > 0u ? cnt : 1u;
}

__device__ __forceinline__ void xcd_barrier(const XcdBarrier& b) {
    asm volatile("s_waitcnt vmcnt(0)" ::: "memory");
    __syncthreads();
    if (threadIdx.x == 0) {
        unsigned* bar = b.bar;
        __builtin_amdgcn_s_waitcnt(0);
        unsigned nloc = b.st[0], nx = b.st[1];
        if (nloc == 0u) { xcd_barrier_complete(bar, b.x, nloc, nx); b.st[0] = nloc; b.st[1] = nx; }
        const unsigned old = xb_add(&bar[XB_XSUB(b.x)], 1u);
        const unsigned gen = old / nloc;
        if (old + 1u == (gen + 1u) * nloc) {
            __builtin_amdgcn_fence(__ATOMIC_RELEASE, "agent");
            asm volatile("s_waitcnt vmcnt(0)" ::: "memory");
            const unsigned og = xb_add(&bar[XB_TOP], 1u);
            const unsigned tg = og / nx;
            if (og + 1u == (tg + 1u) * nx) xb_add(&bar[XB_TOPGEN], 1u);
            else XB_SPIN(xb_ld(&bar[XB_TOPGEN]) == tg, bar);
            __builtin_amdgcn_fence(__ATOMIC_ACQUIRE, "agent");
            xb_add(&bar[XB_XGEN(b.x)], 1u);
            asm volatile("s_waitcnt vmcnt(0)" ::: "memory");
        } else {
            XB_SPIN(xb_ld(&bar[XB_XGEN(b.x)]) == gen, bar);
            __builtin_amdgcn_fence(__ATOMIC_ACQUIRE, "agent");
            asm volatile("s_waitcnt vmcnt(0)" ::: "memory");
        }
    }
    __syncthreads();
}

template <int NH>
__device__ __forceinline__ void build_hs_table(LAS float* tab, const float* SS, int pm, int tid) {
    for (int it = tid; it < 256 * NH; it += 512) { const int row = it / NH, h = it % NH;
        const f32x4* sp = (const f32x4*)(SS + ((size_t)(pm * 256 + row) * NH + h) * 32);
        float s = 0.f;
#pragma unroll
        for (int i = 0; i < 8; ++i) { const f32x4 v = sp[i]; s += (v.x + v.y) + (v.z + v.w); }
        tab[h * 256 + row] = rsqrtf(s * (1.f / 512.f) + 1e-6f); }
    __syncthreads();
    float f[NH / 2];
#pragma unroll
    for (int k = 0; k < NH / 2; ++k) { const int it = tid + 512 * k, j = it >> 8, row = it & 255; f[k] = (j < NH - 1) ? tab[j * 256 + row] / tab[(j + 1) * 256 + row] : tab[j * 256 + row]; }
    __syncthreads();
#pragma unroll
    for (int k = 0; k < NH / 2; ++k) tab[tid + 512 * k] = f[k];
    __syncthreads();
}

struct Args { const float* x; const int* pos; const float* ev_norm; const float* ev_w_in; const float* sgu_gain; const float* sgu_w_s; const float* sgu_b; const float* ev_w_out;
              const float* od_norm; const float* od_w_in; const float* gla_w_lr; const float* gla_b_lr; const float* od_w_out; const float* final_norm; float* out; unsigned char* ws; int never; int pad; };

__global__ void __launch_bounds__(512, 2) trunk_fwd(Args a) {
    extern __shared__ __attribute__((aligned(16))) unsigned char lds_raw[];
    LAS unsigned char* lds = (LAS unsigned char*)lds_raw;
    cg::grid_group grid = cg::this_grid();
    volatile LAS unsigned* xbst = (volatile LAS unsigned*)(lds + 131072 + 8 * 2304);
    if (threadIdx.x < 2) xbst[threadIdx.x] = 0u;
    __syncthreads();
    XcdBarrier xbar = xcd_barrier_post((unsigned*)a.ws, xbst);
    const int G = gridDim.x, bid = blockIdx.x, ngw = G * 8;
#define PH_BEGIN int t_ = threadIdx.x; asm volatile("" : "+v"(t_)); const int tid = t_, lane = tid & 63, wave = __builtin_amdgcn_readfirstlane(tid >> 6), gw = bid * 8 + wave; LAS float* scr = (LAS float*)(lds + wave * 16384); (void)lane; (void)gw; (void)scr;
    unsigned char* ws = a.ws;
    float* LR = (float*)(ws + WS_LR); bf16* WLRT = (bf16*)(ws + WS_WLRT); float* DEC = (float*)(ws + WS_DEC);
    bf16* WA = (bf16*)(ws + WS_WA); bf16* H = (bf16*)(ws + WS_H); bf16* Pb = (bf16*)(ws + WS_P);
    bf16* SC = (bf16*)(ws + WS_SC); float* SS = (float*)(ws + WS_SS); bf16* WO0 = (bf16*)(ws + WS_WO0);

    { PH_BEGIN
    for (int rep = 0; rep < 1 + ((PROBE >> 11) & 1); ++rep) {
    transpose_all<true>(a.ev_w_in, 12288, 2048, 12288, WA, scr, gw, ngw, lane);
    for (int m = gw; m < T; m += ngw) rms_row_bf16(a.x + (size_t)m * DM, a.ev_norm, H + (size_t)m * DM, lane);
    }
    }
    xcd_barrier(xbar);
    { PH_BEGIN
    if ((PROBE >> 15) & 1) { pg8::Gemm g{H, WA, T, 12288, 2048, 2048}; pg8::StaticOrder S; S.init(T, 12288, G, bid); pg8::EpiHot E{(bf16*)a.out};
      pg8::gemm_phase<pg8::EpiHot, pg8::StaticOrder, true, true>(lds, g, S, E); }
    for (int rep = 0; rep < 1 + ((PROBE >> 1) & 1); ++rep)
    { pg8::Gemm g{H, WA, T, 12288, 2048, 2048}; pg8::StaticOrder S; S.init(T, 12288, G, bid); pg8::EpiBf16W E{Pb, LD, lds + 131072};
      pg8::gemm_phase<pg8::EpiBf16W, pg8::StaticOrder, true, true>(lds, g, S, E); }
    }
    xcd_barrier(xbar);
    { PH_BEGIN
    if ((PROBE >> 2) & 1) for (int u = bid; u < 1024; u += G) retpre_unit<true>(lds, Pb, a.pos, SC, DEC, u, tid, a.never);
    for (int u = bid; u < 1024; u += G) retpre_unit<false>(lds, Pb, a.pos, SC, DEC, u, tid, a.never);
    }
    xcd_barrier(xbar);
    { PH_BEGIN
    for (int v = bid; v < 256; v += G) { const int xcd = v & 7, idx = v >> 3;
        if (idx < 16) { const int wk = xcd * 16 + idx;
            if ((PROBE >> 4) & 1) scan_worker<4, Q0, K0, V0, GR0, true>(lds, Pb, SC, DEC, SS, wk, tid, a.never);
            scan_worker<4, Q0, K0, V0, GR0, false>(lds, Pb, SC, DEC, SS, wk, tid, a.never);
        } else { const int hi = (idx - 16) * 8 + xcd;
            if ((PROBE >> 3) & 1) for (int u = hi; u < 1024; u += 128) sgu_unit<true>(lds, Pb, a.sgu_gain, a.sgu_w_s, a.sgu_b, u, tid, a.never);
            for (int u = hi; u < 1024; u += 128) sgu_unit<false>(lds, Pb, a.sgu_gain, a.sgu_w_s, a.sgu_b, u, tid, a.never);
            transpose_all<false>(a.ev_w_out, 2048, 4096, 2048, WO0, scr, hi * 8 + wave, 128 * 8, lane);
            transpose_all<false>(a.od_w_in, 12304, 2048, 12288, WA, scr, hi * 8 + wave, 128 * 8, lane);
        } }
    }
    grid.sync();
    if (G != 256) {
    { PH_BEGIN
    if ((PROBE >> 5) & 1) fin_phase<4, GR0, true>(Pb, SS, gw, ngw, lane, a.never);
    fin_phase<4, GR0, false>(Pb, SS, gw, ngw, lane, a.never);
    }
    xcd_barrier(xbar);
    }
    { PH_BEGIN
    { pg8::Gemm g{Pb + MIXC, WO0, T, 2048, 4096, LD}; pg8::StaticOrder S; S.init(T, 2048, G, bid); pg8::EpiBf16W E{(bf16*)a.out, 2 * DM, lds + 131072};
      if (G == 256) { pg8::Unit u0; S.next(0, u0); LAS float* tab = (LAS float*)(lds + HS_OFF); build_hs_table<4>(tab, SS, u0.pm, tid);
        pg8::gemm_phase<pg8::EpiBf16W, pg8::StaticOrder, true, true, 4>(lds, g, S, E, tab); }
      else pg8::gemm_phase<pg8::EpiBf16W, pg8::StaticOrder, true, true>(lds, g, S, E); }
    }
    xcd_barrier(xbar);
    { PH_BEGIN
    for (int m = gw; m < T; m += ngw) res_rms_row_bf16(a.x + (size_t)m * DM, (const bf16*)a.out + (size_t)m * 2 * DM, a.od_norm, H + (size_t)m * DM, lane);
    for (int i = bid * 512 + tid; i < 16 * 2048; i += G * 512) { const int r = i >> 11, k = i & 2047; WLRT[i] = (bf16)f2bf(a.od_w_in[(size_t)k * 12304 + 12288 + r]); }
    }
    xcd_barrier(xbar);
    { PH_BEGIN
    lr_phase(H, WLRT, LR, gw, ngw, lane);
    { pg8::Gemm g{H, WA, T, 12288, 2048, 2048}; pg8::StaticOrder S; S.init(T, 12288, G, bid); pg8::EpiBf16W E{Pb, LD, lds + 131072};
      pg8::gemm_phase<pg8::EpiBf16W, pg8::StaticOrder, true, true>(lds, g, S, E); }
    }
    xcd_barrier(xbar);
    { PH_BEGIN
    { float wl[16]; float bb = 0.f; int hcur = -1;
#pragma unroll
      for (int r = 0; r < 16; ++r) wl[r] = 0.f;
      for (int u = bid; u < 2048; u += G) { const int h_ = u & 7;
        if (h_ != hcur) { hcur = h_; const int c_ = tid & 255;
#pragma unroll
            for (int r = 0; r < 16; ++r) wl[r] = a.gla_w_lr[r * 2048 + h_ * 256 + c_];
            bb = a.gla_b_lr[h_ * 256 + c_]; }
        if ((PROBE >> 8) & 1) glapre_unit<true>(lds, Pb, LR, wl, bb, SC, DEC, u, tid, a.never);
        glapre_unit<false>(lds, Pb, LR, wl, bb, SC, DEC, u, tid, a.never); } }
    transpose_all<false>(a.od_w_out, 2048, 4096, 2048, WA, scr, gw, ngw, lane);
    }
    xcd_barrier(xbar);
    { PH_BEGIN
    for (int v = bid; v < 256; v += G) { const int xcd = v & 7, idx = v >> 3; const int wk = (xcd * 2 + (idx >> 4)) * 16 + (idx & 15);
        if ((PROBE >> 9) & 1) scan_worker<8, Q1, K1, V1, G1, true>(lds, Pb, SC, DEC, SS, wk, tid, a.never);
        scan_worker<8, Q1, K1, V1, G1, false>(lds, Pb, SC, DEC, SS, wk, tid, a.never); }
    }
    xcd_barrier(xbar);
    if (G != 256) {
    { PH_BEGIN
    if ((PROBE >> 10) & 1) fin_phase<8, G1, true>(Pb, SS, gw, ngw, lane, a.never);
    fin_phase<8, G1, false>(Pb, SS, gw, ngw, lane, a.never);
    }
    xcd_barrier(xbar);
    }
    { PH_BEGIN
    { pg8::Gemm g{Pb + MIXC, WA, T, 2048, 4096, LD}; pg8::StaticOrder S; S.init(T, 2048, G, bid); pg8::EpiBf16W E{Pb, LD, lds + 131072};
      if (G == 256) { pg8::Unit u0; S.next(0, u0); LAS float* tab = (LAS float*)(lds + HS_OFF); build_hs_table<8>(tab, SS, u0.pm, tid);
        pg8::gemm_phase<pg8::EpiBf16W, pg8::StaticOrder, true, true, 8>(lds, g, S, E, tab); }
      else pg8::gemm_phase<pg8::EpiBf16W, pg8::StaticOrder, true, true>(lds, g, S, E); }
    }
    xcd_barrier(xbar);
    if ((PROBE >> 12) & 1) { for (int rep = 0; rep < 12; ++rep) xcd_barrier(xbar); }
    { PH_BEGIN
    for (int m = gw; m < T; m += ngw) res_rms_row_f32(a.x + (size_t)m * DM, a.out + (size_t)m * DM, Pb + (size_t)m * LD, a.final_norm, lane);
    }
}

extern "C" void kernel_launch(void* const* d_in, const int* in_sizes, int n_in, void* d_out, int out_size, void* d_ws, size_t ws_size, hipStream_t stream) {
    static int grid = 0;
    if (grid == 0) {
        if (n_in != 14 || out_size != T * DM || ws_size < WS_END) { fprintf(stderr, "kernel_launch: unexpected shapes (n_in %d out %d ws %zu)\n", n_in, out_size, ws_size); grid = -1; return; }
        int dev = 0, cus = 0, per_cu = 0;
        (void)hipGetDevice(&dev);
        (void)hipDeviceGetAttribute(&cus, hipDeviceAttributeMultiprocessorCount, dev);
        (void)hipFuncSetAttribute((const void*)trunk_fwd, hipFuncAttributeMaxDynamicSharedMemorySize, LDS_BYTES);
        (void)hipOccupancyMaxActiveBlocksPerMultiprocessor(&per_cu, (const void*)trunk_fwd, 512, LDS_BYTES);
        if (per_cu < 1) per_cu = 1;
        grid = cus * per_cu;
    }
    if (grid < 0) return;
    (void)hipMemsetAsync(d_ws, 0, 16384, stream);
    Args a{};
    a.x = (const float*)d_in[0]; a.pos = (const int*)d_in[1]; a.ev_norm = (const float*)d_in[2]; a.ev_w_in = (const float*)d_in[3]; a.sgu_gain = (const float*)d_in[4];
    a.sgu_w_s = (const float*)d_in[5]; a.sgu_b = (const float*)d_in[6]; a.ev_w_out = (const float*)d_in[7]; a.od_norm = (const float*)d_in[8]; a.od_w_in = (const float*)d_in[9];
    a.gla_w_lr = (const float*)d_in[10]; a.gla_b_lr = (const float*)d_in[11]; a.od_w_out = (const float*)d_in[12]; a.final_norm = (const float*)d_in[13];
    a.out = (float*)d_out; a.ws = (unsigned char*)d_ws;
    void* args[] = {&a};
    hipError_t e = hipLaunchCooperativeKernel((void*)trunk_fwd, dim3(grid), dim3(512), args, LDS_BYTES, stream);
    if (e != hipSuccess) fprintf(stderr, "kernel_launch: cooperative launch failed: %s (grid %d)\n", hipGetErrorString(e), grid);
}
```
